# Optimizing an MI355X kernel written in HIP

```python
import math
import jax, jax.numpy as jnp
from jax import lax
import numpy as np

D_MODEL = 1024
BATCH = 2
SEQ = 8192
DEPTH = 4

N_EVEN = (DEPTH + 1) // 2
N_ODD = DEPTH // 2
D_FF = 256 * ((8 * D_MODEL // 3 + 255) // 256)
NORM_EPS = 1e-6
SC_WIDTH = D_MODEL // 2
SC_KERNEL = 3
ATT_HEAD_DIM = 64
ATT_HEADS = D_MODEL // 128
ATT_WIDTH = ATT_HEADS * ATT_HEAD_DIM
IDX_HEADS = D_MODEL // 128
IDX_DIM = ATT_HEAD_DIM
TOPK_MAX = 256
Q_BLOCK = 128
EV_MIX_WIDTH = SC_WIDTH + ATT_WIDTH
EV_PROJ = 3 * SC_WIDTH + 3 * ATT_WIDTH + IDX_HEADS * IDX_DIM + IDX_DIM + IDX_HEADS
DN_HEAD_DIM = 128
DN_HEADS = D_MODEL // 128
DN_WIDTH = DN_HEADS * DN_HEAD_DIM
DN_KERNEL = 4
CHUNK = 64
OD_PROJ = 4 * DN_WIDTH + 2 * DN_HEADS
ROPE_THETA = 500000.0
ROPE_DIM = ATT_HEAD_DIM // 4

kernel_name = "hybrid_conv_dsa_gdn_macaron"


def rmsnorm(x, gain):
    xf = x.astype(jnp.float32)
    y = xf * lax.rsqrt(jnp.mean(xf * xf, axis=-1, keepdims=True) + NORM_EPS)
    return (y * gain.astype(jnp.float32)).astype(x.dtype)


def l2norm(x):
    xf = x.astype(jnp.float32)
    return (xf * lax.rsqrt(jnp.sum(xf * xf, axis=-1, keepdims=True) + NORM_EPS)).astype(x.dtype)


def split_cols(t, sizes):
    return jnp.split(t, np.cumsum(sizes)[:-1].tolist(), axis=-1)


def swiglu(h, w_gate, w_up, w_down):
    return (jax.nn.silu(h @ w_gate) * (h @ w_up)) @ w_down


def rope_tables(positions):
    inv_freq = ROPE_THETA ** (-jnp.arange(0, ROPE_DIM, 2, dtype=jnp.float32) / ROPE_DIM)
    ang = positions.astype(jnp.float32)[..., None] * inv_freq
    return jnp.cos(ang), jnp.sin(ang)


def apply_partial_rope(x, cos, sin):
    half = ROPE_DIM // 2
    c = cos[:, :, None, :].astype(x.dtype)
    s = sin[:, :, None, :].astype(x.dtype)
    x1, x2, rest = x[..., :half], x[..., half:ROPE_DIM], x[..., ROPE_DIM:]
    return jnp.concatenate([x1 * c - x2 * s, x2 * c + x1 * s, rest], axis=-1)


def causal_depthwise_conv(u, w):
    width, seq = w.shape[0], u.shape[1]
    up = jnp.pad(u, ((0, 0), (width - 1, 0), (0, 0)))
    out = up[:, 0:seq] * w[0]
    for j in range(1, width):
        out = out + up[:, j:j + seq] * w[j]
    return out


def dsa_attention(q, k, v, q_idx, k_idx, w_idx, top_k):
    bsz, seq, heads, hd = q.shape
    n_blocks = seq // Q_BLOCK
    key_pos = jnp.arange(seq, dtype=jnp.int32)
    scale = hd ** -0.5
    gather = jax.vmap(lambda t, i: t[i])

    def blocks(t):
        return jnp.moveaxis(t.reshape((bsz, n_blocks, Q_BLOCK) + t.shape[2:]), 1, 0)

    def one_block(args):
        start, qb, qib, wb = args
        tpos = start + jnp.arange(Q_BLOCK, dtype=jnp.int32)
        admissible = key_pos[None, :] <= tpos[:, None]
        score = jax.nn.relu(jnp.einsum('bthd,bsd->bths', qib, k_idx))
        score = jnp.einsum('bths,bth->bts', score, wb).astype(jnp.float32)
        score = jnp.where(admissible[None], score, -jnp.inf)
        _, sel = lax.top_k(score, top_k)
        k_sel = gather(k, sel)
        v_sel = gather(v, sel)
        logits = jnp.einsum('bthd,btkhd->bthk', qb, k_sel).astype(jnp.float32) * scale
        valid = (sel <= tpos[None, :, None])[:, :, None, :]
        probs = jax.nn.softmax(jnp.where(valid, logits, -jnp.inf), axis=-1).astype(v.dtype)
        return jnp.einsum('bthk,btkhd->bthd', probs, v_sel)

    starts = jnp.arange(n_blocks, dtype=jnp.int32) * Q_BLOCK
    out = lax.map(one_block, (starts, blocks(q), blocks(q_idx), blocks(w_idx)))
    return jnp.moveaxis(out, 0, 1).reshape(bsz, seq, heads * hd)


def conv_sparse_attn_mixer(h, cos, sin, w_in, conv_w, w_out, top_k):
    bsz, seq, _ = h.shape
    parts = split_cols(h @ w_in, [SC_WIDTH] * 3 + [ATT_WIDTH] * 3 + [IDX_HEADS * IDX_DIM, IDX_DIM, IDX_HEADS])
    sc_b, sc_c, sc_x, q, k, v, q_idx, k_idx, w_idx = parts
    y_conv = sc_b * causal_depthwise_conv(sc_c * sc_x, conv_w)
    q = apply_partial_rope(q.reshape(bsz, seq, ATT_HEADS, ATT_HEAD_DIM), cos, sin)
    k = apply_partial_rope(k.reshape(bsz, seq, ATT_HEADS, ATT_HEAD_DIM), cos, sin)
    v = v.reshape(bsz, seq, ATT_HEADS, ATT_HEAD_DIM)
    q_idx = apply_partial_rope(q_idx.reshape(bsz, seq, IDX_HEADS, IDX_DIM), cos, sin)
    k_idx = apply_partial_rope(k_idx[:, :, None, :], cos, sin)[:, :, 0]
    w_idx = w_idx * (IDX_HEADS * IDX_DIM) ** -0.5
    y_attn = dsa_attention(q, k, v, q_idx, k_idx, w_idx, top_k)
    return jnp.concatenate([y_conv, y_attn], axis=-1) @ w_out


def gated_delta_rule(q, k, v, g, beta):
    bsz, seq, heads, dk = q.shape
    dv = v.shape[-1]
    n_chunks = seq // CHUNK

    def chunks(t):
        t = jnp.moveaxis(t, 2, 1).astype(jnp.float32)
        return t.reshape(t.shape[:2] + (n_chunks, CHUNK) + t.shape[3:])

    q, k, v, g, beta = (chunks(t) for t in (q, k, v, g, beta))
    g = jnp.cumsum(g, axis=-1)
    causal = jnp.tril(jnp.ones((CHUNK, CHUNK), dtype=bool))
    strict = jnp.tril(jnp.ones((CHUNK, CHUNK), dtype=bool), k=-1)
    diff = g[..., :, None] - g[..., None, :]
    decay = jnp.where(causal, jnp.exp(jnp.where(causal, diff, 0.0)), 0.0)
    k_beta = k * beta[..., None]
    a_mat = jnp.where(strict, jnp.einsum('bhnid,bhnjd->bhnij', k_beta, k) * decay, 0.0)
    eye = jnp.eye(CHUNK, dtype=jnp.float32)
    t_inv = lax.linalg.triangular_solve(a_mat + eye, jnp.broadcast_to(eye, a_mat.shape),
                                        left_side=True, lower=True, unit_diagonal=True)
    u = jnp.einsum('bhnij,bhnjd->bhnid', t_inv, v * beta[..., None])
    w = jnp.einsum('bhnij,bhnjd->bhnid', t_inv, k_beta * jnp.exp(g)[..., None])
    intra = jnp.einsum('bhnid,bhnjd->bhnij', q, k) * decay
    q_dec = q * jnp.exp(g)[..., None]
    k_dec = k * jnp.exp(g[..., -1:] - g)[..., None]
    chunk_decay = jnp.exp(g[..., -1])
    xs = tuple(jnp.moveaxis(t, 2, 0) for t in (u, w, intra, q_dec, k_dec, chunk_decay))

    def step(state, inp):
        u_n, w_n, intra_n, q_n, k_n, d_n = inp
        v_new = u_n - jnp.einsum('bhcd,bhde->bhce', w_n, state)
        out = jnp.einsum('bhcd,bhde->bhce', q_n, state) + jnp.einsum('bhij,bhje->bhie', intra_n, v_new)
        state = state * d_n[..., None, None] + jnp.einsum('bhcd,bhce->bhde', k_n, v_new)
        return state, out

    state0 = jnp.zeros((bsz, heads, dk, dv), jnp.float32)
    _, out = lax.scan(step, state0, xs)
    out = jnp.moveaxis(out, 0, 2).reshape(bsz, heads, seq, dv)
    return jnp.moveaxis(out, 1, 2)


def gated_deltanet_mixer(h, w_in, conv_w, a_log, dt_bias, o_gain, w_out):
    bsz, seq, _ = h.shape
    qkv, z, b_raw, a_raw = split_cols(h @ w_in, [3 * DN_WIDTH, DN_WIDTH, DN_HEADS, DN_HEADS])
    qkv = jax.nn.silu(causal_depthwise_conv(qkv, conv_w))
    q, k, v = (t.reshape(bsz, seq, DN_HEADS, DN_HEAD_DIM) for t in jnp.split(qkv, 3, axis=-1))
    q = l2norm(q) * DN_HEAD_DIM ** -0.5
    k = l2norm(k)
    beta = jax.nn.sigmoid(b_raw.astype(jnp.float32))
    g = -jnp.exp(a_log.astype(jnp.float32)) * jax.nn.softplus(a_raw.astype(jnp.float32) + dt_bias.astype(jnp.float32))
    o = gated_delta_rule(q, k, v, g, beta).astype(h.dtype)
    o = rmsnorm(o, o_gain) * jax.nn.silu(z.reshape(bsz, seq, DN_HEADS, DN_HEAD_DIM))
    return o.reshape(bsz, seq, DN_WIDTH) @ w_out


def setup_inputs(seed: int = 0) -> dict:
    key = jax.random.key(seed)
    ks = jax.random.split(key, 16)
    f32 = jnp.float32

    def nrm(k, shape, fan_in):
        return jax.random.normal(k, shape, f32) * fan_in ** -0.5

    x = jax.random.normal(ks[0], (BATCH, SEQ, D_MODEL), f32)
    positions = jnp.broadcast_to(jnp.arange(SEQ, dtype=jnp.int32), (BATCH, SEQ))
    norm_gain = 1.0 + 0.02 * jax.random.normal(ks[1], (DEPTH, 3, D_MODEL), f32)
    ffn_w_gate = nrm(ks[2], (DEPTH, 2, D_MODEL, D_FF), D_MODEL)
    ffn_w_up = nrm(ks[3], (DEPTH, 2, D_MODEL, D_FF), D_MODEL)
    ffn_w_down = nrm(ks[4], (DEPTH, 2, D_FF, D_MODEL), D_FF)
    ev_w_in = nrm(ks[5], (N_EVEN, D_MODEL, EV_PROJ), D_MODEL)
    ev_conv_w = nrm(ks[6], (N_EVEN, SC_KERNEL, SC_WIDTH), SC_KERNEL)
    ev_w_out = nrm(ks[7], (N_EVEN, EV_MIX_WIDTH, D_MODEL), EV_MIX_WIDTH)
    od_w_in = nrm(ks[8], (N_ODD, D_MODEL, OD_PROJ), D_MODEL)
    od_conv_w = nrm(ks[9], (N_ODD, DN_KERNEL, 3 * DN_WIDTH), DN_KERNEL)
    od_a_log = jnp.log(jax.random.uniform(ks[10], (N_ODD, DN_HEADS), f32, 1.0, 16.0))
    dt = jnp.exp(jax.random.uniform(ks[11], (N_ODD, DN_HEADS), f32, math.log(1e-3), math.log(1e-1)))
    od_dt_bias = dt + jnp.log(-jnp.expm1(-dt))
    od_o_gain = 1.0 + 0.02 * jax.random.normal(ks[12], (N_ODD, DN_HEAD_DIM), f32)
    od_w_out = nrm(ks[13], (N_ODD, DN_WIDTH, D_MODEL), DN_WIDTH)
    final_gain = 1.0 + 0.02 * jax.random.normal(ks[14], (D_MODEL,), f32)
    return {"x": x, "positions": positions, "norm_gain": norm_gain,
            "ffn_w_gate": ffn_w_gate, "ffn_w_up": ffn_w_up, "ffn_w_down": ffn_w_down,
            "ev_w_in": ev_w_in, "ev_conv_w": ev_conv_w, "ev_w_out": ev_w_out,
            "od_w_in": od_w_in, "od_conv_w": od_conv_w, "od_a_log": od_a_log,
            "od_dt_bias": od_dt_bias, "od_o_gain": od_o_gain, "od_w_out": od_w_out,
            "final_gain": final_gain}


def reference(x, positions, norm_gain, ffn_w_gate, ffn_w_up, ffn_w_down, ev_w_in, ev_conv_w, ev_w_out,
              od_w_in, od_conv_w, od_a_log, od_dt_bias, od_o_gain, od_w_out, final_gain):
    top_k = min(TOPK_MAX, x.shape[1] // 4)
    cos, sin = rope_tables(positions)
    for layer in range(DEPTH):
        i = layer // 2
        x = x + 0.5 * swiglu(rmsnorm(x, norm_gain[layer, 0]), ffn_w_gate[layer, 0], ffn_w_up[layer, 0], ffn_w_down[layer, 0])
        h = rmsnorm(x, norm_gain[layer, 1])
        if layer % 2 == 0:
            x = x + conv_sparse_attn_mixer(h, cos, sin, ev_w_in[i], ev_conv_w[i], ev_w_out[i], top_k)
        else:
            x = x + gated_deltanet_mixer(h, od_w_in[i], od_conv_w[i], od_a_log[i], od_dt_bias[i], od_o_gain[i], od_w_out[i])
        x = x + 0.5 * swiglu(rmsnorm(x, norm_gain[layer, 2]), ffn_w_gate[layer, 1], ffn_w_up[layer, 1], ffn_w_down[layer, 1])
    return rmsnorm(x, final_gain)
```

```cpp
#include <hip/hip_runtime.h>
#include <stdint.h>

namespace orc {
constexpr int D_MODEL = 1024, BATCH = 2, SEQ = 8192, NTOK = BATCH * SEQ, DEPTH = 4, D_FF = 2816;
constexpr int EV_PROJ = 3656, OD_PROJ = 4112;
constexpr float EPS = 1e-6f;

__global__ void __launch_bounds__(256) k_rmsnorm(const float* x, const float* gain, float* out, int rows) {
    const int row = blockIdx.x * 4 + (threadIdx.x >> 6), lane = threadIdx.x & 63;
    if (row >= rows) return;
    const float* xr = x + (size_t)row * D_MODEL; float v[16]; float s = 0.f;
#pragma unroll
    for (int i = 0; i < 16; ++i) { v[i] = xr[lane + 64 * i]; s += v[i] * v[i]; }
#pragma unroll
    for (int o = 32; o >= 1; o >>= 1) s += __shfl_xor(s, o);
    const float r = 1.0f / sqrtf(s * (1.0f / D_MODEL) + EPS);
#pragma unroll
    for (int i = 0; i < 16; ++i) out[(size_t)row * D_MODEL + lane + 64 * i] = v[i] * r * gain[lane + 64 * i];
}

template <int MODE>
__global__ void __launch_bounds__(256) k_gemm(const float* __restrict__ A, const float* __restrict__ B, const float* __restrict__ B2, float* C, int M, int N, int K, float alpha) {
    __shared__ float As[16][64 + 4], Bs[16][64 + 4], Bs2[MODE == 1 ? 16 : 1][64 + 4];
    const int tx = threadIdx.x & 15, ty = threadIdx.x >> 4, m0 = blockIdx.y * 64, n0 = blockIdx.x * 64;
    float acc[4][4] = {}, acc2[4][4] = {};
    for (int k0 = 0; k0 < K; k0 += 16) {
        for (int i = threadIdx.x; i < 64 * 16; i += 256) { const int r = i >> 4, c = i & 15; As[c][r] = A[(size_t)(m0 + r) * K + k0 + c]; }
        for (int i = threadIdx.x; i < 16 * 64; i += 256) { const int r = i >> 6, c = i & 63; const int n = n0 + c;
            Bs[r][c] = n < N ? B[(size_t)(k0 + r) * N + n] : 0.f; if (MODE == 1) Bs2[r][c] = n < N ? B2[(size_t)(k0 + r) * N + n] : 0.f; }
        __syncthreads();
#pragma unroll
        for (int kk = 0; kk < 16; ++kk) {
            float a[4], b[4], b2[4];
#pragma unroll
            for (int i = 0; i < 4; ++i) { a[i] = As[kk][ty * 4 + i]; b[i] = Bs[kk][tx * 4 + i]; if (MODE == 1) b2[i] = Bs2[kk][tx * 4 + i]; }
#pragma unroll
            for (int i = 0; i < 4; ++i)
#pragma unroll
                for (int j = 0; j < 4; ++j) { acc[i][j] += a[i] * b[j]; if (MODE == 1) acc2[i][j] += a[i] * b2[j]; }
        }
        __syncthreads();
    }
#pragma unroll
    for (int i = 0; i < 4; ++i)
#pragma unroll
        for (int j = 0; j < 4; ++j) { const int m = m0 + ty * 4 + i, n = n0 + tx * 4 + j; if (n < N) { float* c = C + (size_t)m * N + n;
            if (MODE == 0) *c = acc[i][j];
            if (MODE == 1) { const float g = acc[i][j]; *c = g / (1.0f + expf(-g)) * acc2[i][j]; }
            if (MODE == 2) *c = *c + alpha * acc[i][j]; } }
}

__global__ void k_rope(const int* __restrict__ pos, float* cs, float* sn) {
    const int i = blockIdx.x * blockDim.x + threadIdx.x; if (i >= NTOK * 8) return;
    const int t = i >> 3, j = i & 7;
    const float inv = (float)pow(500000.0, -(double)(2 * j) / 16.0);
    const float ang = (float)pos[t] * inv;
    cs[i] = (float)cos((double)ang); sn[i] = (float)sin((double)ang);
}

__global__ void __launch_bounds__(256) k_ev_post(float* proj, const float* __restrict__ cs, const float* __restrict__ sn, const float* __restrict__ convw, float* y) {
    const int tok = blockIdx.x, t = tok % SEQ, tid = threadIdx.x;
    float* p = proj + (size_t)tok * EV_PROJ;
    for (int c = tid; c < 512; c += 256) {
        float acc = 0.f;
#pragma unroll
        for (int j = 0; j < 3; ++j) { const int tt = t - 2 + j; if (tt >= 0) { const float* pp = proj + (size_t)(tok - 2 + j) * EV_PROJ; acc += convw[j * 512 + c] * (pp[512 + c] * pp[1024 + c]); } }
        y[(size_t)tok * D_MODEL + c] = p[c] * acc;
    }
    __syncthreads();
    for (int i = tid; i < 25 * 8; i += 256) { const int hd = i >> 3, j = i & 7; int base;
        if (hd < 8) base = 1536 + hd * 64; else if (hd < 16) base = 2048 + (hd - 8) * 64; else if (hd < 24) base = 3072 + (hd - 16) * 64; else base = 3584;
        const float c = cs[tok * 8 + j], s = sn[tok * 8 + j], x1 = p[base + j], x2 = p[base + 8 + j];
        p[base + j] = x1 * c - x2 * s; p[base + 8 + j] = x2 * c + x1 * s; }
    if (tid < 8) p[3648 + tid] *= 0.044194173824159216f;
}

__device__ __forceinline__ unsigned fkey(float f) { const unsigned u = __float_as_uint(f); return (u & 0x80000000u) ? ~u : (u | 0x80000000u); }
__device__ __forceinline__ float block_sum(float v, float* red, int tid) {
#pragma unroll
    for (int o = 32; o >= 1; o >>= 1) v += __shfl_xor(v, o);
    __syncthreads(); if ((tid & 63) == 0) red[tid >> 6] = v; __syncthreads();
    return red[0] + red[1] + red[2] + red[3];
}
__device__ __forceinline__ float block_max(float v, float* red, int tid) {
#pragma unroll
    for (int o = 32; o >= 1; o >>= 1) v = fmaxf(v, __shfl_xor(v, o));
    __syncthreads(); if ((tid & 63) == 0) red[tid >> 6] = v; __syncthreads();
    return fmaxf(fmaxf(red[0], red[1]), fmaxf(red[2], red[3]));
}
__device__ __forceinline__ int block_sum_i(int v, int* red, int tid) {
#pragma unroll
    for (int o = 32; o >= 1; o >>= 1) v += __shfl_xor(v, o);
    __syncthreads(); if ((tid & 63) == 0) red[tid >> 6] = v; __syncthreads();
    return red[0] + red[1] + red[2] + red[3];
}

__global__ void __launch_bounds__(256) k_dsa(const float* __restrict__ proj, float* y) {
    __shared__ float sc[SEQ]; __shared__ float qv[512]; __shared__ float wv[8]; __shared__ int sel[256]; __shared__ float pr[256];
    __shared__ float redf[4]; __shared__ int redi[4]; __shared__ int scan[256];
    const int tok = blockIdx.x, b = tok / SEQ, t = tok % SEQ, tid = threadIdx.x, n = t + 1;
    const float* p = proj + (size_t)tok * EV_PROJ;
    for (int i = tid; i < 512; i += 256) qv[i] = p[3072 + i];
    if (tid < 8) wv[tid] = p[3648 + tid];
    __syncthreads();
    for (int s = tid; s < n; s += 256) {
        const float* kk = proj + (size_t)(b * SEQ + s) * EV_PROJ + 3584; float kr[64];
#pragma unroll
        for (int d = 0; d < 64; ++d) kr[d] = kk[d];
        float acc = 0.f;
        for (int h = 0; h < 8; ++h) { float dd = 0.f;
#pragma unroll
            for (int d = 0; d < 64; ++d) dd += qv[h * 64 + d] * kr[d];
            acc += fmaxf(dd, 0.f) * wv[h]; }
        sc[s] = acc;
    }
    __syncthreads();
    int nsel;
    if (n <= 256) { if (tid < n) sel[tid] = tid; nsel = n; }
    else {
        unsigned lo = 0u;
        for (int bit = 31; bit >= 0; --bit) { const unsigned c = lo | (1u << bit); int cnt = 0;
            for (int s = tid; s < n; s += 256) cnt += fkey(sc[s]) >= c ? 1 : 0;
            cnt = block_sum_i(cnt, redi, tid); if (cnt >= 256) lo = c; }
        int cg = 0, ce = 0;
        for (int s = tid * 32; s < tid * 32 + 32 && s < n; ++s) { const unsigned k = fkey(sc[s]); cg += k > lo; ce += k == lo; }
        const int tot_g = block_sum_i(cg, redi, tid); const int need = 256 - tot_g;
        __syncthreads(); scan[tid] = ce; __syncthreads();
        int eprefix = 0; for (int i = 0; i < tid; ++i) eprefix += scan[i];
        int mysel = cg + max(0, min(ce, need - eprefix));
        __syncthreads(); scan[tid] = mysel; __syncthreads();
        int sprefix = 0; for (int i = 0; i < tid; ++i) sprefix += scan[i];
        int er = eprefix, pos = sprefix;
        for (int s = tid * 32; s < tid * 32 + 32 && s < n; ++s) { const unsigned k = fkey(sc[s]); bool take = k > lo; if (k == lo) { take = er < need; ++er; } if (take) sel[pos++] = s; }
        nsel = 256;
    }
    __syncthreads();
    for (int h = 0; h < 8; ++h) {
        float lg = -INFINITY;
        if (tid < nsel) { const float* kk = proj + (size_t)(b * SEQ + sel[tid]) * EV_PROJ + 2048 + h * 64; const float* qq = p + 1536 + h * 64; float dd = 0.f;
#pragma unroll
            for (int d = 0; d < 64; ++d) dd += qq[d] * kk[d];
            lg = dd * 0.125f; }
        const float mx = block_max(lg, redf, tid);
        const float e = tid < nsel ? expf(lg - mx) : 0.f;
        const float sm = block_sum(e, redf, tid);
        pr[tid] = e / sm;
        __syncthreads();
        { const int d = tid & 63, part = tid >> 6; float acc = 0.f;
          for (int j = part; j < nsel; j += 4) acc += pr[j] * proj[(size_t)(b * SEQ + sel[j]) * EV_PROJ + 2560 + h * 64 + d];
          __syncthreads(); scan[tid] = __float_as_int(acc); __syncthreads();
          if (tid < 64) y[(size_t)tok * D_MODEL + 512 + h * 64 + tid] = __int_as_float(scan[tid]) + __int_as_float(scan[tid + 64]) + __int_as_float(scan[tid + 128]) + __int_as_float(scan[tid + 192]); }
        __syncthreads();
    }
}

__global__ void __launch_bounds__(128) k_gdn(const float* __restrict__ proj, const float* __restrict__ convw, const float* __restrict__ a_log, const float* __restrict__ dt_bias,
                                             const float* __restrict__ o_gain, float* y) {
    __shared__ float qs[128], ks[128]; __shared__ float red[2];
    const int b = blockIdx.x >> 3, h = blockIdx.x & 7, e = threadIdx.x, ch = h * 128 + e;
    float S[128];
#pragma unroll
    for (int d = 0; d < 128; ++d) S[d] = 0.f;
    float cw[3][4];
#pragma unroll
    for (int s3 = 0; s3 < 3; ++s3)
#pragma unroll
        for (int j = 0; j < 4; ++j) cw[s3][j] = convw[j * 3072 + s3 * 1024 + ch];
    float hist[3][3] = {};
    const float A = -expf(a_log[h]), dtb = dt_bias[h], og = o_gain[e];
    for (int t = 0; t < SEQ; ++t) {
        const float* p = proj + (size_t)(b * SEQ + t) * OD_PROJ;
        float val[3];
#pragma unroll
        for (int s3 = 0; s3 < 3; ++s3) { const float cur = p[s3 * 1024 + ch];
            const float c = cw[s3][0] * hist[s3][0] + cw[s3][1] * hist[s3][1] + cw[s3][2] * hist[s3][2] + cw[s3][3] * cur;
            hist[s3][0] = hist[s3][1]; hist[s3][1] = hist[s3][2]; hist[s3][2] = cur; val[s3] = c / (1.0f + expf(-c)); }
        float sq = val[0] * val[0], sk = val[1] * val[1];
#pragma unroll
        for (int o = 32; o >= 1; o >>= 1) { sq += __shfl_xor(sq, o); sk += __shfl_xor(sk, o); }
        __syncthreads(); if ((e & 63) == 0) { qs[e >> 6] = sq; ks[e >> 6] = sk; } __syncthreads();
        sq = qs[0] + qs[1]; sk = ks[0] + ks[1]; __syncthreads();
        const float qn = val[0] / sqrtf(sq + EPS) * 0.08838834764831845f, kn = val[1] / sqrtf(sk + EPS), vv = val[2];
        qs[e] = qn; ks[e] = kn; __syncthreads();
        const float braw = p[4096 + h], araw = p[4104 + h];
        const float beta = 1.0f / (1.0f + expf(-braw)); const float xsp = araw + dtb; const float sp = xsp > 20.f ? xsp : log1pf(expf(xsp));
        const float eg = expf(A * sp);
        float kS = 0.f;
#pragma unroll
        for (int d = 0; d < 128; ++d) kS += ks[d] * S[d];
        const float coef = beta * (vv - eg * kS);
        float o = 0.f;
#pragma unroll
        for (int d = 0; d < 128; ++d) { S[d] = eg * S[d] + ks[d] * coef; o += qs[d] * S[d]; }
        float so = o * o;
#pragma unroll
        for (int off = 32; off >= 1; off >>= 1) so += __shfl_xor(so, off);
        __syncthreads(); if ((e & 63) == 0) red[e >> 6] = so; __syncthreads();
        so = red[0] + red[1];
        const float z = p[3072 + ch];
        y[(size_t)(b * SEQ + t) * D_MODEL + ch] = o / sqrtf(so * (1.0f / 128.0f) + EPS) * og * (z / (1.0f + expf(-z)));
    }
}

template <int MODE> static void gemm(const float* A, const float* B, const float* B2, float* C, int M, int N, int K, float alpha, hipStream_t st) {
    dim3 grid((N + 63) / 64, M / 64); hipLaunchKernelGGL(k_gemm<MODE>, grid, dim3(256), 0, st, A, B, B2, C, M, N, K, alpha);
}

static void forward(void* const* d_in, float* xio, char* ws, hipStream_t st) {
    const float* x_in = (const float*)d_in[0]; const int* pos = (const int*)d_in[1]; const float* norm_gain = (const float*)d_in[2];
    const float* wg = (const float*)d_in[3]; const float* wu = (const float*)d_in[4]; const float* wd = (const float*)d_in[5];
    const float* ev_w_in = (const float*)d_in[6]; const float* ev_conv = (const float*)d_in[7]; const float* ev_w_out = (const float*)d_in[8];
    const float* od_w_in = (const float*)d_in[9]; const float* od_conv = (const float*)d_in[10]; const float* od_a_log = (const float*)d_in[11];
    const float* od_dt = (const float*)d_in[12]; const float* od_og = (const float*)d_in[13]; const float* od_w_out = (const float*)d_in[14]; const float* fgain = (const float*)d_in[15];
    float* xn = (float*)ws;
    float* big = (float*)(ws + (size_t)NTOK * D_MODEL * 4);
    float* yb = big + (size_t)NTOK * OD_PROJ;
    float* cs = yb + (size_t)NTOK * D_MODEL; float* sn = cs + NTOK * 8;
    hipMemcpyAsync(xio, x_in, (size_t)NTOK * D_MODEL * 4, hipMemcpyDeviceToDevice, st);
    hipLaunchKernelGGL(k_rope, dim3(NTOK * 8 / 256), dim3(256), 0, st, pos, cs, sn);
    for (int l = 0; l < DEPTH; ++l) { const int i = l / 2;
        for (int half = 0; half < 2; ++half) {
            if (half == 1) {
                hipLaunchKernelGGL(k_rmsnorm, dim3(NTOK / 4), dim3(256), 0, st, xio, norm_gain + (l * 3 + 1) * D_MODEL, xn, NTOK);
                if (l % 2 == 0) {
                    gemm<0>(xn, ev_w_in + (size_t)i * D_MODEL * EV_PROJ, nullptr, big, NTOK, EV_PROJ, D_MODEL, 0.f, st);
                    hipLaunchKernelGGL(k_ev_post, dim3(NTOK), dim3(256), 0, st, big, cs, sn, ev_conv + i * 3 * 512, yb);
                    hipLaunchKernelGGL(k_dsa, dim3(NTOK), dim3(256), 0, st, big, yb);
                    gemm<2>(yb, ev_w_out + (size_t)i * D_MODEL * D_MODEL, nullptr, xio, NTOK, D_MODEL, D_MODEL, 1.0f, st);
                } else {
                    gemm<0>(xn, od_w_in + (size_t)i * D_MODEL * OD_PROJ, nullptr, big, NTOK, OD_PROJ, D_MODEL, 0.f, st);
                    hipLaunchKernelGGL(k_gdn, dim3(16), dim3(128), 0, st, big, od_conv + i * 4 * 3072, od_a_log + i * 8, od_dt + i * 8, od_og + i * 128, yb);
                    gemm<2>(yb, od_w_out + (size_t)i * D_MODEL * D_MODEL, nullptr, xio, NTOK, D_MODEL, D_MODEL, 1.0f, st);
                }
            }
            const int f = half;
            const size_t wo = ((size_t)l * 2 + f) * D_MODEL * D_FF;
            hipLaunchKernelGGL(k_rmsnorm, dim3(NTOK / 4), dim3(256), 0, st, xio, norm_gain + (l * 3 + (f == 0 ? 0 : 2)) * D_MODEL, xn, NTOK);
            gemm<1>(xn, wg + wo, wu + wo, big, NTOK, D_FF, D_MODEL, 0.f, st);
            gemm<2>(big, wd + wo, nullptr, xio, NTOK, D_MODEL, D_FF, 0.5f, st);
        }
    }
    hipLaunchKernelGGL(k_rmsnorm, dim3(NTOK / 4), dim3(256), 0, st, xio, fgain, xio, NTOK);
}
}

extern "C" void kernel_launch(void* const* d_in, const int* in_sizes, int n_in, void* d_out, int out_size, void* d_ws, size_t ws_size, hipStream_t stream) {
    orc::forward(d_in, (float*)d_out, (char*)d_ws, stream);
}
```

```cpp
#include <hip/hip_runtime.h>
#include <stdint.h>
#include <cstdio>
#ifndef MK_ONE_LAUNCH
#define MK_ONE_LAUNCH 1
#endif
#ifndef MK_VCU
#define MK_VCU 0
#endif
#define LAS __attribute__((address_space(3)))
namespace pg8 {
#define PG8_LAS __attribute__((address_space(3)))
typedef unsigned short bf16_t;
typedef short bf16x8 __attribute__((ext_vector_type(8)));
typedef float f32x4 __attribute__((ext_vector_type(4)));
typedef unsigned u32x4 __attribute__((ext_vector_type(4)));
constexpr int BM = 256, BK = 64, HALF = 128, HTB = HALF * BK * 2  , STAGE_BYTES = 8 * HTB, NXCD = 8, WGM = 8;

__host__ __device__ __forceinline__ int lds_byte(int r, int c) { const int st = (r >> 4) * 2 + (c >> 5), rr = r & 15, cc = c & 31, ob = rr * 64 + cc * 2; return st * 1024 + (ob ^ (((ob >> 9) & 1) << 5)); }
__host__ __device__ __forceinline__ void stage_rc(int b, int& R, int& C) { const int st = b / 1024, sb = b % 1024, swz = sb ^ (((sb >> 9) & 1) << 5); R = (st >> 1) * 16 + swz / 64; C = (st & 1) * 32 + (swz % 64) / 2; }
__host__ __device__ __forceinline__ int perm32(int rho) { const int n = rho >> 4, i = rho & 15; return 8 * (i >> 2) + 4 * n + (i & 3); }

struct Unit { int pm, pn; };
struct Gemm { const bf16_t* A; const bf16_t* Bt; int M, N, K; int ntov; int kz; };

struct StaticOrder {
    int nM, nN, nwg, G, c;
    __host__ __device__ void init(int M, int N, int G_, int c_) { nM = M / BM; nN = N / BM; nwg = nM * nN; G = G_; c = c_; }
    __host__ __device__ bool next(int i, Unit& u) const {
        const long L = (long)i * G + c; if (L >= nwg) return false;
        int wgid = (int)L; { const int q = nwg / NXCD, r = nwg % NXCD, xcd = wgid % NXCD, off = wgid / NXCD; wgid = (xcd < r ? xcd * (q + 1) : r * (q + 1) + (xcd - r) * q) + off; }
        const int nig = WGM * nN, gid = wgid / nig, fm = gid * WGM, gsz = (nM - fm) < WGM ? (nM - fm) : WGM;
        u.pm = fm + ((wgid % nig) % gsz); u.pn = (wgid % nig) / gsz; return true;
    }
    __device__ __forceinline__ void a_ready(const Unit&) const {}
    __device__ __forceinline__ void done(const Unit&) const {}
};__device__ __forceinline__ unsigned cvt_pk_bf16(float lo, float hi) { unsigned r; asm volatile("v_cvt_pk_bf16_f32 %0, %1, %2" : "=v"(r) : "v"(lo), "v"(hi)); return r; }
template <class Epi, class Sched, bool ALIGN_EPI = false, bool SP2 = false>
__device__ __forceinline__ void gemm_phase(PG8_LAS unsigned char* lds, const Gemm g, const Sched& S, const Epi& E) {
    int tid_ = threadIdx.x; asm volatile("" : "+v"(tid_));
    const int tid = tid_, wid = __builtin_amdgcn_readfirstlane(tid >> 6), lane = tid & 63, wr = wid >> 2, wc = wid & 3, fr = lane & 15, fq = lane >> 4;
    const int K = g.K, nt = g.ntov ? g.ntov : K / BK;
    unsigned voffA[2], voffB[2];
#pragma unroll
    for (int i = 0; i < 2; ++i) { int R, C; stage_rc(tid * 16 + i * 8192, R, C); const int Rb = Epi::PERM ? ((R & ~31) + perm32(R & 31)) : R;
        voffA[i] = (unsigned)(R * K + C) * 2u; voffB[i] = (unsigned)(Rb * K + C) * 2u; }
    const size_t kstep = g.kz ? (size_t)0 : (size_t)(BK * 2);
    size_t hstep = (size_t)HALF * K * 2;
    const size_t tstep = 2 * hstep;
    const unsigned ldsw = (unsigned)wid * 1024u;
    const int aoff = lds_byte(wr * 64 + fr, fq * 8), boff = lds_byte(wc * 32 + fr, fq * 8);
#define PG8_SA(b, h) (((b) * 2 + (h)) * HTB)
#define PG8_SB(b, h) ((4 + (b) * 2 + (h)) * HTB)
#define PG8_STAGE(bufoff, gbase, voff) do { _Pragma("unroll") for (int _i = 0; _i < 2; ++_i) \
        __builtin_amdgcn_global_load_lds((const unsigned*)((const char*)(gbase) + (voff)[_i]), (PG8_LAS unsigned*)(lds + (bufoff) + ldsw + _i * 8192), 16, 0, 0); } while (0)
#define PG8_LDA(dst, b, h) do { _Pragma("unroll") for (int m = 0; m < 4; ++m) _Pragma("unroll") for (int k = 0; k < 2; ++k) dst[m][k] = *(const PG8_LAS bf16x8*)(lds + PG8_SA(b, h) + aoff + m * 2048 + k * 1024); } while (0)
#define PG8_LDB(dst, b, h) do { _Pragma("unroll") for (int n = 0; n < 2; ++n) _Pragma("unroll") for (int k = 0; k < 2; ++k) dst[n][k] = *(const PG8_LAS bf16x8*)(lds + PG8_SB(b, h) + boff + n * 2048 + k * 1024); } while (0)
#define PG8_MMA(ai, bj, At, Bt) do { __builtin_amdgcn_s_setprio(1); _Pragma("unroll") for (int m = 0; m < 4; ++m) _Pragma("unroll") for (int n = 0; n < 2; ++n) _Pragma("unroll") for (int k = 0; k < 2; ++k) \
        acc[ai][bj][m][n] = __builtin_amdgcn_mfma_f32_16x16x32_bf16(Bt[n][k], At[m][k], acc[ai][bj][m][n], 0, 0, 0); __builtin_amdgcn_s_setprio(0); } while (0)
#define PG8_WAIT_V(n) asm volatile("s_waitcnt vmcnt(" #n ")" ::: "memory")
#define PG8_WAIT_L(n) asm volatile("s_waitcnt lgkmcnt(" #n ")" ::: "memory")
#define PG8_BAR __builtin_amdgcn_s_barrier()
#define PG8_SCHED __builtin_amdgcn_sched_barrier(0)
    Unit cur, nxt; int ui = 0;
    if (!S.next(0, cur)) return;
    f32x4 acc[2][2][4][2];
#pragma unroll
    for (int a = 0; a < 2; ++a)
#pragma unroll
        for (int b = 0; b < 2; ++b)
#pragma unroll
            for (int m = 0; m < 4; ++m)
#pragma unroll
                for (int n = 0; n < 2; ++n) acc[a][b][m][n] = (f32x4){0.f, 0.f, 0.f, 0.f};
    bf16x8 At[4][2], B0[2][2], B1[2][2];
    const char* cA = (const char*)g.A + (size_t)cur.pm * tstep; const char* cB = (const char*)g.Bt + (size_t)cur.pn * tstep;
    const int rot = Epi::KROT == 1 ? (cur.pn & 3) * ((nt >> 2) & ~1) : 0;
#define PG8_KT(t) (Epi::KROT == 2 ? (size_t)(nt - 2 - ((t) & ~1) + ((t) & 1)) : (size_t)((t) + rot >= nt ? (t) + rot - nt : (t) + rot))
    const char* cA0 = cA + PG8_KT(0) * kstep; const char* cB0 = cB + PG8_KT(0) * kstep;
    S.a_ready(cur);
    if constexpr (SP2) {
        PG8_STAGE(PG8_SB(0, 0), cB0, voffB); PG8_STAGE(PG8_SB(0, 1), cB0 + hstep, voffB); PG8_STAGE(PG8_SA(0, 0), cA0, voffA); PG8_STAGE(PG8_SA(0, 1), cA0 + hstep, voffA);
        if (wr == 1) PG8_BAR;
        PG8_WAIT_V(2); PG8_BAR;
        PG8_STAGE(PG8_SB(1, 0), cB0 + kstep, voffB); PG8_STAGE(PG8_SA(1, 0), cA0 + kstep, voffA); PG8_STAGE(PG8_SB(1, 1), cB0 + hstep + kstep, voffB);
        PG8_WAIT_V(6); PG8_BAR;
    } else {
        PG8_STAGE(PG8_SB(0, 0), cB, voffB); PG8_STAGE(PG8_SA(0, 0), cA, voffA); PG8_STAGE(PG8_SB(0, 1), cB + hstep, voffB); PG8_STAGE(PG8_SA(0, 1), cA + hstep, voffA);
        if (wr == 1) PG8_BAR;
        PG8_WAIT_V(4); PG8_BAR;
        PG8_STAGE(PG8_SB(1, 0), cB0 + kstep, voffB); PG8_STAGE(PG8_SA(1, 0), cA0 + kstep, voffA); PG8_STAGE(PG8_SB(1, 1), cB0 + hstep + kstep, voffB);
        PG8_WAIT_V(6); PG8_BAR;
    }
    for (;;) {
        const bool has_next = S.next(ui + 1, nxt);
        const char* nA = has_next ? (const char*)g.A + (size_t)nxt.pm * tstep : cA; const char* nB = has_next ? (const char*)g.Bt + (size_t)nxt.pn * tstep : cB;
        if constexpr (Epi::RESID_LDS) { if (!has_next) { nB = E.resid_tile(cur); nA = nB + 256; } }
        for (int t = 0; t < nt; t += 2) {
            const bool last = (t == nt - 2);
            const char* a1 = cA + PG8_KT(t + 1) * kstep;
            const char* a2 = last ? nA : cA + PG8_KT(t + 2) * kstep; const char* b2 = last ? nB : cB + PG8_KT(t + 2) * kstep;
            const char* a3 = a2 + kstep; const char* b3 = b2 + kstep;
            if (last && has_next) S.a_ready(nxt);
            if constexpr (SP2) {
            bool lastx = false; if constexpr (Epi::RESID_LDS) lastx = last && !has_next;
            PG8_LDB(B0, 0, 0); PG8_LDB(B1, 0, 1); PG8_SCHED; PG8_LDA(At, 0, 0); PG8_STAGE(PG8_SA(1, 1), a1 + hstep, voffA);
            PG8_WAIT_V(8); PG8_WAIT_L(0); PG8_BAR; PG8_MMA(0, 0, At, B0); PG8_MMA(0, 1, At, B1); PG8_BAR; PG8_SCHED;
            if constexpr (Epi::RESID_LDS) { if (lastx) {
                int t2 = threadIdx.x; asm volatile("" : "+v"(t2));
#pragma unroll
                for (int i = 0; i < 2; ++i) { int R, C; stage_rc(t2 * 16 + i * 8192, R, C); voffA[i] = voffB[i] = (unsigned)(R * E.resid_ld() + C) * 2u; }
                hstep = (size_t)HALF * E.resid_ld() * 2; } }
            PG8_LDA(At, 0, 1); PG8_STAGE(PG8_SB(0, 0), b2, voffB); PG8_STAGE(PG8_SB(0, 1), b2 + hstep, voffB); PG8_STAGE(PG8_SA(0, 0), a2, voffA);
            PG8_WAIT_V(8); PG8_WAIT_L(0); PG8_BAR; PG8_MMA(1, 0, At, B0); PG8_MMA(1, 1, At, B1); PG8_BAR; PG8_SCHED;
            PG8_LDB(B0, 1, 0); PG8_LDB(B1, 1, 1); PG8_SCHED; PG8_LDA(At, 1, 0); PG8_STAGE(PG8_SA(0, 1), a2 + hstep, voffA);
            PG8_WAIT_V(8); PG8_WAIT_L(0); PG8_BAR; PG8_MMA(0, 0, At, B0); PG8_MMA(0, 1, At, B1); PG8_BAR; PG8_SCHED;
            PG8_LDA(At, 1, 1); PG8_STAGE(PG8_SB(1, 0), b3, voffB); PG8_STAGE(PG8_SB(1, 1), b3 + hstep, voffB); PG8_STAGE(PG8_SA(1, 0), a3, voffA);
            if (lastx) PG8_WAIT_V(14); else PG8_WAIT_V(8);
            PG8_WAIT_L(0); PG8_BAR; PG8_MMA(1, 0, At, B0); PG8_MMA(1, 1, At, B1); PG8_BAR; PG8_SCHED;
            } else {
            PG8_LDB(B0, 0, 0); PG8_SCHED; PG8_LDA(At, 0, 0); PG8_STAGE(PG8_SA(1, 1), a1 + hstep, voffA);
            PG8_WAIT_L(8); PG8_BAR; PG8_WAIT_L(0); PG8_MMA(0, 0, At, B0); PG8_BAR; PG8_SCHED;
            PG8_LDB(B1, 0, 1); PG8_STAGE(PG8_SB(0, 0), b2, voffB);
            PG8_BAR; PG8_WAIT_L(0); PG8_MMA(0, 1, At, B1); PG8_BAR;
            PG8_LDA(At, 0, 1); PG8_STAGE(PG8_SA(0, 0), a2, voffA);
            PG8_BAR; PG8_WAIT_L(0); PG8_MMA(1, 0, At, B0); PG8_BAR; PG8_SCHED;
            PG8_STAGE(PG8_SB(0, 1), b2 + hstep, voffB);
            PG8_WAIT_V(6); PG8_BAR; PG8_MMA(1, 1, At, B1); PG8_BAR;
            PG8_LDB(B0, 1, 0); PG8_SCHED; PG8_LDA(At, 1, 0); PG8_STAGE(PG8_SA(0, 1), a2 + hstep, voffA);
            PG8_WAIT_L(8); PG8_BAR; PG8_WAIT_L(0); PG8_MMA(0, 0, At, B0); PG8_BAR; PG8_SCHED;
            PG8_LDB(B1, 1, 1); PG8_STAGE(PG8_SB(1, 0), b3, voffB);
            PG8_BAR; PG8_WAIT_L(0); PG8_MMA(0, 1, At, B1); PG8_BAR;
            PG8_LDA(At, 1, 1); PG8_STAGE(PG8_SA(1, 0), a3, voffA);
            PG8_BAR; PG8_WAIT_L(0); PG8_MMA(1, 0, At, B0); PG8_BAR; PG8_SCHED;
            PG8_STAGE(PG8_SB(1, 1), b3 + hstep, voffB);
            PG8_WAIT_V(6); PG8_BAR; PG8_MMA(1, 1, At, B1); PG8_BAR;
            }
        }
        if constexpr (ALIGN_EPI) { if (wr == 0) PG8_BAR; }
        if constexpr (Epi::RESID_LDS) { E.resid_lds(acc, cur, wr, wc, fr, fq, lds); S.done(cur); return; }
        else if constexpr (!Epi::AFTER_DRAIN) { E(acc, cur, wr, wc, fr, fq); S.done(cur); }
        if (!has_next) break;
#pragma unroll
        for (int a = 0; a < 2; ++a)
#pragma unroll
            for (int b = 0; b < 2; ++b)
#pragma unroll
                for (int m = 0; m < 4; ++m)
#pragma unroll
                    for (int n = 0; n < 2; ++n) acc[a][b][m][n] = (f32x4){0.f, 0.f, 0.f, 0.f};
        cur = nxt; cA = nA; cB = nB; ++ui;
        if constexpr (ALIGN_EPI) { if (wr == 1) PG8_BAR; }
    }
    PG8_WAIT_V(0);
    if constexpr (!ALIGN_EPI) { if (wr == 0) PG8_BAR; }
    PG8_BAR;
    if constexpr (Epi::AFTER_DRAIN) { E.fused(acc, cur, wr, wc, fr, fq, lds, wid, lane); S.done(cur); }
#undef PG8_SA
#undef PG8_KT
#undef PG8_SB
#undef PG8_STAGE
#undef PG8_LDA
#undef PG8_LDB
#undef PG8_MMA
#undef PG8_WAIT_V
#undef PG8_WAIT_L
#undef PG8_BAR
#undef PG8_SCHED
}
}
#define XB_TMO      128
#define XB_XCNT(j)  (256  + 64 * (j))
#define XB_XSUB(j)  (1280 + 64 * (j))
#define XB_XGEN(j)  (2304 + 64 * (j))
#define XB_TOP      3328
#define XB_TOPGEN   3392
#define XCD_BAR_WORDS 3456
#define XB_SPIN_CAP (1u << 18)

__device__ __forceinline__ unsigned xb_ld(unsigned* p)              { return __hip_atomic_load(p, __ATOMIC_RELAXED, __HIP_MEMORY_SCOPE_AGENT); }
__device__ __forceinline__ unsigned xb_add(unsigned* p, unsigned v) { return __hip_atomic_fetch_add(p, v, __ATOMIC_RELAXED, __HIP_MEMORY_SCOPE_AGENT); }
__device__ __forceinline__ unsigned xb_xcc_id() { return (unsigned)__builtin_amdgcn_s_getreg((3 << 11) | 20) & 0xFu; }
#define XB_SPIN(cond, bar) do { unsigned _sp = 0; while (cond) { __builtin_amdgcn_s_sleep(1); \
    if ((++_sp & 255u) == 0u) { if (xb_ld(&(bar)[XB_TMO])) break; if (_sp > XB_SPIN_CAP) { atomicAdd(&(bar)[XB_TMO], 1u); break; } } } } while (0)

struct XcdBarrier {
    unsigned* bar; unsigned x;
    volatile LAS unsigned* st;
};

__device__ __forceinline__ XcdBarrier xcd_barrier_post(unsigned* bar, volatile LAS unsigned* st) {
    XcdBarrier b; b.bar = bar; b.x = xb_xcc_id(); b.st = st;
    if (threadIdx.x == 0) (void)xb_add(&bar[XB_XCNT(b.x)], 1u);
    return b;
}
__device__ __forceinline__ void xcd_barrier_complete(unsigned* bar, unsigned x, unsigned& nloc, unsigned& nx) {
    const unsigned G = gridDim.x * gridDim.y * gridDim.z;
    unsigned sum, cnt, mine, sp = 0u;
    for (;;) {
        sum = 0u; cnt = 0u; mine = 0u;
#pragma unroll
        for (unsigned j = 0; j < 16; ++j) { const unsigned c = xb_ld(&bar[XB_XCNT(j)]); sum += c; cnt += (c > 0u) ? 1u : 0u; mine = (j == x) ? c : mine; }
        if (sum == G) break;
        __builtin_amdgcn_s_sleep(1);
        if ((++sp & 255u) == 0u) { if (xb_ld(&bar[XB_TMO])) break; if (sp > XB_SPIN_CAP) { atomicAdd(&bar[XB_TMO], 1u); break; } }
    }
    nloc = mine > 0u ? mine : 1u; nx = cnt > 0u ? cnt : 1u;
}

__device__ __forceinline__ void xcd_barrier(const XcdBarrier& b, const bool local = false) {
    asm volatile("s_waitcnt vmcnt(0)" ::: "memory");
    __syncthreads();
    if (threadIdx.x == 0) {
        unsigned* bar = b.bar;
        __builtin_amdgcn_s_waitcnt(0);
        unsigned nloc = b.st[0], nx = b.st[1];
        if (nloc == 0u) { xcd_barrier_complete(bar, b.x, nloc, nx); b.st[0] = nloc; b.st[1] = nx; }
        const unsigned old = xb_add(&bar[XB_XSUB(b.x)], 1u);
        const unsigned gen = old / nloc;
        if (old + 1u == (gen + 1u) * nloc) {
            if (!local) {
            __builtin_amdgcn_fence(__ATOMIC_RELEASE, "agent");
            asm volatile("s_waitcnt vmcnt(0)" ::: "memory");
            const unsigned og = xb_add(&bar[XB_TOP], 1u);
            const unsigned tg = og / nx;
            if (og + 1u == (tg + 1u) * nx) xb_add(&bar[XB_TOPGEN], 1u);
            else XB_SPIN(xb_ld(&bar[XB_TOPGEN]) == tg, bar);
            }
            __builtin_amdgcn_fence(__ATOMIC_ACQUIRE, "agent");
            xb_add(&bar[XB_XGEN(b.x)], 1u);
            asm volatile("s_waitcnt vmcnt(0)" ::: "memory");
        } else {
            XB_SPIN(xb_ld(&bar[XB_XGEN(b.x)]) == gen, bar);
            __builtin_amdgcn_fence(__ATOMIC_ACQUIRE, "agent");
            asm volatile("s_waitcnt vmcnt(0)" ::: "memory");
        }
    }
    __syncthreads();
}


namespace mk {
using pg8::bf16_t; using pg8::f32x4; using pg8::u32x4; using pg8::Unit; using pg8::bf16x8;

constexpr int DM = 1024, NTOK = 16384, SEQ = 8192, DFF = 2816;
constexpr float EPS = 1e-6f;
constexpr size_t MB = 1ull << 20;
constexpr size_t WS_BAR = 0;
constexpr size_t WS_TICK = 32 * 1024;
constexpr size_t WS_SS = 64 * 1024;
constexpr size_t WS_ROPE = WS_SS + MB;
constexpr size_t WS_XB = 4 * MB;
constexpr size_t WS_W = WS_XB + 32 * MB;
constexpr size_t WREG = 46 * MB;
constexpr size_t WO_GU0 = 0, WO_D0 = 11534336, WO_GU1 = WO_D0 + 5767168, WO_D1 = WO_GU1 + 11534336, WO_MIN = WO_D1 + 5767168, WO_MOUT = WO_MIN + 8388608, WO_BA = WO_MOUT + 2097152;
constexpr size_t WS_MIX = WS_W + 2 * WREG;
constexpr size_t WS_H = WS_MIX;

__device__ __forceinline__ int otid() { int t = threadIdx.x; asm volatile("" : "+v"(t)); return t; }
typedef float f32x2_t __attribute__((ext_vector_type(2))); typedef __bf16 bf16x2_t __attribute__((ext_vector_type(2)));
__device__ __forceinline__ unsigned pk2(float lo, float hi) { const f32x2_t v = {lo, hi}; const bf16x2_t b = __builtin_convertvector(v, bf16x2_t); return __builtin_bit_cast(unsigned, b); }
__device__ __forceinline__ int dpp_i(int v, const int ctl) { return ctl == 0xB1 ? __builtin_amdgcn_update_dpp(0, v, 0xB1, 0xF, 0xF, true) : ctl == 0x4E ? __builtin_amdgcn_update_dpp(0, v, 0x4E, 0xF, 0xF, true) : ctl == 0x141 ? __builtin_amdgcn_update_dpp(0, v, 0x141, 0xF, 0xF, true) : __builtin_amdgcn_update_dpp(0, v, 0x140, 0xF, 0xF, true); }
__device__ __forceinline__ float dpp_f(float v, const int ctl) { return __int_as_float(dpp_i(__float_as_int(v), ctl)); }
__device__ __forceinline__ float sum8_f(float s) { s += dpp_f(s, 0xB1); s += dpp_f(s, 0x4E); s += dpp_f(s, 0x141); return s; }
__device__ __forceinline__ int wave_sum_i(int v) {
    v += dpp_i(v, 0xB1); v += dpp_i(v, 0x4E); v += dpp_i(v, 0x141); v += dpp_i(v, 0x140);
    return __builtin_amdgcn_readlane(v, 0) + __builtin_amdgcn_readlane(v, 16) + __builtin_amdgcn_readlane(v, 32) + __builtin_amdgcn_readlane(v, 48);
}
__device__ __forceinline__ float bf2f(unsigned short b) { return __uint_as_float(((unsigned)b) << 16); }
__device__ __forceinline__ float silu_f(float g) { return g * __builtin_amdgcn_rcpf(1.0f + __expf(-g)); }
__device__ __forceinline__ float row_rstd(const float* ss, int row) {
    const f32x4* p = (const f32x4*)(ss + (size_t)row * 16); const f32x4 a = p[0], b = p[1], c = p[2], d = p[3];
    const float s = (((a[0] + a[1]) + (a[2] + a[3])) + ((b[0] + b[1]) + (b[2] + b[3]))) + (((c[0] + c[1]) + (c[2] + c[3])) + ((d[0] + d[1]) + (d[2] + d[3])));
    return 1.0f / sqrtf(s * (1.0f / 1024.0f) + EPS);
}

__device__ __forceinline__ void rows_rstd4(const float* ss, int rowa, int fr, int fq, float (&rs)[4]) {
    const float r0 = row_rstd(ss, rowa + fq * 16);
#pragma unroll
    for (int q = 0; q < 4; ++q) rs[q] = __shfl(r0, q * 16 + fr);
}

__device__ __forceinline__ void ph_xprep(const float* x, bf16_t* xb, float* ss, int G, int bid) {
    const int tid = otid(), wid = tid >> 6, lane = tid & 63;
    for (int row = bid * 8 + wid; row < NTOK; row += G * 8) {
        const float* xr = x + (size_t)row * DM; bf16_t* br = xb + (size_t)row * DM;
#pragma unroll
        for (int hlf = 0; hlf < 2; ++hlf) { const int c = hlf * 512 + lane * 8;
            const f32x4 a = *(const f32x4*)(xr + c), b = *(const f32x4*)(xr + c + 4);
            u32x4 w; w.x = pk2(a[0], a[1]); w.y = pk2(a[2], a[3]); w.z = pk2(b[0], b[1]); w.w = pk2(b[2], b[3]); *(u32x4*)(br + c) = w;
            const float a0 = __uint_as_float(w.x << 16), a1 = __uint_as_float(w.x & 0xffff0000u), a2 = __uint_as_float(w.y << 16), a3 = __uint_as_float(w.y & 0xffff0000u);
            const float b0 = __uint_as_float(w.z << 16), b1 = __uint_as_float(w.z & 0xffff0000u), b2 = __uint_as_float(w.w << 16), b3 = __uint_as_float(w.w & 0xffff0000u);
            float s = (a0 * a0 + a1 * a1) + (a2 * a2 + a3 * a3) + (b0 * b0 + b1 * b1) + (b2 * b2 + b3 * b3);
            s = sum8_f(s);
            if ((lane & 7) == 0) ss[(size_t)row * 16 + hlf * 8 + (lane >> 3)] = s; }
    }
}
__device__ __forceinline__ void ph_rope(const int* pos, float* cs, float* sn, int G, int bid) {
    for (int i = bid * 512 + otid(); i < NTOK * 8; i += G * 512) { const int t = i >> 3, j = i & 7;
        const float inv = (float)pow(500000.0, -(double)(2 * j) / 16.0); const float ang = (float)pos[t] * inv;
        cs[i] = (float)cos((double)ang); sn[i] = (float)sin((double)ang); }
}

__device__ __forceinline__ int hperm(int p) { return p < 16 ? ((p & 3) | ((p & 4) << 1) | ((p & 8) >> 1)) : p; }
__device__ __forceinline__ int src_col(int kind, int n, float& scale, int& mat) {
    scale = 1.0f; mat = 0;
    if (kind == 0) return n;
    if (kind == 1) { const int pn = n >> 8, j = n & 255; mat = j >> 7; return pn * 128 + (j & 127); }
    if (kind == 3) return n < 16 ? 4096 + n : -1;
    const int pn = n >> 8, j = n & 255;
    if (pn < 4) return j < 128 ? 512 + 128 * pn + j : 1024 + 128 * pn + (j - 128);
    if (pn < 6) return (pn - 4) * 256 + j;
    if (pn < 14) { const int base = 1536 + (pn - 6) * 256 + j; if (pn < 10 || pn >= 12) { const int p = base & 63; return base - p + hperm(p); } return base; }
    if (j < 64) return 3584 + hperm(j);
    if (j < 72) { scale = 0.044194173824159216f; return 3648 + (j - 64); }
    return -1;
}
__device__ __forceinline__ void conv_tile(LAS float* tl, int kind, const float* W, const float* W2, const float* gain, bf16_t* Wt, int K, int Nsrc, int tile) {
    const int ktiles = K >> 6, nt = tile / ktiles, kt = tile - nt * ktiles, n0 = nt * 128, k0 = kt * 64, tid = otid();
    { const int nq = (tid & 31) * 4, kr = tid >> 5; float sc; int mat; const int sc_col = src_col(kind, n0 + nq, sc, mat); const float* Ws = mat ? W2 : W;
      f32x4 v[4];
#pragma unroll
      for (int i = 0; i < 4; ++i) { const int k = k0 + kr + 16 * i; v[i] = (f32x4){0.f, 0.f, 0.f, 0.f};
          if (sc_col >= 0) { v[i] = *(const f32x4*)(Ws + (size_t)k * Nsrc + sc_col) * (gain ? sc * gain[k] : sc); } }
#pragma unroll
      for (int i = 0; i < 4; ++i) *(LAS f32x4*)(tl + (kr + 16 * i) * 132 + nq) = v[i]; }
    __syncthreads();
    { const int r = tid >> 2, kq = tid & 3; float v[16];
#pragma unroll
      for (int e = 0; e < 16; ++e) v[e] = tl[(16 * kq + e) * 132 + r];
      u32x4 w0, w1; w0.x = pk2(v[0], v[1]); w0.y = pk2(v[2], v[3]); w0.z = pk2(v[4], v[5]); w0.w = pk2(v[6], v[7]);
      w1.x = pk2(v[8], v[9]); w1.y = pk2(v[10], v[11]); w1.z = pk2(v[12], v[13]); w1.w = pk2(v[14], v[15]);
      bf16_t* dst = Wt + (size_t)(n0 + r) * K + k0 + 16 * kq; *(u32x4*)dst = w0; *(u32x4*)(dst + 8) = w1; }
    __syncthreads();
}
struct Args { const float* in[16]; float* out; unsigned char* ws; int ph_lo, ph_hi; };
typedef Args WPtrs;
__device__ __forceinline__ void convert_layer(LAS float* tl, const WPtrs& P, unsigned char* ws, int l, int first, int stride) {
    const int i = l >> 1, odd = l & 1; unsigned char* wr = ws + WS_W + (size_t)(l & 1) * WREG;
    const float* ng = P.in[2] + (size_t)l * 3 * DM;
    const int nGU = 44 * 16, nD = 8 * 44, nIN = odd ? 32 * 16 : 30 * 16, nOUT = 8 * 16, nBA = odd ? 16 : 0;
    const int t1 = nGU, t2 = t1 + nD, t3 = t2 + nGU, t4 = t3 + nD, t5 = t4 + nIN, t6 = t5 + nOUT, t7 = t6 + nBA;
    for (int t = first; t < t7; t += stride) {
        if (t < t1) { const size_t wo = ((size_t)l * 2 + 0) * DM * DFF; conv_tile(tl, 1, P.in[3] + wo, P.in[4] + wo, ng + 0 * DM, (bf16_t*)(wr + WO_GU0), DM, DFF, t); }
        else if (t < t2) { const size_t wo = ((size_t)l * 2 + 0) * DM * DFF; conv_tile(tl, 0, P.in[5] + wo, nullptr, nullptr, (bf16_t*)(wr + WO_D0), DFF, DM, t - t1); }
        else if (t < t3) { const size_t wo = ((size_t)l * 2 + 1) * DM * DFF; conv_tile(tl, 1, P.in[3] + wo, P.in[4] + wo, ng + 2 * DM, (bf16_t*)(wr + WO_GU1), DM, DFF, t - t2); }
        else if (t < t4) { const size_t wo = ((size_t)l * 2 + 1) * DM * DFF; conv_tile(tl, 0, P.in[5] + wo, nullptr, nullptr, (bf16_t*)(wr + WO_D1), DFF, DM, t - t3); }
        else if (t < t5) { if (!odd) conv_tile(tl, 2, P.in[6] + (size_t)i * DM * 3656, nullptr, ng + DM, (bf16_t*)(wr + WO_MIN), DM, 3656, t - t4);
                           else conv_tile(tl, 0, P.in[9] + (size_t)i * DM * 4112, nullptr, ng + DM, (bf16_t*)(wr + WO_MIN), DM, 4112, t - t4); }
        else if (t < t6) { conv_tile(tl, 0, (odd ? P.in[14] : P.in[8]) + (size_t)i * DM * DM, nullptr, nullptr, (bf16_t*)(wr + WO_MOUT), DM, DM, t - t5); }
        else { conv_tile(tl, 3, P.in[9] + (size_t)i * DM * 4112, nullptr, ng + DM, (bf16_t*)(wr + WO_BA), DM, 4112, t - t6); }
    }
}

struct EpiGateUp {
    static constexpr bool PERM = true, AFTER_DRAIN = false, RESID_LDS = false; static constexpr int KROT = 0;
    bf16_t* H; const float* ss;
    __device__ __forceinline__ void operator()(const f32x4 (&acc)[2][2][4][2], const Unit& u, int wr, int wc, int fr, int fq) const {
        const int row0 = u.pm * 256 + wr * 64 + fr, hc = u.pn * 128 + wc * 32 + 8 * fq;
#ifndef EPX_GU
#define EPX_GU 1
#endif
        for (int epx_ = 0; epx_ < EPX_GU; ++epx_)
#pragma unroll
        for (int ai = 0; ai < 2; ++ai) { float rs[4]; rows_rstd4(ss, row0 + ai * 128, fr, fq, rs);
#pragma unroll
            for (int m = 0; m < 4; ++m) { const int row = row0 + ai * 128 + m * 16; const float r = rs[m];
                float h[8];
#pragma unroll
                for (int n = 0; n < 2; ++n)
#pragma unroll
                    for (int j = 0; j < 4; ++j) h[n * 4 + j] = silu_f(acc[ai][0][m][n][j] * r) * (acc[ai][1][m][n][j] * r);
                u32x4 w; w.x = pk2(h[0], h[1]); w.y = pk2(h[2], h[3]); w.z = pk2(h[4], h[5]); w.w = pk2(h[6], h[7]);
                *(u32x4*)(H + (size_t)row * DFF + hc) = w; } }
    }
};
template <int KR> struct EpiResidT {
    static constexpr bool PERM = true, AFTER_DRAIN = false, RESID_LDS = true; static constexpr int KROT = KR;
    bf16_t* XB; float* ss; float alpha;
    __device__ __forceinline__ void operator()(const f32x4 (&acc)[2][2][4][2], const Unit& u, int wr, int wc, int fr, int fq) const {
        const int row0 = u.pm * 256 + wr * 64 + fr;
        const unsigned loff = (unsigned)(fr * DM + 8 * fq) * 2u;
        char* const ub = (char*)(XB + (size_t)(u.pm * 256 + wr * 64) * DM + u.pn * 256 + wc * 32);
#ifdef EPX_SKIP
        if (alpha == 0.f) return;
#endif
        u32x4 xv[2][4][2];
#pragma unroll
        for (int ai = 0; ai < 2; ++ai)
#pragma unroll
            for (int m = 0; m < 4; ++m)
#pragma unroll
                for (int bj = 0; bj < 2; ++bj) xv[ai][m][bj] = *(const u32x4*)(ub + (size_t)((ai * 128 + m * 16) * DM + bj * 128) * 2 + loff);
        asm volatile("" ::: "memory");
#pragma unroll
        for (int ai = 0; ai < 2; ++ai) {
#pragma unroll
            for (int m = 0; m < 4; ++m) { const int row = row0 + ai * 128 + m * 16; float s = 0.f;
#pragma unroll
                for (int bj = 0; bj < 2; ++bj) { const u32x4 x = xv[ai][m][bj]; const f32x4 d0 = acc[ai][bj][m][0] * alpha, d1 = acc[ai][bj][m][1] * alpha;
                    u32x4 w; w.x = pk2(__uint_as_float(x.x << 16) + d0[0], __uint_as_float(x.x & 0xffff0000u) + d0[1]); w.y = pk2(__uint_as_float(x.y << 16) + d0[2], __uint_as_float(x.y & 0xffff0000u) + d0[3]);
                    w.z = pk2(__uint_as_float(x.z << 16) + d1[0], __uint_as_float(x.z & 0xffff0000u) + d1[1]); w.w = pk2(__uint_as_float(x.w << 16) + d1[2], __uint_as_float(x.w & 0xffff0000u) + d1[3]);
                    *(u32x4*)(ub + (size_t)((ai * 128 + m * 16) * DM + bj * 128) * 2 + loff) = w;
                    const float a0 = __uint_as_float(w.x << 16), a1 = __uint_as_float(w.x & 0xffff0000u), a2 = __uint_as_float(w.y << 16), a3 = __uint_as_float(w.y & 0xffff0000u);
                    const float b0 = __uint_as_float(w.z << 16), b1 = __uint_as_float(w.z & 0xffff0000u), b2 = __uint_as_float(w.w << 16), b3 = __uint_as_float(w.w & 0xffff0000u);
                    s += (a0 * a0 + a1 * a1) + (a2 * a2 + a3 * a3) + (b0 * b0 + b1 * b1) + (b2 * b2 + b3 * b3); }
                s += __shfl_xor(s, 16); s += __shfl_xor(s, 32);
                if (fq == 0) ss[(size_t)row * 16 + u.pn * 4 + wc] = s; }
        }
    }
    __device__ __forceinline__ const char* resid_tile(const Unit& u) const { return (const char*)(XB + (size_t)u.pm * 256 * DM + u.pn * 256); }
    __device__ __forceinline__ int resid_ld() const { return DM; }
    __device__ __forceinline__ void resid_lds(const f32x4 (&acc)[2][2][4][2], const Unit& u, int wr, int wc, int fr, int fq, LAS unsigned char* lds) const {
        const int row0 = u.pm * 256 + wr * 64 + fr;
        const unsigned loff = (unsigned)(fr * DM + 8 * fq) * 2u;
        char* const ub = (char*)(XB + (size_t)(u.pm * 256 + wr * 64) * DM + u.pn * 256 + wc * 32);
        const bool gl = wc >= 2; u32x4 xg[4];
        if (gl) {
#pragma unroll
            for (int m = 0; m < 4; ++m) xg[m] = *(const u32x4*)(ub + (size_t)((128 + m * 16) * DM + 128) * 2 + loff);
            asm volatile("s_waitcnt vmcnt(4)" ::: "memory"); }
        else asm volatile("s_waitcnt vmcnt(0)" ::: "memory");
        if (wr == 0) __builtin_amdgcn_s_barrier();
        __builtin_amdgcn_s_barrier(); asm volatile("" ::: "memory");
        const unsigned lo = (unsigned)pg8::lds_byte(wr * 64 + fr, (wc & 1) * 32 + 8 * fq) + (unsigned)(wc >> 1) * (unsigned)(2 * pg8::HTB);
#pragma unroll
        for (int ai = 0; ai < 2; ++ai) {
            u32x4 xv[4][2];
#pragma unroll
            for (int m = 0; m < 4; ++m) {
                xv[m][0] = *(const LAS u32x4*)(lds + (4 + ai) * pg8::HTB + lo + m * 2048);
                if (ai == 1) { if (gl) xv[m][1] = xg[m]; else xv[m][1] = *(const LAS u32x4*)(lds + ai * pg8::HTB + lo + m * 2048); }
                else xv[m][1] = *(const LAS u32x4*)(lds + ai * pg8::HTB + lo + m * 2048); }
#pragma unroll
            for (int m = 0; m < 4; ++m) { const int row = row0 + ai * 128 + m * 16; float s = 0.f;
#pragma unroll
                for (int bj = 0; bj < 2; ++bj) { const u32x4 x = xv[m][bj]; const f32x4 d0 = acc[ai][bj][m][0] * alpha, d1 = acc[ai][bj][m][1] * alpha;
                    u32x4 w; w.x = pk2(__uint_as_float(x.x << 16) + d0[0], __uint_as_float(x.x & 0xffff0000u) + d0[1]); w.y = pk2(__uint_as_float(x.y << 16) + d0[2], __uint_as_float(x.y & 0xffff0000u) + d0[3]);
                    w.z = pk2(__uint_as_float(x.z << 16) + d1[0], __uint_as_float(x.z & 0xffff0000u) + d1[1]); w.w = pk2(__uint_as_float(x.w << 16) + d1[2], __uint_as_float(x.w & 0xffff0000u) + d1[3]);
                    *(u32x4*)(ub + (size_t)((ai * 128 + m * 16) * DM + bj * 128) * 2 + loff) = w;
                    const float a0 = __uint_as_float(w.x << 16), a1 = __uint_as_float(w.x & 0xffff0000u), a2 = __uint_as_float(w.y << 16), a3 = __uint_as_float(w.y & 0xffff0000u);
                    const float b0 = __uint_as_float(w.z << 16), b1 = __uint_as_float(w.z & 0xffff0000u), b2 = __uint_as_float(w.w << 16), b3 = __uint_as_float(w.w & 0xffff0000u);
                    s += (a0 * a0 + a1 * a1) + (a2 * a2 + a3 * a3) + (b0 * b0 + b1 * b1) + (b2 * b2 + b3 * b3); }
                s += __shfl_xor(s, 16); s += __shfl_xor(s, 32);
                if (fq == 0) ss[(size_t)row * 16 + u.pn * 4 + wc] = s; }
        }
    }
};
typedef EpiResidT<0> EpiResid;
typedef EpiResidT<2> EpiResidRev;

constexpr size_t EV_U = 0, EV_B = 16 * MB, EV_Q = 32 * MB, EV_K = 48 * MB, EV_V = 64 * MB, EV_QI = 80 * MB, EV_KI = 96 * MB, EV_WI = 98 * MB, EV_Y = 100 * MB, EV_S16 = 132 * MB, EV_BM = 196 * MB;

struct EpiEvIn {
    static constexpr bool PERM = true, AFTER_DRAIN = false, RESID_LDS = false; static constexpr int KROT = 0;
    unsigned char* mx; const float* ss; const float* cs; const float* sn;
    __device__ __forceinline__ void operator()(const f32x4 (&acc)[2][2][4][2], const Unit& u, int wr, int wc, int fr, int fq) const {
        const int row0 = u.pm * 256 + wr * 64 + fr, pn = u.pn;
#pragma unroll
        for (int ai = 0; ai < 2; ++ai) { float rs[4]; rows_rstd4(ss, row0 + ai * 128, fr, fq, rs);
#pragma unroll
            for (int m = 0; m < 4; ++m) { const int row = row0 + ai * 128 + m * 16; const float r = rs[m];
                if (pn < 4) {
                    float h[8]; const float r2 = r * r;
#pragma unroll
                    for (int n = 0; n < 2; ++n)
#pragma unroll
                        for (int j = 0; j < 4; ++j) h[n * 4 + j] = acc[ai][0][m][n][j] * acc[ai][1][m][n][j] * r2;
                    u32x4 w; w.x = pk2(h[0], h[1]); w.y = pk2(h[2], h[3]); w.z = pk2(h[4], h[5]); w.w = pk2(h[6], h[7]);
                    *(u32x4*)((bf16_t*)(mx + EV_U) + (size_t)row * 512 + pn * 128 + wc * 32 + 8 * fq) = w;
                } else if (pn < 6) {
#pragma unroll
                    for (int bj = 0; bj < 2; ++bj) { const f32x4 a = acc[ai][bj][m][0] * r, b = acc[ai][bj][m][1] * r;
                        u32x4 w; w.x = pk2(a[0], a[1]); w.y = pk2(a[2], a[3]); w.z = pk2(b[0], b[1]); w.w = pk2(b[2], b[3]);
                        *(u32x4*)((bf16_t*)(mx + EV_B) + (size_t)row * 512 + (pn - 4) * 256 + bj * 128 + wc * 32 + 8 * fq) = w; }
                } else if (pn < 14) {
                    const int sec = (pn - 6) >> 1; bf16_t* dst = (bf16_t*)(mx + (sec == 0 ? EV_Q : sec == 1 ? EV_K : sec == 2 ? EV_V : EV_QI));
                    const bool rope = (sec != 2) && ((wc & 1) == 0) && (fq < 2);
                    f32x4 c4 = {1.f, 1.f, 1.f, 1.f}, s4 = {0.f, 0.f, 0.f, 0.f};
                    if (rope) { c4 = *(const f32x4*)(cs + (size_t)row * 8 + 4 * fq); s4 = *(const f32x4*)(sn + (size_t)row * 8 + 4 * fq); }
                    const float rq = sec == 0 ? r * 0.18033688011112042f : r;
#pragma unroll
                    for (int bj = 0; bj < 2; ++bj) { const f32x4 x1 = acc[ai][bj][m][0] * rq, x2 = acc[ai][bj][m][1] * rq;
                        const f32x4 a = rope ? x1 * c4 - x2 * s4 : x1, b = rope ? x2 * c4 + x1 * s4 : x2;
                        u32x4 w; w.x = pk2(a[0], a[1]); w.y = pk2(a[2], a[3]); w.z = pk2(b[0], b[1]); w.w = pk2(b[2], b[3]);
                        *(u32x4*)(dst + (size_t)row * 512 + ((pn - 6) & 1) * 256 + bj * 128 + wc * 32 + 8 * fq) = w; }
                } else {
                    const f32x4 x1 = acc[ai][0][m][0] * r, x2 = acc[ai][0][m][1] * r;
                    if (wc < 2) { const bool rope = (wc == 0) && (fq < 2);
                        f32x4 c4 = {1.f, 1.f, 1.f, 1.f}, s4 = {0.f, 0.f, 0.f, 0.f};
                        if (rope) { c4 = *(const f32x4*)(cs + (size_t)row * 8 + 4 * fq); s4 = *(const f32x4*)(sn + (size_t)row * 8 + 4 * fq); }
                        const f32x4 a = rope ? x1 * c4 - x2 * s4 : x1, b = rope ? x2 * c4 + x1 * s4 : x2;
                        u32x4 w; w.x = pk2(a[0], a[1]); w.y = pk2(a[2], a[3]); w.z = pk2(b[0], b[1]); w.w = pk2(b[2], b[3]);
                        *(u32x4*)((bf16_t*)(mx + EV_KI) + (size_t)row * 64 + wc * 32 + 8 * fq) = w;
                    } else if (wc == 2 && fq == 0) { float* wi = (float*)(mx + EV_WI) + (size_t)row * 8; *(f32x4*)wi = x1; *(f32x4*)(wi + 4) = x2; }
                }
            } }
    }
};

__device__ __forceinline__ void ph_yconv(unsigned char* mx, const float* convw, int G, int bid) {
    const bf16_t* U = (const bf16_t*)(mx + EV_U); const bf16_t* Bb = (const bf16_t*)(mx + EV_B); bf16_t* Y = (bf16_t*)(mx + EV_Y);
    for (int it = bid * 512 + otid(); it < NTOK * 64; it += G * 512) { const int row = it >> 6, c = (it & 63) * 8, t = row & (SEQ - 1);
        float acc[8] = {0.f, 0.f, 0.f, 0.f, 0.f, 0.f, 0.f, 0.f};
#pragma unroll
        for (int j = 0; j < 3; ++j) if (t - 2 + j >= 0) { const u32x4 uv = *(const u32x4*)(U + (size_t)(row - 2 + j) * 512 + c);
            const f32x4 w0 = *(const f32x4*)(convw + j * 512 + c), w1 = *(const f32x4*)(convw + j * 512 + c + 4);
            acc[0] += w0[0] * __uint_as_float(uv.x << 16); acc[1] += w0[1] * __uint_as_float(uv.x & 0xffff0000u); acc[2] += w0[2] * __uint_as_float(uv.y << 16); acc[3] += w0[3] * __uint_as_float(uv.y & 0xffff0000u);
            acc[4] += w1[0] * __uint_as_float(uv.z << 16); acc[5] += w1[1] * __uint_as_float(uv.z & 0xffff0000u); acc[6] += w1[2] * __uint_as_float(uv.w << 16); acc[7] += w1[3] * __uint_as_float(uv.w & 0xffff0000u); }
        const u32x4 bv = *(const u32x4*)(Bb + (size_t)row * 512 + c);
        u32x4 w; w.x = pk2(acc[0] * __uint_as_float(bv.x << 16), acc[1] * __uint_as_float(bv.x & 0xffff0000u)); w.y = pk2(acc[2] * __uint_as_float(bv.y << 16), acc[3] * __uint_as_float(bv.y & 0xffff0000u));
        w.z = pk2(acc[4] * __uint_as_float(bv.z << 16), acc[5] * __uint_as_float(bv.z & 0xffff0000u)); w.w = pk2(acc[6] * __uint_as_float(bv.w << 16), acc[7] * __uint_as_float(bv.w & 0xffff0000u));
        *(u32x4*)(Y + (size_t)row * 1024 + c) = w; }
}

__device__ __forceinline__ int wave_excl_scan_i(int v, int lane) {
    int s = v;
#pragma unroll
    for (int o = 1; o < 64; o <<= 1) { const int t = __shfl_up(s, o); if (lane >= o) s += t; }
    return s - v;
}
__device__ __forceinline__ unsigned f16key2(float a, float b) {
    const unsigned x = __builtin_bit_cast(unsigned, __builtin_amdgcn_cvt_pkrtz(a, b));
    const unsigned s = (x >> 15) & 0x00010001u; return x ^ ((s * 0x7FFFu) | 0x80008000u);
}
typedef float f32x4c __attribute__((ext_vector_type(4)));
typedef unsigned short u16x2v __attribute__((ext_vector_type(2)));
__device__ __forceinline__ unsigned pk_sub16(unsigned a, unsigned b) { return __builtin_bit_cast(unsigned, (u16x2v)(__builtin_bit_cast(u16x2v, a) - __builtin_bit_cast(u16x2v, b))); }
__device__ __forceinline__ unsigned pk_add16(unsigned a, unsigned b) { return __builtin_bit_cast(unsigned, (u16x2v)(__builtin_bit_cast(u16x2v, a) + __builtin_bit_cast(u16x2v, b))); }
__device__ __forceinline__ unsigned pk_shr15(unsigned a) { return __builtin_bit_cast(unsigned, (u16x2v)(__builtin_bit_cast(u16x2v, a) >> (u16x2v){15, 15})); }
__device__ __forceinline__ unsigned pk_min16(unsigned a, unsigned b) { return __builtin_bit_cast(unsigned, __builtin_elementwise_min(__builtin_bit_cast(u16x2v, a), __builtin_bit_cast(u16x2v, b))); }
__device__ __forceinline__ void ph_ev_index(unsigned char* mx, int G, int bid) {
    const int tid = otid(), lane = tid & 63, wid = __builtin_amdgcn_readfirstlane(tid >> 6), n16 = lane & 15, g4 = lane >> 4;
    const bf16_t* Qi = (const bf16_t*)(mx + EV_QI); const bf16_t* Ki = (const bf16_t*)(mx + EV_KI); const float* Wi = (const float*)(mx + EV_WI);
    unsigned short* S16 = (unsigned short*)(mx + EV_S16) + (size_t)bid * 16 * 8192; unsigned* BM = (unsigned*)(mx + EV_BM);
    for (int p = bid; p < 256; p += G)
    for (int it = 0; it < 4; ++it) {
        const int b = it >> 1, grp = (it & 1) ? 511 - p : p, q0 = grp * 16, tokbase = b * SEQ;
        const int nt = (q0 + 16 + 63) >> 6;
#ifndef EVX_SC
#define EVX_SC 1
#define EVX_SEL 1
#define EVX_YC 1
#endif
        for (int rp_ = 0; rp_ < EVX_SC; ++rp_)
        {
            bf16x8 afA[4][2], afB[4][2];
#define EV_KP(tt) (Ki + (size_t)(tokbase + (tt) * 64 + 16 * (n16 >> 2) + (n16 & 3)) * 64 + g4 * 8)
#define EV_LDK(dst, tt) do { const bf16_t* kp_ = EV_KP(tt); \
                _Pragma("unroll") for (int mt = 0; mt < 4; ++mt) { dst[mt][0] = *(const bf16x8*)(kp_ + (size_t)(4 * mt) * 64); dst[mt][1] = *(const bf16x8*)(kp_ + (size_t)(4 * mt) * 64 + 32); } } while (0)
            const int ntl = nt;
            if (wid < ntl) EV_LDK(afB, wid);
            bf16x8 qf[8][2]; float wv[8];
            { const bf16_t* qp = Qi + (size_t)(tokbase + q0 + n16) * 512 + g4 * 8;
#pragma unroll
              for (int h = 0; h < 8; ++h) { qf[h][0] = *(const bf16x8*)(qp + h * 64); qf[h][1] = *(const bf16x8*)(qp + h * 64 + 32); }
              const f32x4 w0 = *(const f32x4*)(Wi + (size_t)(tokbase + q0 + n16) * 8), w1 = *(const f32x4*)(Wi + (size_t)(tokbase + q0 + n16) * 8 + 4);
              wv[0] = 0.5f * w0[0]; wv[1] = 0.5f * w0[1]; wv[2] = 0.5f * w0[2]; wv[3] = 0.5f * w0[3]; wv[4] = 0.5f * w1[0]; wv[5] = 0.5f * w1[1]; wv[6] = 0.5f * w1[2]; wv[7] = 0.5f * w1[3]; }
            bf16x8 qh[2], ql[2];
#pragma unroll
            for (int ks = 0; ks < 2; ++ks) { float cq[8];
#pragma unroll
                for (int j = 0; j < 8; ++j) { float a = 0.f;
#pragma unroll
                    for (int h = 0; h < 8; ++h) a += wv[h] * __uint_as_float(((unsigned)(unsigned short)qf[h][ks][j]) << 16);
                    cq[j] = a; }
                unsigned hw[4], lw4[4];
#pragma unroll
                for (int j = 0; j < 4; ++j) { hw[j] = pk2(cq[2 * j], cq[2 * j + 1]); lw4[j] = pk2(cq[2 * j] - __uint_as_float(hw[j] << 16), cq[2 * j + 1] - __uint_as_float(hw[j] & 0xffff0000u)); }
                qh[ks] = __builtin_bit_cast(bf16x8, (u32x4){hw[0], hw[1], hw[2], hw[3]}); ql[ks] = __builtin_bit_cast(bf16x8, (u32x4){lw4[0], lw4[1], lw4[2], lw4[3]}); }
#define EV_TILE(AF, AFN, tt) do { const int t_ = (tt), k0 = t_ * 64; EV_LDK(AFN, (t_ + 8 < ntl) ? t_ + 8 : t_); \
                unsigned kw[8]; \
                _Pragma("unroll") for (int mt = 0; mt < 4; ++mt) { \
                    f32x4c a[8], lh, ll; const f32x4c z4 = {0.f, 0.f, 0.f, 0.f}; \
                    _Pragma("unroll") for (int h = 0; h < 8; ++h) a[h] = __builtin_amdgcn_mfma_f32_16x16x32_bf16(AF[mt][0], qf[h][0], z4, 0, 0, 0); \
                    lh = __builtin_amdgcn_mfma_f32_16x16x32_bf16(AF[mt][0], qh[0], z4, 0, 0, 0); ll = __builtin_amdgcn_mfma_f32_16x16x32_bf16(AF[mt][0], ql[0], z4, 0, 0, 0); \
                    __builtin_amdgcn_sched_barrier(0); \
                    _Pragma("unroll") for (int h = 0; h < 8; ++h) a[h] = __builtin_amdgcn_mfma_f32_16x16x32_bf16(AF[mt][1], qf[h][1], a[h], 0, 0, 0); \
                    lh = __builtin_amdgcn_mfma_f32_16x16x32_bf16(AF[mt][1], qh[1], lh, 0, 0, 0); ll = __builtin_amdgcn_mfma_f32_16x16x32_bf16(AF[mt][1], ql[1], ll, 0, 0, 0); \
                    __builtin_amdgcn_sched_barrier(0); \
                    f32x4c sc; \
                    _Pragma("unroll") for (int r = 0; r < 4; ++r) sc[r] = __builtin_fabsf(a[0][r]) * wv[0]; \
                    _Pragma("unroll") for (int h = 1; h < 8; ++h) _Pragma("unroll") for (int r = 0; r < 4; ++r) sc[r] = __builtin_fmaf(__builtin_fabsf(a[h][r]), wv[h], sc[r]); \
                    _Pragma("unroll") for (int r = 0; r < 4; ++r) sc[r] += lh[r] + ll[r]; \
                    kw[2 * mt] = f16key2(sc[0], sc[1]); kw[2 * mt + 1] = f16key2(sc[2], sc[3]); \
                    if (k0 + 63 > q0) {     \
                        const int kb = k0 + 16 * g4 + 4 * mt, tq = q0 + n16; \
                        if (kb + 0 > tq) kw[2 * mt] &= 0xFFFF0000u; if (kb + 1 > tq) kw[2 * mt] &= 0x0000FFFFu; \
                        if (kb + 2 > tq) kw[2 * mt + 1] &= 0xFFFF0000u; if (kb + 3 > tq) kw[2 * mt + 1] &= 0x0000FFFFu; } \
                    __builtin_amdgcn_sched_barrier(0); } \
                unsigned short* dst = S16 + (size_t)n16 * 8192 + k0 + 16 * g4; \
                u32x4 s0, s1; s0.x = kw[0]; s0.y = kw[1]; s0.z = kw[2]; s0.w = kw[3]; s1.x = kw[4]; s1.y = kw[5]; s1.z = kw[6]; s1.w = kw[7]; \
                *(u32x4*)dst = s0; *(u32x4*)(dst + 8) = s1; } while (0)
            if (wid < ntl) {
                for (int t = wid; t < ntl; t += 8) {
#pragma unroll
                    for (int mt = 0; mt < 4; ++mt) { afA[mt][0] = afB[mt][0]; afA[mt][1] = afB[mt][1]; }
                    EV_TILE(afA, afB, t); } }
#undef EV_TILE
#undef EV_LDK
#undef EV_KP
        }
        asm volatile("s_waitcnt vmcnt(0)" ::: "memory"); __syncthreads();
        for (int rp_ = 0; rp_ < EVX_SEL; ++rp_)
        for (int rr = 0; rr < 2; ++rr) { const int row = 2 * wid + rr, t = q0 + row, n = t + 1;
            unsigned* bm = BM + (size_t)(tokbase + t) * 256;
            if (n <= 256) { if (lane < 8) { const int lo = lane * 32; bm[lane] = (n >= lo + 32) ? 0xFFFFFFFFu : (n > lo ? ((1u << (n - lo)) - 1u) : 0u); } }
            else {
                const int npad = nt * 64, jmax = (npad + 511) >> 9; const unsigned short* srow = S16 + (size_t)row * 8192;
                u32x4 x[16];
#pragma unroll
                for (int j = 0; j < 16; ++j) { x[j] = (u32x4){0u, 0u, 0u, 0u}; if (j < jmax) { const int c = 64 * j + lane; if (8 * c < npad) x[j] = *(const u32x4*)(srow + 8 * c); } }
                int cpos = 0;
#pragma unroll
                for (int j = 0; j < 16; ++j) if (j < jmax) {
#pragma unroll
                    for (int q = 0; q < 4; ++q) { const unsigned v = x[j][q]; cpos += (int)(v >> 31) + (int)((v >> 15) & 1u); } }
                cpos = wave_sum_i(cpos); const bool hi = cpos >= 256;
                u32x4 w[16];
#pragma unroll
                for (int j = 0; j < 16; ++j) { w[j] = (u32x4){0u, 0u, 0u, 0u}; if (j < jmax) {
#pragma unroll
                    for (int q = 0; q < 4; ++q) { const unsigned v = x[j][q]; if (hi) { const unsigned m = v & 0x80008000u; w[j][q] = v & (m - (m >> 15)); } else w[j][q] = pk_min16(v, 0x7FFF7FFFu); } } }
                const int ntot = jmax * 512; unsigned lo15 = 0u;
                for (int bit = 14; bit >= 0; --bit) { const unsigned c = lo15 | (1u << bit), c2 = c * 0x10001u; unsigned acc = 0u;
#pragma unroll
                    for (int j = 0; j < 16; ++j) if (j < jmax) {
#pragma unroll
                        for (int q = 0; q < 4; ++q) acc = pk_add16(acc, pk_shr15(pk_sub16(w[j][q], c2))); }
                    const int lt = wave_sum_i((int)((acc & 0xFFFFu) + (acc >> 16))); if (ntot - lt >= 256) lo15 = c; }
                const unsigned lo = hi ? (0x8000u | lo15) : lo15;
                const unsigned tau = lo; int cg = 0;
#pragma unroll
                for (int j = 0; j < 16; ++j) if (j < jmax) {
#pragma unroll
                    for (int q = 0; q < 4; ++q) { const unsigned v = x[j][q]; cg += ((v & 0xFFFFu) > tau ? 1 : 0) + ((v >> 16) > tau ? 1 : 0); } }
                const int need = 256 - wave_sum_i(cg); int R = 0;
#pragma unroll
                for (int j = 0; j < 16; ++j) if (j < jmax) {
                    int tc = 0;
#pragma unroll
                    for (int q = 0; q < 4; ++q) { const unsigned v = x[j][q]; tc += ((v & 0xFFFFu) == tau ? 1 : 0) + ((v >> 16) == tau ? 1 : 0); }
                    const int Tj = wave_sum_i(tc); int quota = (R + Tj <= need) ? tc : 0;
                    if (R < need && R + Tj > need) { const int P = wave_excl_scan_i(tc, lane); quota = min(max(need - R - P, 0), tc); }
                    R += Tj;
                    unsigned byte = 0u; int taken = 0;
#pragma unroll
                    for (int e = 0; e < 8; ++e) { const unsigned k = (e & 1) ? (x[j][e >> 1] >> 16) : (x[j][e >> 1] & 0xFFFFu);
                        bool s = k > tau; if (k == tau) { s = taken < quota; ++taken; } byte |= (s ? 1u : 0u) << e; }
                    unsigned w = byte << (8 * (lane & 3)); w |= (unsigned)dpp_i((int)w, 0xB1); w |= (unsigned)dpp_i((int)w, 0x4E);
                    if ((lane & 3) == 0) bm[(64 * j + lane) >> 2] = w; }
            }
        }
        __syncthreads();
    }
}

namespace at64 {
using bf16 = unsigned short;
using bf16x8 = __attribute__((ext_vector_type(8))) short;
using s16x4 = __attribute__((ext_vector_type(4))) short;
using f32x16 = __attribute__((ext_vector_type(16))) float;
using u32x4 = __attribute__((ext_vector_type(4))) unsigned;
constexpr int BATCH = 2, NHEAD = 8, SEQ = 8192, D = 64, DM = NHEAD * D, DMO = 1024, OCOL = 512;
#define ATTN64_THR 8
#define ATTN64_BROKEN 0
constexpr int NW = 8, QBLK = 32, QB = QBLK * NW, KVBLK = 64, NQB = SEQ / QB;
constexpr float C2 = 0.125f * 1.4426950408889634f;
constexpr int SLOTB = 8192, LDS_K = 0, LDS_V = 3 * SLOTB, LDS_WS = 6 * SLOTB, LDS_OST = LDS_WS + NW * 256, LDS_MSK = LDS_OST + NW * 4096, LDS_BYTES = LDS_MSK + NW * 2048;
#define SBAR() __builtin_amdgcn_sched_barrier(0)
#define PIN(x) asm volatile("" : "+v"(x))
#define MFMA(a, b, c) __builtin_amdgcn_mfma_f32_32x32x16_bf16(a, b, c, 0, 0, 0)
#define WAIT_BAR(N) asm volatile("s_waitcnt vmcnt(" #N ") lgkmcnt(0)\n\ts_barrier" ::: "memory")

__device__ __forceinline__ int crow(int r, int hi) { return (r & 3) + 8 * (r >> 2) + 4 * hi; }
__device__ __forceinline__ unsigned cvtpk(float lo, float hi) { unsigned r; asm("v_cvt_pk_bf16_f32 %0, %1, %2" : "=v"(r) : "v"(lo), "v"(hi)); return r; }
__device__ __forceinline__ void glds16(const void* g, unsigned lds_base) {
    unsigned sv; asm volatile("s_mov_b32 %0, m0\n\ts_mov_b32 m0, %2\n\ts_nop 0\n\tglobal_load_lds_dwordx4 %1, off\n\ts_mov_b32 m0, %0" : "=&s"(sv) : "v"(g), "s"(lds_base) : "memory"); }
typedef __attribute__((address_space(3))) const char* lds_cptr;
typedef short v4i16_t __attribute__((ext_vector_type(4)));
__device__ __forceinline__ void kload2(bf16x8* kf, lds_cptr kp, int d0) { kf[2 * d0] = *(const __attribute__((address_space(3))) bf16x8*)(kp + d0 * 2048); kf[2 * d0 + 1] = *(const __attribute__((address_space(3))) bf16x8*)(kp + d0 * 2048 + 512); }
__device__ __forceinline__ s16x4 vtr(lds_cptr p) { return __builtin_bit_cast(s16x4, __builtin_amdgcn_ds_read_tr16_b64_v4i16((__attribute__((address_space(3))) v4i16_t*)p)); }
#define MX3(a, b, c) __builtin_fmaxf(__builtin_fmaxf((a), (b)), (c))
__device__ __forceinline__ float rowmax(const f32x16& p0, const f32x16& p1) {
    float a = MX3(p0[0], p0[1], p1[0]), b = MX3(p0[2], p0[3], p1[1]); a = MX3(a, p1[2], p1[3]);
#pragma unroll
    for (int r = 4; r < 16; r += 4) { a = MX3(a, p0[r], p0[r + 1]); b = MX3(b, p0[r + 2], p0[r + 3]); a = MX3(a, p1[r], p1[r + 1]); b = MX3(b, p1[r + 2], p1[r + 3]); }
    float m = __builtin_fmaxf(a, b); auto rr = __builtin_amdgcn_permlane32_swap(__float_as_uint(m), __float_as_uint(m), false, false);
    return __builtin_fmaxf(__uint_as_float(rr[0]), __uint_as_float(rr[1])); }
__device__ __forceinline__ void cmask(f32x16& p0, f32x16& p1, int jb, int qrel, int hi) {
    const int kb = 64 * jb + 4 * hi;
#pragma unroll
    for (int r = 0; r < 16; ++r) { const int kv = kb + (r & 3) + 8 * (r >> 2); if (kv > qrel) p0[r] = -INFINITY; if (kv + 32 > qrel) p1[r] = -INFINITY; } }

__device__ __forceinline__ void attn64_unit(int b, int h, int qb, const bf16* Q, const bf16* __restrict__ K, const bf16* __restrict__ V, const unsigned* __restrict__ BM, bf16* O, char* lds) {
    int tid_ = threadIdx.x; asm volatile("" : "+v"(tid_)); const int tid = tid_, lane = tid & 63, r32 = lane & 31, hi = lane >> 5; const int wid = __builtin_amdgcn_readfirstlane(tid >> 6);
    const long rowbase = (long)b * SEQ; const int q0 = qb * QB, NT = (q0 + QB) / KVBLK;
    const bf16* Qw = Q + (rowbase + q0 + wid * QBLK) * DM + h * D;
    const unsigned lds0 = (unsigned)(uintptr_t)lds; float* wsf = (float*)(lds + LDS_WS) + wid * 64;
    const bf16* ksrc = K + rowbase * DM + h * D + (long)lane * DM + wid * 8;
    const bf16* vsrc = V + rowbase * DM + h * D + (long)(16 * (wid & 3) + (lane >> 2)) * DM + (wid >> 2) * 32 + (lane & 3) * 8;
    const unsigned kdst = lds0 + LDS_K + wid * 1024, vdst = lds0 + LDS_V + wid * 1024;
#define DMA_K(t, slot) glds16(ksrc + (long)(t) * KVBLK * DM, (unsigned)__builtin_amdgcn_readfirstlane(kdst + (slot)))
#define DMA_V(t, slot) glds16(vsrc + (long)(t) * KVBLK * DM, (unsigned)__builtin_amdgcn_readfirstlane(vdst + (slot)))
    const unsigned* msrc = BM + (size_t)(rowbase + q0 + wid * QBLK + r32) * 256;
    const unsigned mdst = lds0 + LDS_MSK + wid * 2048;
    const lds_cptr mrd = (lds_cptr)lds + LDS_MSK + wid * 2048 + r32 * 16;
#define DMA_M(c) glds16(msrc + (c) * 4, (unsigned)__builtin_amdgcn_readfirstlane(mdst + ((c) & 1) * 1024))
#define BMASK(P0, P1, t) do { const unsigned long long mw_ = *(const __attribute__((address_space(3))) unsigned long long*)(mrd + (((t) >> 1) & 1) * 1024 + ((t) & 1) * 8); \
        const unsigned w0_ = (unsigned)mw_ >> (4 * hi), w1_ = (unsigned)(mw_ >> 32) >> (4 * hi); \
        _Pragma("unroll") for (int r = 0; r < 16; ++r) { const int bp_ = (r & 3) + 8 * (r >> 2); \
            const unsigned m0_ = (unsigned)(((int)(w0_ << (31 - bp_))) >> 31), m1_ = (unsigned)(((int)(w1_ << (31 - bp_))) >> 31); \
            P0[r] = __uint_as_float((__float_as_uint(P0[r]) & m0_) | (0xFF800000u & ~m0_)); P1[r] = __uint_as_float((__float_as_uint(P1[r]) & m1_) | (0xFF800000u & ~m1_)); } } while (0)
    const lds_cptr vp0 = (lds_cptr)lds + LDS_V + ((lane >> 4) & 1) * 32 + (lane & 3) * 8 + (4 * hi + ((lane & 15) >> 2)) * 64;
    const lds_cptr kp0 = (lds_cptr)lds + LDS_K + hi * 1024 + r32 * 16;
    DMA_M(0);
    DMA_K(0, 0); DMA_V(0, 0); DMA_K(1, SLOTB);
    bf16x8 qr[4];
#pragma unroll
    for (int d0 = 0; d0 < 4; ++d0) qr[d0] = *reinterpret_cast<const bf16x8*>(&Qw[(long)r32 * DM + d0 * 16 + hi * 8]);
    float mhat = 0.f, l_reg = 0.f; f32x16 o[2]; o[0] = f32x16{}; o[1] = f32x16{};
    f32x16 zero16 = f32x16{}; PIN(zero16);
    const int qrel = wid * QBLK + r32; bool resc = false;
    f32x16 pA0, pA1, pB0, pB1; bf16x8 kf[8]; s16x4 vlo[8], vhi[8]; u32x4 pw0, pw1, pw2, pw3;
    int sl_prev = 0, sl_cur = 0, sl_next = SLOTB;
#define ROT() do { sl_prev = sl_cur; sl_cur = sl_next; sl_next = (sl_next == 2 * SLOTB) ? 0 : sl_next + SLOTB; } while (0)
#define EX(v) __builtin_amdgcn_exp2f(v)
#define RESC() do { if (resc && !ATTN64_BROKEN) { _Pragma("unroll") for (int d_ = 0; d_ < 2; ++d_) _Pragma("unroll") for (int r = 0; r < 16; ++r) o[d_][r] *= wsf[crow(r, hi)]; } } while (0)
    DMA_K(2, 2 * SLOTB);
    WAIT_BAR(3);
    _Pragma("unroll") for (int d0 = 0; d0 < 4; ++d0) kload2(kf, kp0, d0);
    pA0 = MFMA(kf[0], qr[0], zero16); pA1 = MFMA(kf[1], qr[0], zero16); pA0 = MFMA(kf[2], qr[1], pA0); pA1 = MFMA(kf[3], qr[1], pA1);
    pA0 = MFMA(kf[4], qr[2], pA0); pA1 = MFMA(kf[5], qr[2], pA1); pA0 = MFMA(kf[6], qr[3], pA0); pA1 = MFMA(kf[7], qr[3], pA1);
    if (NT == 4) cmask(pA0, pA1, 0, qrel, hi);
    BMASK(pA0, pA1, 0);
    { const float rm = rowmax(pA0, pA1); mhat = __builtin_fmaxf(rm, -200.f); const float nmh = -mhat;
#pragma unroll
      for (int r = 0; r < 16; ++r) { pA0[r] = EX(pA0[r] + nmh); pA1[r] = EX(pA1[r] + nmh); }
#pragma unroll
      for (int r = 0; r < 16; ++r) zero16[r] = nmh;
      PIN(zero16); }
    WAIT_BAR(0);
    DMA_K(3, 0); DMA_V(1, SLOTB); ROT();
    _Pragma("unroll") for (int d0 = 0; d0 < 4; ++d0) kload2(kf, kp0 + sl_cur, d0);
    WAIT_BAR(2);
#define PKW(P, i) cvtpk(P[i], P[i + 1])
#define PAF(k) __builtin_bit_cast(bf16x8, pw##k)
#define VFR(i) (bf16x8){vlo[i][0], vlo[i][1], vlo[i][2], vlo[i][3], vhi[i][0], vhi[i][1], vhi[i][2], vhi[i][3]}
#define VRD(i) do { vlo[i] = vtr(vp_ + (((i) >> 2) * 4096 + ((i) & 3) * 1024)); vhi[i] = vtr(vp_ + (((i) >> 2) * 4096 + ((i) & 3) * 1024 + 512)); } while (0)
#define KRD(G, d0) do { if (G) { kload2(kf, kp0 + sl_next, d0); SBAR(); } } while (0)
#define GAPA(MF, a0, a1, a2, a3, W0, W1, PW) do { MF; sacc += a0; sacc += a1; sacc += a2; sacc += a3; W0; W1; PIN(PW); PIN(sacc); SBAR(); } while (0)
#define GAPB(MF, X, i) do { MF; X[i] = EX(X[i]); X[i + 1] = EX(X[i + 1]); X[i + 2] = EX(X[i + 2]); X[i + 3] = EX(X[i + 3]); PIN(X); SBAR(); } while (0)
#define STEP(C0, C1, P0, P1, t, MASK, GK, GV, GL, GM) do { SBAR(); \
    const lds_cptr vp_ = vp0 + sl_prev; \
    VRD(0); SBAR(); float sacc = P0[0] + P0[1];                                                                                                       \
                    GAPA(C0 = MFMA(kf[0], qr[0], zero16), P0[2], P0[3], P0[4], P0[5],     pw0[0] = PKW(P0, 0),  pw0[1] = PKW(P0, 2),  pw0); \
    VRD(4); SBAR(); GAPA(C1 = MFMA(kf[1], qr[0], zero16), P0[6], P0[7], P0[8], P0[9],     pw0[2] = PKW(P0, 4),  pw0[3] = PKW(P0, 6),  pw0); \
    VRD(1); SBAR(); GAPA(C0 = MFMA(kf[2], qr[1], C0),    P0[10], P0[11], P0[12], P0[13], pw1[0] = PKW(P0, 8),  pw1[1] = PKW(P0, 10), pw1); \
    VRD(5); SBAR(); GAPA(C1 = MFMA(kf[3], qr[1], C1),    P0[14], P0[15], P1[0], P1[1],   pw1[2] = PKW(P0, 12), pw1[3] = PKW(P0, 14), pw1); \
    VRD(2); SBAR(); GAPA(C0 = MFMA(kf[4], qr[2], C0),    P1[2], P1[3], P1[4], P1[5],     pw2[0] = PKW(P1, 0),  pw2[1] = PKW(P1, 2),  pw2); \
    VRD(6); SBAR(); GAPA(C1 = MFMA(kf[5], qr[2], C1),    P1[6], P1[7], P1[8], P1[9],     pw2[2] = PKW(P1, 4),  pw2[3] = PKW(P1, 6),  pw2); \
    VRD(3); SBAR(); GAPA(C0 = MFMA(kf[6], qr[3], C0),    P1[10], P1[11], P1[12], P1[13], pw3[0] = PKW(P1, 8),  pw3[1] = PKW(P1, 10), pw3); \
    VRD(7); SBAR(); GAPA(C1 = MFMA(kf[7], qr[3], C1),    P1[14], P1[15], 0.f, 0.f,       pw3[2] = PKW(P1, 12), pw3[3] = PKW(P1, 14), pw3); \
    l_reg += sacc; \
    if (GM) DMA_M(((t) + 1) >> 1); if (GK) DMA_K((t) + 3, sl_cur); if (GV) DMA_V((t) + 1, sl_next);                                                       \
    if (MASK) cmask(C0, C1, (t) - (NT - 4), qrel, hi); BMASK(C0, C1, (t)); \
    { const float rm = rowmax(C0, C1); resc = false;                                                                       \
      if (__builtin_expect(__any(rm > (float)ATTN64_THR), 0)) { const float dl = __builtin_fmaxf(rm, 0.f); mhat += dl;     \
          const float f = __builtin_amdgcn_exp2f(-dl); l_reg *= f; if (hi == 0) wsf[r32] = f; resc = true; \
          _Pragma("unroll") for (int r = 0; r < 16; ++r) { C0[r] -= dl; C1[r] -= dl; zero16[r] = -mhat; } PIN(zero16); } } \
    SBAR(); \
    GAPB(o[0] = MFMA(PAF(0), VFR(0), o[0]), C0, 0);              GAPB(o[1] = MFMA(PAF(0), VFR(4), o[1]), C0, 4); \
    KRD(GL, 0); GAPB(o[0] = MFMA(PAF(1), VFR(1), o[0]), C0, 8);  KRD(GL, 1); GAPB(o[1] = MFMA(PAF(1), VFR(5), o[1]), C0, 12);                                     \
    KRD(GL, 2); GAPB(o[0] = MFMA(PAF(2), VFR(2), o[0]), C1, 0);  KRD(GL, 3); GAPB(o[1] = MFMA(PAF(2), VFR(6), o[1]), C1, 4); \
    GAPB(o[0] = MFMA(PAF(3), VFR(3), o[0]), C1, 8);              GAPB(o[1] = MFMA(PAF(3), VFR(7), o[1]), C1, 12); \
    } while (0)
    int t = 1;
    for (; t + 5 < NT; t += 2) {
        STEP(pB0, pB1, pA0, pA1, t, false, true, true, true, true);     WAIT_BAR(2); RESC(); ROT();
        STEP(pA0, pA1, pB0, pB1, t + 1, false, true, true, true, false); WAIT_BAR(2); RESC(); ROT();
    }
#define ENDW(tt) do { if ((tt) + 3 < NT) { WAIT_BAR(2); } else if ((tt) + 2 < NT) { WAIT_BAR(1); } else { WAIT_BAR(0); } } while (0)
    for (; t + 1 < NT; t += 2) {
        STEP(pB0, pB1, pA0, pA1, t, true, (t + 3 < NT), (t + 1 < NT), (t + 1 < NT), (t + 1 < NT));         ENDW(t);     RESC(); ROT();
        STEP(pA0, pA1, pB0, pB1, t + 1, true, (t + 4 < NT), (t + 2 < NT), (t + 2 < NT), false);     ENDW(t + 1); RESC(); ROT();
    }
    STEP(pB0, pB1, pA0, pA1, NT - 1, true, false, false, false, false); RESC();
    { float sacc = pB0[0] + pB0[1];
#pragma unroll
      for (int r = 2; r < 16; ++r) sacc += pB0[r];
#pragma unroll
      for (int r = 0; r < 16; ++r) sacc += pB1[r];
      l_reg += sacc;
      pw0 = (u32x4){PKW(pB0, 0), PKW(pB0, 2), PKW(pB0, 4), PKW(pB0, 6)}; pw1 = (u32x4){PKW(pB0, 8), PKW(pB0, 10), PKW(pB0, 12), PKW(pB0, 14)};
      pw2 = (u32x4){PKW(pB1, 0), PKW(pB1, 2), PKW(pB1, 4), PKW(pB1, 6)}; pw3 = (u32x4){PKW(pB1, 8), PKW(pB1, 10), PKW(pB1, 12), PKW(pB1, 14)};
      const lds_cptr vp_ = vp0 + sl_cur; _Pragma("unroll") for (int i = 0; i < 8; ++i) VRD(i);
      o[0] = MFMA(PAF(0), VFR(0), o[0]); o[1] = MFMA(PAF(0), VFR(4), o[1]); o[0] = MFMA(PAF(1), VFR(1), o[0]); o[1] = MFMA(PAF(1), VFR(5), o[1]);
      o[0] = MFMA(PAF(2), VFR(2), o[0]); o[1] = MFMA(PAF(2), VFR(6), o[1]); o[0] = MFMA(PAF(3), VFR(3), o[0]); o[1] = MFMA(PAF(3), VFR(7), o[1]); }
    { auto rr = __builtin_amdgcn_permlane32_swap(__float_as_uint(l_reg), __float_as_uint(l_reg), false, false); l_reg = __uint_as_float(rr[0]) + __uint_as_float(rr[1]); }
    if (hi == 0) wsf[32 + r32] = l_reg; asm volatile("s_waitcnt lgkmcnt(0)" ::: "memory");
    float rli[16];
#pragma unroll
    for (int r = 0; r < 16; ++r) rli[r] = __builtin_amdgcn_rcpf(wsf[32 + crow(r, hi)]);
    bf16* Ow = O + (rowbase + q0 + wid * QBLK) * DMO + OCOL + h * D; bf16* stg = (bf16*)(lds + LDS_OST) + wid * 2048;
#pragma unroll
    for (int r = 0; r < 16; ++r) { const int orow = crow(r, hi);
#pragma unroll
        for (int d0 = 0; d0 < 2; ++d0) stg[orow * 64 + d0 * 32 + r32] = (bf16)(cvtpk(o[d0][r] * rli[r], 0.f) & 0xffffu); }
    asm volatile("s_waitcnt lgkmcnt(0)" ::: "memory");
#pragma unroll
    for (int i = 0; i < 4; ++i) { const int row = i * 8 + (lane >> 3), ch = lane & 7; *(u32x4*)(Ow + (long)row * DMO + ch * 8) = *(const u32x4*)(stg + row * 64 + ch * 8); }
    asm volatile("s_waitcnt lgkmcnt(0)\n\ts_barrier" ::: "memory");
#undef DMA_K
#undef DMA_V
#undef DMA_M
#undef BMASK
#undef ROT
#undef EX
#undef RESC
#undef PKW
#undef PAF
#undef VFR
#undef VRD
#undef KRD
#undef ENDW
#undef GAPA
#undef GAPB
#undef STEP
}
#undef SBAR
#undef PIN
#undef MFMA
#undef WAIT_BAR
#undef MX3
}

constexpr size_t OD_PRE = 0, OD_SSN = 0, OD_Y = 64 * MB, OD_ZS = 96 * MB, OD_ITEMS = 128 * MB, OD_EG = 272 * MB, OD_EK = OD_EG + 512 * 1024, OD_DL = OD_EK + 512 * 1024;
constexpr int IT_WP = 0, IT_QP = 8192, IT_KT = 16384, IT_IN = 24576, IT_UT = 28672, IT_ELEMS = 36864;

struct EpiOdIn {
    static constexpr bool PERM = true, AFTER_DRAIN = false, RESID_LDS = false; static constexpr int KROT = 0;
    unsigned char* mx; const float* ss;
    __device__ __forceinline__ void operator()(const f32x4 (&acc)[2][2][4][2], const Unit& u, int wr, int wc, int fr, int fq) const {
        const int row0 = u.pm * 256 + wr * 64 + fr, pn = u.pn;
#pragma unroll
        for (int ai = 0; ai < 2; ++ai) { float rs[4]; rows_rstd4(ss, row0 + ai * 128, fr, fq, rs);
#pragma unroll
            for (int m = 0; m < 4; ++m) { const int row = row0 + ai * 128 + m * 16; const float r = rs[m];
#pragma unroll
                for (int bj = 0; bj < 2; ++bj) { f32x4 a = acc[ai][bj][m][0] * r, b = acc[ai][bj][m][1] * r;
                    if (pn >= 12) {
#pragma unroll
                        for (int j = 0; j < 4; ++j) { a[j] = silu_f(a[j]); b[j] = silu_f(b[j]); } }
                    u32x4 w; w.x = pk2(a[0], a[1]); w.y = pk2(a[2], a[3]); w.z = pk2(b[0], b[1]); w.w = pk2(b[2], b[3]);
                    if (pn < 12) *(u32x4*)((bf16_t*)(mx + OD_PRE) + (size_t)row * 3072 + pn * 256 + bj * 128 + wc * 32 + 8 * fq) = w;
                    else *(u32x4*)((bf16_t*)(mx + OD_ZS) + (size_t)row * 1024 + (pn - 12) * 256 + bj * 128 + wc * 32 + 8 * fq) = w; }
            } }
    }
};

typedef short s16x4v __attribute__((ext_vector_type(4)));
__device__ __forceinline__ bf16x8 tr_frag(LAS const unsigned char* p) {
    const s16x4v lo = __builtin_amdgcn_ds_read_tr16_b64_v4i16((LAS s16x4v*)p);
    const s16x4v hi = __builtin_amdgcn_ds_read_tr16_b64_v4i16((LAS s16x4v*)(p + 4 * 272));
    return (bf16x8){lo[0], lo[1], lo[2], lo[3], hi[0], hi[1], hi[2], hi[3]};
}
typedef float f32x4d __attribute__((ext_vector_type(4)));
typedef unsigned u32x2 __attribute__((ext_vector_type(2)));

constexpr int PL_Q = 0, PL_K = 17408, PL_V = 34816, PL_AM = 52224, PL_T1 = 69632, PL_T2 = 78848, PL_BA = 88064, PL_BETA = 96256, PL_GC = 98304, PL_CW = 100352, PL_END = 112640;

__device__ __forceinline__ void ph_od_prep(LAS unsigned char* lds, unsigned char* mx, const bf16_t* xb, const float* ss, const bf16_t* Wba, const float* convw, const float* a_log, const float* dt_bias, int G, int bid) {
    const int tid = otid(), lane = tid & 63, wid = __builtin_amdgcn_readfirstlane(tid >> 6), n16 = lane & 15, g4 = lane >> 4;
    const bf16_t* PRE = (const bf16_t*)(mx + OD_PRE); bf16_t* ITEMS = (bf16_t*)(mx + OD_ITEMS);
    float* EG = (float*)(mx + OD_EG); float* EK = (float*)(mx + OD_EK); float* DL = (float*)(mx + OD_DL);
    LAS float* BA = (LAS float*)(lds + PL_BA); LAS float* betaS = (LAS float*)(lds + PL_BETA); LAS float* gcS = (LAS float*)(lds + PL_GC);
    LAS float* Am = (LAS float*)(lds + PL_AM);
    for (int bc = bid; bc < 256; bc += G) { const int b = bc >> 7, c = bc & 127, t0 = b * SEQ + 64 * c;
        if (tid < 384) { const int i4 = tid * 4, js = i4 >> 7, ch = i4 & 127; *(LAS f32x4*)(lds + PL_CW + i4 * 4) = *(const f32x4*)(convw + (js / 3) * 3072 + (js % 3) * 1024 + ch); }
        { const int mt = wid & 3, kh = wid >> 2; f32x4d acc = {0.f, 0.f, 0.f, 0.f}, acc1 = {0.f, 0.f, 0.f, 0.f};
          const bf16_t* ap = xb + (size_t)(t0 + 16 * mt + n16) * DM + kh * 512 + g4 * 8; const bf16_t* bp = Wba + (size_t)n16 * DM + kh * 512 + g4 * 8;
          bf16x8 fa[16], fb[16];
#pragma unroll
          for (int ks = 0; ks < 16; ++ks) { fa[ks] = *(const bf16x8*)(ap + ks * 32); fb[ks] = *(const bf16x8*)(bp + ks * 32); }
#pragma unroll
          for (int ks = 0; ks < 16; ks += 2) { acc = __builtin_amdgcn_mfma_f32_16x16x32_bf16(fa[ks], fb[ks], acc, 0, 0, 0); acc1 = __builtin_amdgcn_mfma_f32_16x16x32_bf16(fa[ks + 1], fb[ks + 1], acc1, 0, 0, 0); }
          acc += acc1;
#pragma unroll
          for (int r = 0; r < 4; ++r) BA[(kh * 64 + 16 * mt + 4 * g4 + r) * 16 + n16] = acc[r]; }
        __syncthreads();
        { const int h = wid, tok = lane; const float rs = row_rstd(ss, t0 + tok);
          const float braw = (BA[tok * 16 + h] + BA[(64 + tok) * 16 + h]) * rs, araw = (BA[tok * 16 + 8 + h] + BA[(64 + tok) * 16 + 8 + h]) * rs;
          const float beta = 1.0f / (1.0f + expf(-braw)); const float xs = araw + dt_bias[h]; const float sp = fmaxf(xs, 0.f) + __logf(1.0f + __expf(-fabsf(xs)));
          float gc = -expf(a_log[h]) * sp;
#pragma unroll
          for (int o = 1; o < 64; o <<= 1) { const float t = __shfl_up(gc, o); if (lane >= o) gc += t; }
          const float gl = __shfl(gc, 63);
          betaS[h * 64 + tok] = beta; gcS[h * 64 + tok] = gc;
          const size_t so = (size_t)(b * 8 + h) * SEQ + 64 * c + tok; EG[so] = expf(gc); EK[so] = expf(gl - gc); if (lane == 0) DL[(b * 8 + h) * 128 + c] = expf(gl); }
        __syncthreads();
        for (int h = 0; h < 8; ++h) { bf16_t* itp = ITEMS + (size_t)((b * 8 + h) * 128 + c) * IT_ELEMS;
            const int tid = otid(), lane = tid & 63, n16 = lane & 15, g4 = lane >> 4;
            LAS const float* beta = betaS + h * 64; LAS const float* gc = gcS + h * 64;
#ifndef PRX_B1
#define PRX_B1 1
#define PRX_B2 1
#define PRX_B3 1
#define PRX_B4 1
#endif
            for (int rp1_ = 0; rp1_ < PRX_B1; ++rp1_)
            if (tid < 384) { const int sec = tid >> 7, tg = (tid >> 4) & 7, c8 = tid & 15, chn = sec * 1024 + h * 128 + 8 * c8;
                LAS const float* cw = (LAS const float*)(lds + PL_CW + (h & 1) * 6144) + sec * 128 + 8 * c8;
                u32x4 xr[11];
#pragma unroll
                for (int i = 0; i < 11; ++i) { const int tt = 64 * c + 8 * tg - 3 + i; xr[i] = *(const u32x4*)(PRE + (size_t)(b * SEQ + (tt >= 0 ? tt : 0)) * 3072 + chn); if (tt < 0) xr[i] = (u32x4){0u, 0u, 0u, 0u}; }
#pragma unroll
                for (int tt = 0; tt < 8; ++tt) { float acc[8];
#pragma unroll
                    for (int e = 0; e < 8; ++e) acc[e] = 0.f;
#pragma unroll
                    for (int j = 0; j < 4; ++j) { const u32x4 xv = xr[tt + j]; const f32x4 wl = *(LAS const f32x4*)(cw + j * 384), wh = *(LAS const f32x4*)(cw + j * 384 + 4);
                        acc[0] += wl[0] * __uint_as_float(xv.x << 16); acc[1] += wl[1] * __uint_as_float(xv.x & 0xffff0000u); acc[2] += wl[2] * __uint_as_float(xv.y << 16); acc[3] += wl[3] * __uint_as_float(xv.y & 0xffff0000u);
                        acc[4] += wh[0] * __uint_as_float(xv.z << 16); acc[5] += wh[1] * __uint_as_float(xv.z & 0xffff0000u); acc[6] += wh[2] * __uint_as_float(xv.w << 16); acc[7] += wh[3] * __uint_as_float(xv.w & 0xffff0000u); }
                    float sq = 0.f;
#pragma unroll
                    for (int e = 0; e < 8; ++e) { acc[e] = acc[e] * __builtin_amdgcn_rcpf(1.0f + __expf(-acc[e])); sq += acc[e] * acc[e]; }
                    if (sec < 2) { sq += dpp_f(sq, 0xB1); sq += dpp_f(sq, 0x4E); sq += dpp_f(sq, 0x141); sq += dpp_f(sq, 0x140);
                        const float sc = (1.0f / sqrtf(sq + EPS)) * (sec == 0 ? 0.08838834764831845f : 1.0f);
#pragma unroll
                        for (int e = 0; e < 8; ++e) acc[e] *= sc; }
                    const int tok = 8 * tg + tt; const unsigned p0 = pk2(acc[0], acc[1]), p1 = pk2(acc[2], acc[3]), p2 = pk2(acc[4], acc[5]), p3 = pk2(acc[6], acc[7]);
                    *(LAS u32x4*)(lds + (sec == 0 ? PL_Q : sec == 1 ? PL_K : PL_V) + tok * 272 + c8 * 16) = (u32x4){p0, p1, p2, p3};
                    if (sec == 0) { bf16_t* qd = itp + IT_QP + ((tok >> 4) * 4 + (c8 >> 2)) * 512 + ((2 * (c8 & 1)) * 16 + (tok & 15)) * 8 + 4 * ((c8 >> 1) & 1);
                        *(u32x2*)qd = (u32x2){p0, p1}; *(u32x2*)(qd + 128) = (u32x2){p2, p3}; }
                }
            } else { for (int i = tid - 384; i < 64 * 68; i += 128) Am[i] = 0.f; }
            if (h < 7 && tid < 384) { const int i4 = tid * 4, js = i4 >> 7, ch = i4 & 127; *(LAS f32x4*)(lds + PL_CW + ((h + 1) & 1) * 6144 + i4 * 4) = *(const f32x4*)(convw + (js / 3) * 3072 + (js % 3) * 1024 + (h + 1) * 128 + ch); }
            __syncthreads();
            for (int rp2_ = 0; rp2_ < PRX_B2; ++rp2_)
            for (int tk = wid; tk < 26; tk += 8) {
                if (tk >= 20) { const int z = tk - 20; const int it = z < 3 ? 0 : (z < 5 ? 1 : 2), jt = z < 3 ? z + 1 : (z < 5 ? z - 1 : 3);
                    *(u32x2*)(itp + IT_IN + (it * 2 + (jt >> 1)) * 512 + (g4 * 16 + n16) * 8 + 4 * (jt & 1)) = (u32x2){0u, 0u}; continue; }
                const int kind = tk >= 10, ix = kind ? tk - 10 : tk; const int it = ix < 1 ? 0 : (ix < 3 ? 1 : (ix < 6 ? 2 : 3)), jt = ix - (it * (it + 1)) / 2;
                f32x4d acc = {0.f, 0.f, 0.f, 0.f};
                if (!kind) {
#pragma unroll
                    for (int ks = 0; ks < 4; ++ks) acc = __builtin_amdgcn_mfma_f32_16x16x32_bf16(*(LAS const bf16x8*)(lds + PL_K + (16 * it + n16) * 272 + ks * 64 + g4 * 16), *(LAS const bf16x8*)(lds + PL_K + (16 * jt + n16) * 272 + ks * 64 + g4 * 16), acc, 0, 0, 0);
                    const int j = 16 * jt + n16; const float gj = gc[j];
#pragma unroll
                    for (int r = 0; r < 4; ++r) { const int i = 16 * it + 4 * g4 + r; Am[i * 68 + j] = (i > j) ? acc[r] * beta[i] * expf(gc[i] - gj) : 0.f; }
                } else {
#pragma unroll
                    for (int ks = 0; ks < 4; ++ks) acc = __builtin_amdgcn_mfma_f32_16x16x32_bf16(*(LAS const bf16x8*)(lds + PL_K + (16 * jt + n16) * 272 + ks * 64 + g4 * 16), *(LAS const bf16x8*)(lds + PL_Q + (16 * it + n16) * 272 + ks * 64 + g4 * 16), acc, 0, 0, 0);
                    const int i = 16 * it + n16; const float gi = gc[i]; float v[4];
#pragma unroll
                    for (int r = 0; r < 4; ++r) { const int j = 16 * jt + 4 * g4 + r; v[r] = (i >= j) ? acc[r] * expf(gi - gc[j]) : 0.f; }
                    *(u32x2*)(itp + IT_IN + (it * 2 + (jt >> 1)) * 512 + (g4 * 16 + n16) * 8 + 4 * (jt & 1)) = (u32x2){pk2(v[0], v[1]), pk2(v[2], v[3])};
                }
            }
            __syncthreads();
            for (int rp3_ = 0; rp3_ < PRX_B3; ++rp3_)
            { const int grp = wid < 4 ? wid : 11 - wid; const int cl = lane >> 3, p = lane & 7, ccol = 8 * grp + cl; float tj[8];
#pragma unroll
              for (int s8 = 0; s8 < 8; ++s8) tj[s8] = 0.f;
#pragma unroll
              for (int bi = 0; bi < 8; ++bi) { if (bi < grp) continue; f32x4 a0[8], a1[8];
#pragma unroll
                  for (int r = 0; r < 8; ++r) { a0[r] = *(LAS const f32x4*)(lds + PL_AM + (8 * bi + r) * 272 + p * 32); a1[r] = *(LAS const f32x4*)(lds + PL_AM + (8 * bi + r) * 272 + p * 32 + 16); }
                  float tn[8];
#pragma unroll
                  for (int r = 0; r < 8; ++r) { float sp = (a0[r][0] * tj[0] + a0[r][1] * tj[1]) + (a0[r][2] * tj[2] + a0[r][3] * tj[3]) + (a1[r][0] * tj[4] + a1[r][1] * tj[5]) + (a1[r][2] * tj[6] + a1[r][3] * tj[7]);
                      sp = sum8_f(sp);
                      float acc = ((8 * bi + r) == ccol ? 1.0f : 0.0f) - sp;
#pragma unroll
                      for (int q = 0; q < r; ++q) acc -= (q < 4 ? a0[r][q] : a1[r][q - 4]) * tn[q];
                      tn[r] = acc; }
                  if (p == bi) {
#pragma unroll
                      for (int r = 0; r < 8; ++r) tj[r] = tn[r]; } }
              const float bc1 = beta[ccol], bc2 = bc1 * expf(gc[ccol]);
#pragma unroll
              for (int s8 = 0; s8 < 8; ++s8) { const int j = 8 * p + s8;
                  *(LAS unsigned short*)(lds + PL_T1 + j * 144 + ccol * 2) = (unsigned short)(pk2(tj[s8] * bc1, 0.f) & 0xffffu);
                  *(LAS unsigned short*)(lds + PL_T2 + j * 144 + ccol * 2) = (unsigned short)(pk2(tj[s8] * bc2, 0.f) & 0xffffu); } }
            __syncthreads();
            for (int rp4_ = 0; rp4_ < PRX_B4; ++rp4_)
            { const int q4 = (lane & 15) >> 2, p4 = lane & 3;
              bf16x8 bv[2], ak[2];
#pragma unroll
              for (int ks = 0; ks < 2; ++ks) { bv[ks] = tr_frag(lds + PL_V + (32 * ks + 8 * g4 + q4) * 272 + (16 * wid + 4 * p4) * 2); ak[ks] = tr_frag(lds + PL_K + (32 * ks + 8 * g4 + q4) * 272 + (16 * wid + 4 * p4) * 2); }
#pragma unroll
              for (int it = 0; it < 4; ++it) { f32x4d au = {0.f, 0.f, 0.f, 0.f}, aw = {0.f, 0.f, 0.f, 0.f};
#pragma unroll
                  for (int ks = 0; ks < 2; ++ks) { au = __builtin_amdgcn_mfma_f32_16x16x32_bf16(*(LAS const bf16x8*)(lds + PL_T1 + (16 * it + n16) * 144 + ks * 64 + g4 * 16), bv[ks], au, 0, 0, 0);
                      aw = __builtin_amdgcn_mfma_f32_16x16x32_bf16(ak[ks], *(LAS const bf16x8*)(lds + PL_T2 + (16 * it + n16) * 144 + ks * 64 + g4 * 16), aw, 0, 0, 0); }
                  *(u32x2*)(itp + IT_UT + (16 * wid + n16) * 64 + 16 * it + 4 * g4) = (u32x2){pk2(au[0], au[1]), pk2(au[2], au[3])};
                  *(u32x2*)(itp + IT_WP + (it * 4 + (wid >> 1)) * 512 + (g4 * 16 + n16) * 8 + 4 * (wid & 1)) = (u32x2){pk2(aw[0], aw[1]), pk2(aw[2], aw[3])}; }
              { const int dk = tid >> 2, ksq = (tid >> 1) & 1, aq = tid & 1;
#pragma unroll
                for (int kq = 0; kq < 4; ++kq) { const int j0 = 32 * ksq + 16 * aq + 4 * kq; unsigned short e[4];
#pragma unroll
                    for (int r = 0; r < 4; ++r) e[r] = *(LAS const unsigned short*)(lds + PL_K + (j0 + r) * 272 + dk * 2);
                    *(u32x2*)(itp + IT_KT + ((dk >> 4) * 2 + ksq) * 512 + (kq * 16 + (dk & 15)) * 8 + 4 * aq) = (u32x2){(unsigned)e[0] | ((unsigned)e[1] << 16), (unsigned)e[2] | ((unsigned)e[3] << 16)}; } }
            }
            __syncthreads();
        }
    }
}

__device__ __forceinline__ void glds16(const void* g, unsigned lds_base) {
    unsigned sv; asm volatile("s_mov_b32 %0, m0\n\ts_mov_b32 m0, %2\n\ts_nop 0\n\tglobal_load_lds_dwordx4 %1, off\n\ts_mov_b32 m0, %0" : "=&s"(sv) : "v"(g), "s"(lds_base) : "memory"); }
__device__ __forceinline__ void glds4(const void* g, unsigned lds_base) {
    unsigned sv; asm volatile("s_mov_b32 %0, m0\n\ts_mov_b32 m0, %2\n\ts_nop 0\n\tglobal_load_lds_dword %1, off\n\ts_mov_b32 m0, %0" : "=&s"(sv) : "v"(g), "s"(lds_base) : "memory"); }
__device__ __forceinline__ void glds16s(const void* sbase, unsigned voff, unsigned lds_base) {
    unsigned sv; asm volatile("s_mov_b32 %0, m0\n\ts_mov_b32 m0, %3\n\ts_nop 0\n\tglobal_load_lds_dwordx4 %1, %2\n\ts_mov_b32 m0, %0" : "=&s"(sv) : "v"(voff), "s"(sbase), "s"(lds_base) : "memory"); }
constexpr int SC_BUF = 35840;
#ifndef SC_TOUCH_ON
#define SC_TOUCH_ON 0
#endif
#define SC_BAR() do { __builtin_amdgcn_s_barrier(); asm volatile("" ::: "memory"); } while (0)
#define SC_LBAR() do { asm volatile("s_waitcnt lgkmcnt(0)" ::: "memory"); __builtin_amdgcn_s_barrier(); asm volatile("" ::: "memory"); } while (0)
__device__ __forceinline__ void ph_od_scan(unsigned char* lds_generic, LAS unsigned char* lds, unsigned char* mx, unsigned* tickets, int& role_out, int G, int bid) {
    const int tid = otid(), lane = tid & 63, wid = __builtin_amdgcn_readfirstlane(tid >> 6), n16 = lane & 15, g4 = lane >> 4;
    bf16_t* ITEMS = (bf16_t*)(mx + OD_ITEMS); const float* EG = (const float*)(mx + OD_EG); const float* EK = (const float*)(mx + OD_EK); const float* DL = (const float*)(mx + OD_DL);
    unsigned char* SSN = mx + OD_SSN;
    const unsigned lds0 = (unsigned)(uintptr_t)lds_generic;
    const int wk0 = bid; role_out = bid;
    for (int wk = wk0; wk < 128; wk += G) { const int bh = (wk & 7) + 8 * (wk >> 6), slice = (wk >> 3) & 7, dv0 = slice * 16;
        bf16_t* item0 = ITEMS + (size_t)(bh * 128) * IT_ELEMS;
        if (wid >= 2 && wid <= 4) {
            const int lw = wid - 2; const unsigned lane16 = (unsigned)lane * 16u;
#define SC_LOAD(nn, dbase) do { const char* src_ = (const char*)(item0 + (size_t)(nn) * IT_ELEMS); const size_t so_ = (size_t)bh * SEQ + 64 * (nn); \
                const char* sb_ = src_ + lw * 1024; unsigned md_ = (unsigned)__builtin_amdgcn_readfirstlane((dbase) + lw * 1024); \
                _Pragma("unroll 1") for (int k_ = lw; k_ < 16; k_ += 3) { glds16s(sb_, lane16, md_); glds16s(sb_ + IT_KT * 2, lane16, md_ + 16384); sb_ += 3072; md_ += 3072; } \
                const char* g_ = lw == 1 ? (lane < 16 ? (const char*)(EG + so_ + lane * 4) : lane < 32 ? (const char*)(EK + so_ + (lane - 16) * 4) : lane == 32 ? (const char*)(DL + bh * 128 + ((nn) & ~3)) : (const char*)(EG + so_)) \
                                         : src_ + IT_UT * 2 + dv0 * 128 + (lw == 0 ? 1024 : 0) + lane * 16; \
                glds16(g_, (unsigned)__builtin_amdgcn_readfirstlane((dbase) + (lw == 0 ? 33 : lw == 1 ? 34 : 32) * 1024)); } while (0)
            SC_LOAD(0, lds0); SC_LOAD(1, lds0 + SC_BUF);
            if (lw == 0) asm volatile("s_waitcnt vmcnt(13)" ::: "memory"); else asm volatile("s_waitcnt vmcnt(11)" ::: "memory");
            SC_BAR();
#pragma unroll 1
            for (int n = 0; n < 128; ++n) {
                if (n + 2 < 128) { SC_LOAD(n + 2, lds0 + ((n + 2) % 3) * SC_BUF); if (lw == 0) asm volatile("s_waitcnt vmcnt(13)" ::: "memory"); else asm volatile("s_waitcnt vmcnt(11)" ::: "memory"); }
                else asm volatile("s_waitcnt vmcnt(0)" ::: "memory");
#ifdef SCX_LDELAY
                __builtin_amdgcn_s_sleep(15);
#endif
                SC_BAR();
            }
#undef SC_LOAD
        } else if (wid != 0) {
            SC_BAR();
#pragma unroll 1
            for (int n = 0; n < 128; ++n) SC_BAR();
        } else {
            f32x4d S[8];
#pragma unroll
            for (int mt = 0; mt < 8; ++mt) S[mt] = (f32x4d){0.f, 0.f, 0.f, 0.f};
            SC_BAR();
#pragma unroll 1
            for (int n = 0; n < 128; ++n) { LAS const unsigned char* buf = lds + (n % 3) * SC_BUF;
                bf16x8 wf[16];
#pragma unroll
                for (int f = 0; f < 16; ++f) wf[f] = *(LAS const bf16x8*)(buf + f * 1024 + lane * 16);
                const float dl = *(LAS const float*)(buf + 34 * 1024 + 512 + (n & 3) * 4); f32x4 ek[4]; u32x2 uu[4];
#pragma unroll
                for (int it = 0; it < 4; ++it) { ek[it] = *(LAS const f32x4*)(buf + 34 * 1024 + 256 + (16 * it + 4 * g4) * 4); uu[it] = *(LAS const u32x2*)(buf + 32 * 1024 + (n16 * 64 + 16 * it + 4 * g4) * 2); }
                __builtin_amdgcn_sched_barrier(0);
                bf16x8 sb[4]; unsigned char* ssn = SSN + ((size_t)(bh * 128 + n) * 8 + slice) * 4096 + lane * 16;
#pragma unroll
                for (int ks = 0; ks < 4; ++ks) { const unsigned a0 = pk2(S[2 * ks][0], S[2 * ks][1]), a1 = pk2(S[2 * ks][2], S[2 * ks][3]), a2 = pk2(S[2 * ks + 1][0], S[2 * ks + 1][1]), a3 = pk2(S[2 * ks + 1][2], S[2 * ks + 1][3]);
                    sb[ks] = __builtin_bit_cast(bf16x8, (u32x4){a0, a1, a2, a3}); *(bf16x8*)(ssn + ks * 1024) = sb[ks]; }
                asm volatile("s_waitcnt lgkmcnt(0)" ::: "memory"); __builtin_amdgcn_sched_barrier(0);
                bf16x8 kf[16];
#pragma unroll
                for (int f = 0; f < 16; ++f) kf[f] = *(LAS const bf16x8*)(buf + 16384 + f * 1024 + lane * 16);
                __builtin_amdgcn_sched_barrier(0);
                f32x4d aw[4];
#pragma unroll
                for (int it = 0; it < 4; ++it) aw[it] = (f32x4d){0.f, 0.f, 0.f, 0.f};
#pragma unroll
                for (int ks = 0; ks < 4; ++ks)
#pragma unroll
                    for (int it = 0; it < 4; ++it) aw[it] = __builtin_amdgcn_mfma_f32_16x16x32_bf16(wf[it * 4 + ks], sb[ks], aw[it], 0, 0, 0);
                f32x4d vn[4];
#pragma unroll
                for (int it = 0; it < 4; ++it) { vn[it][0] = __uint_as_float(uu[it].x << 16) - aw[it][0]; vn[it][1] = __uint_as_float(uu[it].x & 0xffff0000u) - aw[it][1]; vn[it][2] = __uint_as_float(uu[it].y << 16) - aw[it][2]; vn[it][3] = __uint_as_float(uu[it].y & 0xffff0000u) - aw[it][3]; }
                bf16x8 vk[2]; unsigned char* vdst = (unsigned char*)(item0 + (size_t)n * IT_ELEMS) + IT_UT * 2 + dv0 * 128 + lane * 16;
#pragma unroll
                for (int ks = 0; ks < 2; ++ks) { const f32x4d x0 = vn[2 * ks], x1 = vn[2 * ks + 1], y0 = x0 * ek[2 * ks], y1 = x1 * ek[2 * ks + 1];
                    *(bf16x8*)(vdst + ks * 1024) = __builtin_bit_cast(bf16x8, (u32x4){pk2(x0[0], x0[1]), pk2(x0[2], x0[3]), pk2(x1[0], x1[1]), pk2(x1[2], x1[3])});
                    vk[ks] = __builtin_bit_cast(bf16x8, (u32x4){pk2(y0[0], y0[1]), pk2(y0[2], y0[3]), pk2(y1[0], y1[1]), pk2(y1[2], y1[3])}); }
#pragma unroll
                for (int mt = 0; mt < 8; ++mt) S[mt] = S[mt] * dl;
                asm volatile("s_waitcnt lgkmcnt(0)" ::: "memory"); __builtin_amdgcn_sched_barrier(0);
#pragma unroll
                for (int ks = 0; ks < 2; ++ks)
#pragma unroll
                    for (int mt = 0; mt < 8; ++mt) S[mt] = __builtin_amdgcn_mfma_f32_16x16x32_bf16(kf[mt * 2 + ks], vk[ks], S[mt], 0, 0, 0);
#ifdef SCX_ADELAY
                __builtin_amdgcn_s_sleep(15);
#endif
                SC_LBAR();
            }
        }
        __syncthreads();
    }
}
#undef SC_BAR
#undef SC_LBAR

constexpr int OL_QP = 0, OL_IN = 16384, OL_RED = 24576, OL_RS = 26624, OL_T = 27136;
__device__ __forceinline__ void ph_od_out(LAS unsigned char* lds, unsigned char* mx, const float* o_gain, int G, int bid) {
    const int tid = otid(), lane = tid & 63, wid = __builtin_amdgcn_readfirstlane(tid >> 6), n16 = lane & 15, g4 = lane >> 4;
    const bf16_t* ITEMS = (const bf16_t*)(mx + OD_ITEMS); const float* EG = (const float*)(mx + OD_EG); const unsigned char* SSN = mx + OD_SSN;
    const bf16_t* ZS = (const bf16_t*)(mx + OD_ZS); bf16_t* Y = (bf16_t*)(mx + OD_Y);
    LAS float* red = (LAS float*)(lds + OL_RED); LAS float* rsv = (LAS float*)(lds + OL_RS);
    for (int item = bid; item < 2048; item += G) { const int bh = item >> 7, c = item & 127, b = bh >> 3, h = bh & 7;
        const unsigned char* itb = (const unsigned char*)(ITEMS + (size_t)item * IT_ELEMS);
        u32x4 st[3];
#pragma unroll
        for (int i = 0; i < 3; ++i) { const int piece = tid + 512 * i; st[i] = *(const u32x4*)(itb + (piece < 1024 ? IT_QP * 2 + piece * 16 : IT_IN * 2 + (piece - 1024) * 16)); }
        bf16x8 sb[4], vb[2]; f32x4 eg[4];
#pragma unroll
        for (int ks = 0; ks < 4; ++ks) sb[ks] = *(const bf16x8*)(SSN + ((size_t)item * 8 + wid) * 4096 + ks * 1024 + lane * 16);
#pragma unroll
        for (int ks = 0; ks < 2; ++ks) vb[ks] = *(const bf16x8*)(itb + IT_UT * 2 + wid * 2048 + ks * 1024 + lane * 16);
#pragma unroll
        for (int it = 0; it < 4; ++it) eg[it] = *(const f32x4*)(EG + (size_t)bh * SEQ + 64 * c + 16 * it + 4 * g4);
#pragma unroll
        for (int i = 0; i < 3; ++i) *(LAS u32x4*)(lds + (tid + 512 * i) * 16) = st[i];
        __syncthreads();
        f32x4d o[4];
        { bf16x8 qf[16], nf[8];
#pragma unroll
          for (int f = 0; f < 16; ++f) qf[f] = *(LAS const bf16x8*)(lds + OL_QP + f * 1024 + lane * 16);
#pragma unroll
          for (int f = 0; f < 8; ++f) nf[f] = *(LAS const bf16x8*)(lds + OL_IN + f * 1024 + lane * 16);
          asm volatile("s_waitcnt lgkmcnt(0)" ::: "memory"); __builtin_amdgcn_sched_barrier(0);
          f32x4d aq[4];
#pragma unroll
          for (int it = 0; it < 4; ++it) aq[it] = (f32x4d){0.f, 0.f, 0.f, 0.f};
#pragma unroll
          for (int ks = 0; ks < 4; ++ks)
#pragma unroll
              for (int it = 0; it < 4; ++it) aq[it] = __builtin_amdgcn_mfma_f32_16x16x32_bf16(qf[it * 4 + ks], sb[ks], aq[it], 0, 0, 0);
#pragma unroll
          for (int it = 0; it < 4; ++it) o[it] = aq[it] * eg[it];
#pragma unroll
          for (int ks = 0; ks < 2; ++ks)
#pragma unroll
              for (int it = 0; it < 4; ++it) o[it] = __builtin_amdgcn_mfma_f32_16x16x32_bf16(nf[it * 2 + ks], vb[ks], o[it], 0, 0, 0); }
#pragma unroll
        for (int it = 0; it < 4; ++it)
#pragma unroll
            for (int r = 0; r < 4; ++r) { float q = o[it][r] * o[it][r]; q += dpp_f(q, 0xB1); q += dpp_f(q, 0x4E); q += dpp_f(q, 0x141); q += dpp_f(q, 0x140);
                if (n16 == 0) red[wid * 64 + 16 * it + 4 * g4 + r] = q; }
        __syncthreads();
        if (tid < 64) { float tot = 0.f;
#pragma unroll
            for (int w = 0; w < 8; ++w) tot += red[w * 64 + tid];
            rsv[tid] = 1.0f / sqrtf(tot * (1.0f / 128.0f) + EPS); }
        __syncthreads();
        { const float gn = o_gain[16 * wid + n16];
#pragma unroll
          for (int it = 0; it < 4; ++it) { const f32x4 rs4 = *(LAS const f32x4*)(rsv + 16 * it + 4 * g4);
#pragma unroll
              for (int r = 0; r < 4; ++r) *(LAS unsigned short*)(lds + OL_T + (16 * it + 4 * g4 + r) * 272 + (16 * wid + n16) * 2) = (unsigned short)(pk2(o[it][r] * rs4[r] * gn, 0.f) & 0xffffu); } }
        __syncthreads();
        { const int tok = tid >> 3, dg = tid & 7; const size_t ro = (size_t)(b * SEQ + 64 * c + tok) * 1024 + h * 128 + dg * 16;
          const u32x4 t0 = *(LAS const u32x4*)(lds + OL_T + tok * 272 + dg * 32), t1 = *(LAS const u32x4*)(lds + OL_T + tok * 272 + dg * 32 + 16);
          const u32x4 z0 = *(const u32x4*)(ZS + ro), z1 = *(const u32x4*)(ZS + ro + 8);
          u32x4 w0, w1;
#define OD_MUL2(t, z) pk2(__uint_as_float((t) << 16) * __uint_as_float((z) << 16), __uint_as_float((t) & 0xffff0000u) * __uint_as_float((z) & 0xffff0000u))
          w0.x = OD_MUL2(t0.x, z0.x); w0.y = OD_MUL2(t0.y, z0.y); w0.z = OD_MUL2(t0.z, z0.z); w0.w = OD_MUL2(t0.w, z0.w);
          w1.x = OD_MUL2(t1.x, z1.x); w1.y = OD_MUL2(t1.y, z1.y); w1.z = OD_MUL2(t1.z, z1.z); w1.w = OD_MUL2(t1.w, z1.w);
#undef OD_MUL2
          *(u32x4*)(Y + ro) = w0; *(u32x4*)(Y + ro + 8) = w1; }
        __syncthreads();
    }
}

constexpr int LDS_BYTES = 147456;
constexpr int MISC_OFF = 146432;

__global__ void __launch_bounds__(512, 2) mk_fwd(Args a) {
    extern __shared__ __attribute__((aligned(16))) unsigned char lds_raw[];
    LAS unsigned char* lds = (LAS unsigned char*)lds_raw;
    const int G = gridDim.x, bid = blockIdx.x;
    unsigned char* ws = a.ws;
    float* ss = (float*)(ws + WS_SS); float* cs = (float*)(ws + WS_ROPE); float* sn = cs + NTOK * 8;
    bf16_t* xb = (bf16_t*)(ws + WS_XB);
    const Args& P = a;
    const int lo = a.ph_lo, hi = a.ph_hi; int pc = 0;
    int vcu = bid; bool locok = false;
#if MK_ONE_LAUNCH
    LAS unsigned* misc = (LAS unsigned*)(lds + MISC_OFF);
    if (threadIdx.x < 4) misc[threadIdx.x] = 0u;
    __syncthreads();
    XcdBarrier bar = xcd_barrier_post((unsigned*)(ws + WS_BAR), (volatile LAS unsigned*)misc);
    if (threadIdx.x == 0) { const unsigned r = xb_add((unsigned*)(ws + WS_BAR) + 8 + (bar.x & 15u), 1u); misc[16] = (bar.x & 15u) + 8u * r; }
#define GRID_BAR() xcd_barrier(bar)
#else
#define GRID_BAR() do { } while (0)
#endif
#ifndef PROBE_PC
#define PROBE_PC -1
#define PROBE_REP 0
#endif
#ifndef GX_NT
#define GX_NT 0
#endif
#ifndef GX_KZ
#define GX_KZ 0
#endif
#define PH_BEGIN if (pc >= lo && pc < hi) { const int nrep_ = (PROBE_PC >= 0 && pc == PROBE_PC) ? 1 + PROBE_REP : 1; for (int rep_ = 0; rep_ < nrep_; ++rep_) { if (rep_) GRID_BAR();
#define PH_END   } if (pc + 1 < hi) GRID_BAR(); } ++pc;
#define PH_END_L PH_END_C(true)
#define PH_END_C(c) } if (pc + 1 < hi) xcd_barrier(bar, locok && (c)); } ++pc;

    PH_BEGIN
        ph_xprep(a.in[0], xb, ss, G, bid);
        ph_rope((const int*)a.in[1], cs, sn, G, bid);
        if (bid == 0 && threadIdx.x < 32) ((unsigned*)(ws + WS_TICK))[threadIdx.x] = 0u;
        convert_layer((LAS float*)lds, P, ws, 0, bid, G);
#ifdef PRX_CV
        for (int q_ = 0; q_ < PRX_CV; ++q_) convert_layer((LAS float*)lds, P, ws, 0, bid, G);
#endif
    PH_END
#if MK_ONE_LAUNCH
    if (lo == 0 && hi > 1 && G == 256) {
        if (threadIdx.x == 0) { unsigned ok = 1u;
            for (unsigned j = 0; j < 16; ++j) { const unsigned c = xb_ld((unsigned*)(ws + WS_BAR) + XB_XCNT(j)); ok &= (c == (j < 8u ? 32u : 0u)) ? 1u : 0u; }
            misc[17] = (ok && misc[16] < 256u) ? 1u : 0u; }
        __syncthreads();
        locok = __builtin_amdgcn_readfirstlane((int)misc[17]) != 0; if (locok) vcu = __builtin_amdgcn_readfirstlane((int)misc[16]); }
#endif
    for (int s = 0; s < 8; ++s) {
        const int l = s >> 1; unsigned char* wr = ws + WS_W + (size_t)(l & 1) * WREG;
        bf16_t* H = (bf16_t*)(ws + WS_MIX + ((l & 1) ? (size_t)128 * MB : ((s & 1) ? (size_t)0 : (size_t)100 * MB)));
        PH_BEGIN
            pg8::Gemm g{xb, (const bf16_t*)(wr + ((s & 1) ? WO_GU1 : WO_GU0)), NTOK, 2 * DFF, DM}; pg8::StaticOrder S; S.init(NTOK, 2 * DFF, G, vcu);
            EpiGateUp E{H, ss};
            pg8::gemm_phase<EpiGateUp, pg8::StaticOrder, true, true>(lds, g, S, E);
            if (l < 3 && !(l & 1) && G == 256 && vcu >= 128) { __syncthreads(); convert_layer((LAS float*)lds, P, ws, l + 1, (s & 1) + 2 * (vcu - 128), 256); }
        PH_END_L
        PH_BEGIN
            pg8::Gemm g{H, (const bf16_t*)(wr + ((s & 1) ? WO_D1 : WO_D0)), NTOK, DM, DFF, rep_ ? GX_NT : 0, rep_ ? GX_KZ : 0}; pg8::StaticOrder S; S.init(NTOK, DM, G, vcu);
            EpiResid E{xb, ss, rep_ ? 0.f : 0.5f};
            pg8::gemm_phase<EpiResid, pg8::StaticOrder, false, true>(lds, g, S, E);
            if ((s & 1) && l < 3 && G != 256) { __syncthreads(); convert_layer((LAS float*)lds, P, ws, l + 1, bid, G); }
        PH_END_C(!(s & 1))
        if (!(s & 1)) {
            unsigned char* mx = ws + WS_MIX;
            if (!(l & 1)) {
                PH_BEGIN
                    pg8::Gemm g{xb, (const bf16_t*)(wr + WO_MIN), NTOK, 3840, DM}; pg8::StaticOrder S; S.init(NTOK, 3840, G, vcu);
                    EpiEvIn E{mx, ss, cs, sn};
                    pg8::gemm_phase<EpiEvIn, pg8::StaticOrder, true, true>(lds, g, S, E);
                PH_END
                PH_BEGIN
                    for (int rp_ = 0; rp_ < EVX_YC; ++rp_) ph_yconv(mx, a.in[7] + (size_t)(l >> 1) * 3 * 512, G, bid);
                    ph_ev_index(mx, G, bid);
                PH_END
                PH_BEGIN
                    for (int p = bid; p < 256; p += G) { const int x8 = p & 7, kk = p >> 3, bh = x8 + 8 * (kk >> 4), j = kk & 15;
                        at64::attn64_unit(bh >> 3, bh & 7, j, (const bf16_t*)(mx + EV_Q), (const bf16_t*)(mx + EV_K), (const bf16_t*)(mx + EV_V), (const unsigned*)(mx + EV_BM), (bf16_t*)(mx + EV_Y), (char*)lds_raw);
                        at64::attn64_unit(bh >> 3, bh & 7, 31 - j, (const bf16_t*)(mx + EV_Q), (const bf16_t*)(mx + EV_K), (const bf16_t*)(mx + EV_V), (const unsigned*)(mx + EV_BM), (bf16_t*)(mx + EV_Y), (char*)lds_raw); }
                PH_END
                PH_BEGIN
                    pg8::Gemm g{(const bf16_t*)(mx + EV_Y), (const bf16_t*)(wr + WO_MOUT), NTOK, DM, DM, rep_ ? GX_NT : 0, rep_ ? GX_KZ : 0}; pg8::StaticOrder S; S.init(NTOK, DM, G, vcu);
                    EpiResid E{xb, ss, rep_ ? 0.f : 1.0f};
                    pg8::gemm_phase<EpiResid, pg8::StaticOrder, false, true>(lds, g, S, E);
                PH_END_L
            } else {
                const int io = l >> 1;
                PH_BEGIN
                    pg8::Gemm g{xb, (const bf16_t*)(wr + WO_MIN), NTOK, 4096, DM}; pg8::StaticOrder S; S.init(NTOK, 4096, G, vcu);
                    EpiOdIn E{mx, ss};
                    pg8::gemm_phase<EpiOdIn, pg8::StaticOrder, true, true>(lds, g, S, E);
                PH_END
                PH_BEGIN
                    ph_od_prep(lds, mx, xb, ss, (const bf16_t*)(wr + WO_BA), a.in[10] + (size_t)io * 4 * 3072, a.in[11] + io * 8, a.in[12] + io * 8, G, bid);
                PH_END
                PH_BEGIN
                    int role = bid; ph_od_scan(lds_raw, lds, mx, (unsigned*)(ws + WS_TICK) + (l >> 1) * 16, role, G, bid);
                    if (l < 3 && G == 256 && role >= 128) convert_layer((LAS float*)lds, P, ws, l + 1, role - 128, 128);
                PH_END
                PH_BEGIN
                    ph_od_out(lds, mx, a.in[13] + io * 128, G, bid);
                PH_END
                PH_BEGIN
                    pg8::Gemm g{(const bf16_t*)(mx + OD_Y), (const bf16_t*)(wr + WO_MOUT), NTOK, DM, DM}; pg8::StaticOrder S; S.init(NTOK, DM, G, vcu);
                    EpiResid E{xb, ss, rep_ ? 0.f : 1.0f};
                    pg8::gemm_phase<EpiResid, pg8::StaticOrder, false, true>(lds, g, S, E);
                PH_END_L
            }
        }
    }
#ifdef BARX
    for (int q_ = 0; q_ < BARX; ++q_) GRID_BAR();
#endif
    PH_BEGIN
        const float* fg = a.in[15]; const int tid = otid(), wid = tid >> 6, lane = tid & 63;
        for (int row = bid * 8 + wid; row < NTOK; row += G * 8) { const float r = row_rstd(ss, row); float* orow = a.out + (size_t)row * DM;
#pragma unroll
            for (int q = 0; q < 2; ++q) { const int c = q * 512 + lane * 8; const u32x4 xv = *(const u32x4*)(xb + (size_t)row * DM + c); const f32x4 g0 = *(const f32x4*)(fg + c), g1 = *(const f32x4*)(fg + c + 4);
                f32x4 v0, v1; v0[0] = __uint_as_float(xv.x << 16); v0[1] = __uint_as_float(xv.x & 0xffff0000u); v0[2] = __uint_as_float(xv.y << 16); v0[3] = __uint_as_float(xv.y & 0xffff0000u);
                v1[0] = __uint_as_float(xv.z << 16); v1[1] = __uint_as_float(xv.z & 0xffff0000u); v1[2] = __uint_as_float(xv.w << 16); v1[3] = __uint_as_float(xv.w & 0xffff0000u);
                *(f32x4*)(orow + c) = v0 * r * g0; *(f32x4*)(orow + c + 4) = v1 * r * g1; } }
    PH_END
}
}

#ifndef MK_SPLIT
#define MK_SPLIT 0
#endif
static void launch_phases(const mk::Args& base, int lo, int hi, int grid, hipStream_t st) {
    mk::Args a = base; a.ph_lo = lo; a.ph_hi = hi;
    if (hi - lo > 1) (void)hipMemsetAsync(base.ws + mk::WS_BAR, 0, XCD_BAR_WORDS * sizeof(unsigned), st);
    hipLaunchKernelGGL(mk::mk_fwd, dim3(grid), dim3(512), mk::LDS_BYTES, st, a);
}
constexpr int N_PHASES = 1 + 8 * 2 + 2 * 4 + 2 * 5 + 1;

extern "C" void kernel_launch(void* const* d_in, const int* in_sizes, int n_in, void* d_out, int out_size, void* d_ws, size_t ws_size, hipStream_t stream) {
    static int grid = 0;
    if (grid == 0) {
        int dev = 0, cus = 0;
        if (hipGetDevice(&dev) != hipSuccess || hipDeviceGetAttribute(&cus, hipDeviceAttributeMultiprocessorCount, dev) != hipSuccess) { grid = -1; return; }
        if (hipFuncSetAttribute((const void*)mk::mk_fwd, hipFuncAttributeMaxDynamicSharedMemorySize, mk::LDS_BYTES) != hipSuccess) { grid = -1; return; }
        if (cus < 256) { fprintf(stderr, "kernel_launch: needs 256 compute units (one output tile per workgroup in the residual GEMM phases), found %d\n", cus); grid = -1; return; }
        grid = cus;
        if (ws_size < (size_t)404 * mk::MB || n_in != 16) { fprintf(stderr, "kernel_launch: unexpected workspace/inputs: %zu %d\n", ws_size, n_in); grid = -1; return; }
    }
    if (grid < 0) return;
    mk::Args a{}; for (int i = 0; i < 16; ++i) a.in[i] = (const float*)d_in[i];
    a.out = (float*)d_out; a.ws = (unsigned char*)d_ws;
#if MK_SPLIT
    for (int p = 0; p < N_PHASES; ++p) launch_phases(a, p, p + 1, grid, stream);
#else
    launch_phases(a, 0, N_PHASES, grid, stream);
#endif
}
```

```cpp
#include <hip/hip_runtime.h>
#include <stdint.h>
#include <cstdio>
#ifndef MK_ONE_LAUNCH
#define MK_ONE_LAUNCH 1
#endif
#ifndef MK_VCU
#define MK_VCU 0
#endif
#define LAS __attribute__((address_space(3)))
namespace pg8 {
#define PG8_LAS __attribute__((address_space(3)))
typedef unsigned short bf16_t;
typedef short bf16x8 __attribute__((ext_vector_type(8)));
typedef float f32x4 __attribute__((ext_vector_type(4)));
typedef unsigned u32x4 __attribute__((ext_vector_type(4)));
constexpr int BM = 256, BK = 64, HALF = 128, HTB = HALF * BK * 2  , STAGE_BYTES = 8 * HTB, NXCD = 8, WGM = 8;

__host__ __device__ __forceinline__ int lds_byte(int r, int c) { const int st = (r >> 4) * 2 + (c >> 5), rr = r & 15, cc = c & 31, ob = rr * 64 + cc * 2; return st * 1024 + (ob ^ (((ob >> 9) & 1) << 5)); }
__host__ __device__ __forceinline__ void stage_rc(int b, int& R, int& C) { const int st = b / 1024, sb = b % 1024, swz = sb ^ (((sb >> 9) & 1) << 5); R = (st >> 1) * 16 + swz / 64; C = (st & 1) * 32 + (swz % 64) / 2; }
__host__ __device__ __forceinline__ int perm32(int rho) { const int n = rho >> 4, i = rho & 15; return 8 * (i >> 2) + 4 * n + (i & 3); }

struct Unit { int pm, pn; };
struct Gemm { const bf16_t* A; const bf16_t* Bt; int M, N, K; int ntov; int kz; int atile; };

struct StaticOrder {
    int nM, nN, nwg, G, c;
    __host__ __device__ void init(int M, int N, int G_, int c_) { nM = M / BM; nN = N / BM; nwg = nM * nN; G = G_; c = c_; }
    __host__ __device__ bool next(int i, Unit& u) const {
        const long L = (long)i * G + c; if (L >= nwg) return false;
        int wgid = (int)L; { const int q = nwg / NXCD, r = nwg % NXCD, xcd = wgid % NXCD, off = wgid / NXCD; wgid = (xcd < r ? xcd * (q + 1) : r * (q + 1) + (xcd - r) * q) + off; }
        const int nig = WGM * nN, gid = wgid / nig, fm = gid * WGM, gsz = (nM - fm) < WGM ? (nM - fm) : WGM;
        u.pm = fm + ((wgid % nig) % gsz); u.pn = (wgid % nig) / gsz; return true;
    }
    __device__ __forceinline__ void a_ready(const Unit&) const {}
    __device__ __forceinline__ void done(const Unit&) const {}
};__device__ __forceinline__ unsigned cvt_pk_bf16(float lo, float hi) { unsigned r; asm volatile("v_cvt_pk_bf16_f32 %0, %1, %2" : "=v"(r) : "v"(lo), "v"(hi)); return r; }
template <class Epi, class Sched, bool ALIGN_EPI = false, bool SP2 = false>
__device__ __forceinline__ void gemm_phase(PG8_LAS unsigned char* lds, const Gemm g, const Sched& S, const Epi& E) {
    int tid_ = threadIdx.x; asm volatile("" : "+v"(tid_));
    const int tid = tid_, wid = __builtin_amdgcn_readfirstlane(tid >> 6), lane = tid & 63, wr = wid >> 2, wc = wid & 3, fr = lane & 15, fq = lane >> 4;
    const int K = g.K, nt = g.ntov ? g.ntov : K / BK;
    unsigned voffA[2], voffB[2];
#pragma unroll
    for (int i = 0; i < 2; ++i) { int R, C; stage_rc(tid * 16 + i * 8192, R, C); const int Rb = Epi::PERM ? ((R & ~31) + perm32(R & 31)) : R;
        voffA[i] = g.atile ? (unsigned)(R * BK + C) * 2u : (unsigned)(R * K + C) * 2u; voffB[i] = (unsigned)(Rb * K + C) * 2u; }
    const size_t kstep = g.kz ? (size_t)0 : (size_t)(BK * 2);
    size_t hstep = (size_t)HALF * K * 2;
    const size_t tstep = 2 * hstep;
    size_t kstepA = g.atile ? (size_t)(BM * BK * 2) : kstep, hstepA = g.atile ? (size_t)(HALF * BK * 2) : hstep; const size_t tstepA = g.atile ? (size_t)(K / BK) * (BM * BK * 2) : tstep;
    const unsigned ldsw = (unsigned)wid * 1024u;
    const int aoff = lds_byte(wr * 64 + fr, fq * 8), boff = lds_byte(wc * 32 + fr, fq * 8);
#define PG8_SA(b, h) (((b) * 2 + (h)) * HTB)
#define PG8_SB(b, h) ((4 + (b) * 2 + (h)) * HTB)
#define PG8_STAGE(bufoff, gbase, voff) do { _Pragma("unroll") for (int _i = 0; _i < 2; ++_i) \
        __builtin_amdgcn_global_load_lds((const unsigned*)((const char*)(gbase) + (voff)[_i]), (PG8_LAS unsigned*)(lds + (bufoff) + ldsw + _i * 8192), 16, 0, 0); } while (0)
#define PG8_LDA(dst, b, h) do { _Pragma("unroll") for (int m = 0; m < 4; ++m) _Pragma("unroll") for (int k = 0; k < 2; ++k) dst[m][k] = *(const PG8_LAS bf16x8*)(lds + PG8_SA(b, h) + aoff + m * 2048 + k * 1024); } while (0)
#define PG8_LDB(dst, b, h) do { _Pragma("unroll") for (int n = 0; n < 2; ++n) _Pragma("unroll") for (int k = 0; k < 2; ++k) dst[n][k] = *(const PG8_LAS bf16x8*)(lds + PG8_SB(b, h) + boff + n * 2048 + k * 1024); } while (0)
#define PG8_MMA(ai, bj, At, Bt) do { __builtin_amdgcn_s_setprio(1); _Pragma("unroll") for (int m = 0; m < 4; ++m) _Pragma("unroll") for (int n = 0; n < 2; ++n) _Pragma("unroll") for (int k = 0; k < 2; ++k) \
        acc[ai][bj][m][n] = __builtin_amdgcn_mfma_f32_16x16x32_bf16(Bt[n][k], At[m][k], acc[ai][bj][m][n], 0, 0, 0); __builtin_amdgcn_s_setprio(0); } while (0)
#define PG8_WAIT_V(n) asm volatile("s_waitcnt vmcnt(" #n ")" ::: "memory")
#define PG8_WAIT_L(n) asm volatile("s_waitcnt lgkmcnt(" #n ")" ::: "memory")
#define PG8_BAR __builtin_amdgcn_s_barrier()
#define PG8_SCHED __builtin_amdgcn_sched_barrier(0)
    Unit cur, nxt; int ui = 0;
    if (!S.next(0, cur)) return;
    f32x4 acc[2][2][4][2];
#pragma unroll
    for (int a = 0; a < 2; ++a)
#pragma unroll
        for (int b = 0; b < 2; ++b)
#pragma unroll
            for (int m = 0; m < 4; ++m)
#pragma unroll
                for (int n = 0; n < 2; ++n) acc[a][b][m][n] = (f32x4){0.f, 0.f, 0.f, 0.f};
    bf16x8 At[4][2], B0[2][2], B1[2][2];
    const char* cA = (const char*)g.A + (size_t)cur.pm * tstepA; const char* cB = (const char*)g.Bt + (size_t)cur.pn * tstep;
    const int rot = Epi::KROT == 1 ? (cur.pn & 3) * ((nt >> 2) & ~1) : 0;
#define PG8_KT(t) (Epi::KROT == 2 ? (size_t)(nt - 2 - ((t) & ~1) + ((t) & 1)) : (size_t)((t) + rot >= nt ? (t) + rot - nt : (t) + rot))
    const char* cA0 = cA + PG8_KT(0) * kstepA; const char* cB0 = cB + PG8_KT(0) * kstep;
    S.a_ready(cur);
    if constexpr (SP2) {
        PG8_STAGE(PG8_SB(0, 0), cB0, voffB); PG8_STAGE(PG8_SB(0, 1), cB0 + hstep, voffB); PG8_STAGE(PG8_SA(0, 0), cA0, voffA); PG8_STAGE(PG8_SA(0, 1), cA0 + hstepA, voffA);
        if (wr == 1) PG8_BAR;
        PG8_WAIT_V(2); PG8_BAR;
        PG8_STAGE(PG8_SB(1, 0), cB0 + kstep, voffB); PG8_STAGE(PG8_SA(1, 0), cA0 + kstepA, voffA); PG8_STAGE(PG8_SB(1, 1), cB0 + hstep + kstep, voffB);
        PG8_WAIT_V(6); PG8_BAR;
    } else {
        PG8_STAGE(PG8_SB(0, 0), cB, voffB); PG8_STAGE(PG8_SA(0, 0), cA, voffA); PG8_STAGE(PG8_SB(0, 1), cB + hstep, voffB); PG8_STAGE(PG8_SA(0, 1), cA + hstep, voffA);
        if (wr == 1) PG8_BAR;
        PG8_WAIT_V(4); PG8_BAR;
        PG8_STAGE(PG8_SB(1, 0), cB0 + kstep, voffB); PG8_STAGE(PG8_SA(1, 0), cA0 + kstep, voffA); PG8_STAGE(PG8_SB(1, 1), cB0 + hstep + kstep, voffB);
        PG8_WAIT_V(6); PG8_BAR;
    }
    for (;;) {
        const bool has_next = S.next(ui + 1, nxt);
        const char* nA = has_next ? (const char*)g.A + (size_t)nxt.pm * tstepA : cA; const char* nB = has_next ? (const char*)g.Bt + (size_t)nxt.pn * tstep : cB;
        if constexpr (Epi::RESID_LDS) { if (!has_next) { nB = E.resid_tile(cur); nA = nB + 256; } }
        for (int t = 0; t < nt; t += 2) {
            const bool last = (t == nt - 2);
            const char* a1 = cA + PG8_KT(t + 1) * kstepA;
            const char* a2 = last ? nA : cA + PG8_KT(t + 2) * kstepA; const char* b2 = last ? nB : cB + PG8_KT(t + 2) * kstep;
            const char* b3 = b2 + kstep;
            if (last && has_next) S.a_ready(nxt);
            if constexpr (SP2) {
            bool lastx = false; if constexpr (Epi::RESID_LDS) lastx = last && !has_next;
            PG8_LDB(B0, 0, 0); PG8_LDB(B1, 0, 1); PG8_SCHED; PG8_LDA(At, 0, 0); PG8_STAGE(PG8_SA(1, 1), a1 + hstepA, voffA);
            PG8_WAIT_V(8); PG8_WAIT_L(0); PG8_BAR; PG8_MMA(0, 0, At, B0); PG8_MMA(0, 1, At, B1); PG8_BAR; PG8_SCHED;
            if constexpr (Epi::RESID_LDS) { if (lastx) {
                int t2 = threadIdx.x; asm volatile("" : "+v"(t2));
#pragma unroll
                for (int i = 0; i < 2; ++i) { int R, C; stage_rc(t2 * 16 + i * 8192, R, C); voffA[i] = voffB[i] = (unsigned)(R * E.resid_ld() + C) * 2u; }
                hstep = hstepA = (size_t)HALF * E.resid_ld() * 2; kstepA = kstep; } }
            PG8_LDA(At, 0, 1); PG8_STAGE(PG8_SB(0, 0), b2, voffB); PG8_STAGE(PG8_SB(0, 1), b2 + hstep, voffB); PG8_STAGE(PG8_SA(0, 0), a2, voffA);
            PG8_WAIT_V(8); PG8_WAIT_L(0); PG8_BAR; PG8_MMA(1, 0, At, B0); PG8_MMA(1, 1, At, B1); PG8_BAR; PG8_SCHED;
            PG8_LDB(B0, 1, 0); PG8_LDB(B1, 1, 1); PG8_SCHED; PG8_LDA(At, 1, 0); PG8_STAGE(PG8_SA(0, 1), a2 + hstepA, voffA);
            PG8_WAIT_V(8); PG8_WAIT_L(0); PG8_BAR; PG8_MMA(0, 0, At, B0); PG8_MMA(0, 1, At, B1); PG8_BAR; PG8_SCHED;
            PG8_LDA(At, 1, 1); PG8_STAGE(PG8_SB(1, 0), b3, voffB); PG8_STAGE(PG8_SB(1, 1), b3 + hstep, voffB); PG8_STAGE(PG8_SA(1, 0), a2 + kstepA, voffA);
            if (lastx) PG8_WAIT_V(14); else PG8_WAIT_V(8);
            PG8_WAIT_L(0); PG8_BAR; PG8_MMA(1, 0, At, B0); PG8_MMA(1, 1, At, B1); PG8_BAR; PG8_SCHED;
            } else {
            PG8_LDB(B0, 0, 0); PG8_SCHED; PG8_LDA(At, 0, 0); PG8_STAGE(PG8_SA(1, 1), a1 + hstep, voffA);
            PG8_WAIT_L(8); PG8_BAR; PG8_WAIT_L(0); PG8_MMA(0, 0, At, B0); PG8_BAR; PG8_SCHED;
            PG8_LDB(B1, 0, 1); PG8_STAGE(PG8_SB(0, 0), b2, voffB);
            PG8_BAR; PG8_WAIT_L(0); PG8_MMA(0, 1, At, B1); PG8_BAR;
            PG8_LDA(At, 0, 1); PG8_STAGE(PG8_SA(0, 0), a2, voffA);
            PG8_BAR; PG8_WAIT_L(0); PG8_MMA(1, 0, At, B0); PG8_BAR; PG8_SCHED;
            PG8_STAGE(PG8_SB(0, 1), b2 + hstep, voffB);
            PG8_WAIT_V(6); PG8_BAR; PG8_MMA(1, 1, At, B1); PG8_BAR;
            PG8_LDB(B0, 1, 0); PG8_SCHED; PG8_LDA(At, 1, 0); PG8_STAGE(PG8_SA(0, 1), a2 + hstep, voffA);
            PG8_WAIT_L(8); PG8_BAR; PG8_WAIT_L(0); PG8_MMA(0, 0, At, B0); PG8_BAR; PG8_SCHED;
            PG8_LDB(B1, 1, 1); PG8_STAGE(PG8_SB(1, 0), b3, voffB);
            PG8_BAR; PG8_WAIT_L(0); PG8_MMA(0, 1, At, B1); PG8_BAR;
            PG8_LDA(At, 1, 1); PG8_STAGE(PG8_SA(1, 0), a2 + kstepA, voffA);
            PG8_BAR; PG8_WAIT_L(0); PG8_MMA(1, 0, At, B0); PG8_BAR; PG8_SCHED;
            PG8_STAGE(PG8_SB(1, 1), b3 + hstep, voffB);
            PG8_WAIT_V(6); PG8_BAR; PG8_MMA(1, 1, At, B1); PG8_BAR;
            }
        }
        if constexpr (ALIGN_EPI) { if (wr == 0) PG8_BAR; }
        if constexpr (Epi::RESID_LDS) { E.resid_lds(acc, cur, wr, wc, fr, fq, lds); S.done(cur); return; }
        else if constexpr (!Epi::AFTER_DRAIN) { E(acc, cur, wr, wc, fr, fq); S.done(cur); }
        if (!has_next) break;
#pragma unroll
        for (int a = 0; a < 2; ++a)
#pragma unroll
            for (int b = 0; b < 2; ++b)
#pragma unroll
                for (int m = 0; m < 4; ++m)
#pragma unroll
                    for (int n = 0; n < 2; ++n) acc[a][b][m][n] = (f32x4){0.f, 0.f, 0.f, 0.f};
        cur = nxt; cA = nA; cB = nB; ++ui;
        if constexpr (ALIGN_EPI) { if (wr == 1) PG8_BAR; }
    }
    PG8_WAIT_V(0);
    if constexpr (!ALIGN_EPI) { if (wr == 0) PG8_BAR; }
    PG8_BAR;
    if constexpr (Epi::AFTER_DRAIN) { E.fused(acc, cur, wr, wc, fr, fq, lds, wid, lane); S.done(cur); }
#undef PG8_SA
#undef PG8_KT
#undef PG8_SB
#undef PG8_STAGE
#undef PG8_LDA
#undef PG8_LDB
#undef PG8_MMA
#undef PG8_WAIT_V
#undef PG8_WAIT_L
#undef PG8_BAR
#undef PG8_SCHED
}
}
#define XB_TMO      128
#define XB_XCNT(j)  (256  + 64 * (j))
#define XB_XSUB(j)  (1280 + 64 * (j))
#define XB_XGEN(j)  (2304 + 64 * (j))
#define XB_TOP      3328
#define XB_TOPGEN   3392
#define XCD_BAR_WORDS 3456
#define XB_SPIN_CAP (1u << 18)

__device__ __forceinline__ unsigned xb_ld(unsigned* p)              { return __hip_atomic_load(p, __ATOMIC_RELAXED, __HIP_MEMORY_SCOPE_AGENT); }
__device__ __forceinline__ unsigned xb_add(unsigned* p, unsigned v) { return __hip_atomic_fetch_add(p, v, __ATOMIC_RELAXED, __HIP_MEMORY_SCOPE_AGENT); }
__device__ __forceinline__ unsigned xb_xcc_id() { return (unsigned)__builtin_amdgcn_s_getreg((3 << 11) | 20) & 0xFu; }
#define XB_SPIN(cond, bar) do { unsigned _sp = 0; while (cond) { __builtin_amdgcn_s_sleep(1); \
    if ((++_sp & 255u) == 0u) { if (xb_ld(&(bar)[XB_TMO])) break; if (_sp > XB_SPIN_CAP) { atomicAdd(&(bar)[XB_TMO], 1u); break; } } } } while (0)

struct XcdBarrier {
    unsigned* bar; unsigned x;
    volatile LAS unsigned* st;
};

__device__ __forceinline__ XcdBarrier xcd_barrier_post(unsigned* bar, volatile LAS unsigned* st) {
    XcdBarrier b; b.bar = bar; b.x = xb_xcc_id(); b.st = st;
    if (threadIdx.x == 0) (void)xb_add(&bar[XB_XCNT(b.x)], 1u);
    return b;
}
__device__ __forceinline__ void xcd_barrier_complete(unsigned* bar, unsigned x, unsigned& nloc, unsigned& nx) {
    const unsigned G = gridDim.x * gridDim.y * gridDim.z;
    unsigned sum, cnt, mine, sp = 0u;
    for (;;) {
        sum = 0u; cnt = 0u; mine = 0u;
#pragma unroll
        for (unsigned j = 0; j < 16; ++j) { const unsigned c = xb_ld(&bar[XB_XCNT(j)]); sum += c; cnt += (c > 0u) ? 1u : 0u; mine = (j == x) ? c : mine; }
        if (sum == G) break;
        __builtin_amdgcn_s_sleep(1);
        if ((++sp & 255u) == 0u) { if (xb_ld(&bar[XB_TMO])) break; if (sp > XB_SPIN_CAP) { atomicAdd(&bar[XB_TMO], 1u); break; } }
    }
    nloc = mine > 0u ? mine : 1u; nx = cnt > 0u ? cnt : 1u;
}

__device__ __forceinline__ void xcd_barrier(const XcdBarrier& b, const bool local = false) {
    asm volatile("s_waitcnt vmcnt(0)" ::: "memory");
    __syncthreads();
    if (threadIdx.x == 0) {
        unsigned* bar = b.bar;
        __builtin_amdgcn_s_waitcnt(0);
        unsigned nloc = b.st[0], nx = b.st[1];
        if (nloc == 0u) { xcd_barrier_complete(bar, b.x, nloc, nx); b.st[0] = nloc; b.st[1] = nx; }
        const unsigned old = xb_add(&bar[XB_XSUB(b.x)], 1u);
        const unsigned gen = old / nloc;
        if (old + 1u == (gen + 1u) * nloc) {
            if (!local) {
            __builtin_amdgcn_fence(__ATOMIC_RELEASE, "agent");
            asm volatile("s_waitcnt vmcnt(0)" ::: "memory");
            const unsigned og = xb_add(&bar[XB_TOP], 1u);
            const unsigned tg = og / nx;
            if (og + 1u == (tg + 1u) * nx) xb_add(&bar[XB_TOPGEN], 1u);
            else XB_SPIN(xb_ld(&bar[XB_TOPGEN]) == tg, bar);
            }
            __builtin_amdgcn_fence(__ATOMIC_ACQUIRE, "agent");
            xb_add(&bar[XB_XGEN(b.x)], 1u);
            asm volatile("s_waitcnt vmcnt(0)" ::: "memory");
        } else {
            XB_SPIN(xb_ld(&bar[XB_XGEN(b.x)]) == gen, bar);
            __builtin_amdgcn_fence(__ATOMIC_ACQUIRE, "agent");
            asm volatile("s_waitcnt vmcnt(0)" ::: "memory");
        }
    }
    __syncthreads();
}


namespace mk {
using pg8::bf16_t; using pg8::f32x4; using pg8::u32x4; using pg8::Unit; using pg8::bf16x8;

constexpr int DM = 1024, NTOK = 16384, SEQ = 8192, DFF = 2816;
constexpr float EPS = 1e-6f;
constexpr size_t MB = 1ull << 20;
constexpr size_t WS_BAR = 0;
constexpr size_t WS_TICK = 32 * 1024;
constexpr size_t WS_SS = 64 * 1024;
constexpr size_t WS_ROPE = WS_SS + MB;
constexpr size_t WS_XB = 4 * MB;
constexpr size_t WS_W = WS_XB + 32 * MB;
constexpr size_t WREG = 46 * MB;
constexpr size_t WO_GU0 = 0, WO_D0 = 11534336, WO_GU1 = WO_D0 + 5767168, WO_D1 = WO_GU1 + 11534336, WO_MIN = WO_D1 + 5767168, WO_MOUT = WO_MIN + 8388608, WO_BA = WO_MOUT + 2097152;
constexpr size_t WS_MIX = WS_W + 2 * WREG;
constexpr size_t WS_H = WS_MIX;

__device__ __forceinline__ int otid() { int t = threadIdx.x; asm volatile("" : "+v"(t)); return t; }
typedef float f32x2_t __attribute__((ext_vector_type(2))); typedef __bf16 bf16x2_t __attribute__((ext_vector_type(2)));
__device__ __forceinline__ unsigned pk2(float lo, float hi) { const f32x2_t v = {lo, hi}; const bf16x2_t b = __builtin_convertvector(v, bf16x2_t); return __builtin_bit_cast(unsigned, b); }
__device__ __forceinline__ int dpp_i(int v, const int ctl) { return ctl == 0xB1 ? __builtin_amdgcn_update_dpp(0, v, 0xB1, 0xF, 0xF, true) : ctl == 0x4E ? __builtin_amdgcn_update_dpp(0, v, 0x4E, 0xF, 0xF, true) : ctl == 0x141 ? __builtin_amdgcn_update_dpp(0, v, 0x141, 0xF, 0xF, true) : __builtin_amdgcn_update_dpp(0, v, 0x140, 0xF, 0xF, true); }
__device__ __forceinline__ float dpp_f(float v, const int ctl) { return __int_as_float(dpp_i(__float_as_int(v), ctl)); }
__device__ __forceinline__ float sum8_f(float s) { s += dpp_f(s, 0xB1); s += dpp_f(s, 0x4E); s += dpp_f(s, 0x141); return s; }
__device__ __forceinline__ int wave_sum_i(int v) {
    v += dpp_i(v, 0xB1); v += dpp_i(v, 0x4E); v += dpp_i(v, 0x141); v += dpp_i(v, 0x140);
    return __builtin_amdgcn_readlane(v, 0) + __builtin_amdgcn_readlane(v, 16) + __builtin_amdgcn_readlane(v, 32) + __builtin_amdgcn_readlane(v, 48);
}
__device__ __forceinline__ float bf2f(unsigned short b) { return __uint_as_float(((unsigned)b) << 16); }
__device__ __forceinline__ float silu_f(float g) { return g * __builtin_amdgcn_rcpf(1.0f + __expf(-g)); }
__device__ __forceinline__ float row_rstd(const float* ss, int row) {
    const f32x4* p = (const f32x4*)(ss + (size_t)row * 16); const f32x4 a = p[0], b = p[1], c = p[2], d = p[3];
    const float s = (((a[0] + a[1]) + (a[2] + a[3])) + ((b[0] + b[1]) + (b[2] + b[3]))) + (((c[0] + c[1]) + (c[2] + c[3])) + ((d[0] + d[1]) + (d[2] + d[3])));
    return 1.0f / sqrtf(s * (1.0f / 1024.0f) + EPS);
}

__device__ __forceinline__ void rows_rstd4(const float* ss, int rowa, int fr, int fq, float (&rs)[4]) {
    const float r0 = row_rstd(ss, rowa + fq * 16);
#pragma unroll
    for (int q = 0; q < 4; ++q) rs[q] = __shfl(r0, q * 16 + fr);
}

__device__ __forceinline__ void ph_xprep(const float* x, bf16_t* xb, float* ss, int G, int bid) {
    const int tid = otid(), wid = tid >> 6, lane = tid & 63;
    for (int row = bid * 8 + wid; row < NTOK; row += G * 8) {
        const float* xr = x + (size_t)row * DM; bf16_t* br = xb + (size_t)row * DM;
#pragma unroll
        for (int hlf = 0; hlf < 2; ++hlf) { const int c = hlf * 512 + lane * 8;
            const f32x4 a = *(const f32x4*)(xr + c), b = *(const f32x4*)(xr + c + 4);
            u32x4 w; w.x = pk2(a[0], a[1]); w.y = pk2(a[2], a[3]); w.z = pk2(b[0], b[1]); w.w = pk2(b[2], b[3]); *(u32x4*)(br + c) = w;
            const float a0 = __uint_as_float(w.x << 16), a1 = __uint_as_float(w.x & 0xffff0000u), a2 = __uint_as_float(w.y << 16), a3 = __uint_as_float(w.y & 0xffff0000u);
            const float b0 = __uint_as_float(w.z << 16), b1 = __uint_as_float(w.z & 0xffff0000u), b2 = __uint_as_float(w.w << 16), b3 = __uint_as_float(w.w & 0xffff0000u);
            float s = (a0 * a0 + a1 * a1) + (a2 * a2 + a3 * a3) + (b0 * b0 + b1 * b1) + (b2 * b2 + b3 * b3);
            s = sum8_f(s);
            if ((lane & 7) == 0) ss[(size_t)row * 16 + hlf * 8 + (lane >> 3)] = s; }
    }
}
__device__ __forceinline__ void ph_rope(const int* pos, float* cs, float* sn, int G, int bid) {
    for (int i = bid * 512 + otid(); i < NTOK * 8; i += G * 512) { const int t = i >> 3, j = i & 7;
        const float inv = (float)pow(500000.0, -(double)(2 * j) / 16.0); const float ang = (float)pos[t] * inv;
        cs[i] = (float)cos((double)ang); sn[i] = (float)sin((double)ang); }
}

__device__ __forceinline__ int hperm(int p) { return p < 16 ? ((p & 3) | ((p & 4) << 1) | ((p & 8) >> 1)) : p; }
__device__ __forceinline__ int src_col(int kind, int n, float& scale, int& mat) {
    scale = 1.0f; mat = 0;
    if (kind == 0) return n;
    if (kind == 1) { const int pn = n >> 8, j = n & 255; mat = j >> 7; return pn * 128 + (j & 127); }
    if (kind == 3) return n < 16 ? 4096 + n : -1;
    const int pn = n >> 8, j = n & 255;
    if (pn < 4) return j < 128 ? 512 + 128 * pn + j : 1024 + 128 * pn + (j - 128);
    if (pn < 6) return (pn - 4) * 256 + j;
    if (pn < 14) { const int base = 1536 + (pn - 6) * 256 + j; if (pn < 10 || pn >= 12) { const int p = base & 63; return base - p + hperm(p); } return base; }
    if (j < 64) return 3584 + hperm(j);
    if (j < 72) { scale = 0.044194173824159216f; return 3648 + (j - 64); }
    return -1;
}
__device__ __forceinline__ void conv_tile(LAS float* tl, int kind, const float* W, const float* W2, const float* gain, bf16_t* Wt, int K, int Nsrc, int tile) {
    const int ktiles = K >> 6, nt = tile / ktiles, kt = tile - nt * ktiles, n0 = nt * 128, k0 = kt * 64, tid = otid();
    { const int nq = (tid & 31) * 4, kr = tid >> 5; float sc; int mat; const int sc_col = src_col(kind, n0 + nq, sc, mat); const float* Ws = mat ? W2 : W;
      f32x4 v[4];
#pragma unroll
      for (int i = 0; i < 4; ++i) { const int k = k0 + kr + 16 * i; v[i] = (f32x4){0.f, 0.f, 0.f, 0.f};
          if (sc_col >= 0) { v[i] = *(const f32x4*)(Ws + (size_t)k * Nsrc + sc_col) * (gain ? sc * gain[k] : sc); } }
#pragma unroll
      for (int i = 0; i < 4; ++i) *(LAS f32x4*)(tl + (kr + 16 * i) * 132 + nq) = v[i]; }
    __syncthreads();
    { const int r = tid >> 2, kq = tid & 3; float v[16];
#pragma unroll
      for (int e = 0; e < 16; ++e) v[e] = tl[(16 * kq + e) * 132 + r];
      u32x4 w0, w1; w0.x = pk2(v[0], v[1]); w0.y = pk2(v[2], v[3]); w0.z = pk2(v[4], v[5]); w0.w = pk2(v[6], v[7]);
      w1.x = pk2(v[8], v[9]); w1.y = pk2(v[10], v[11]); w1.z = pk2(v[12], v[13]); w1.w = pk2(v[14], v[15]);
      bf16_t* dst = Wt + (size_t)(n0 + r) * K + k0 + 16 * kq; *(u32x4*)dst = w0; *(u32x4*)(dst + 8) = w1; }
    __syncthreads();
}
struct Args { const float* in[16]; float* out; unsigned char* ws; int ph_lo, ph_hi; };
typedef Args WPtrs;
__device__ __forceinline__ void convert_layer(LAS float* tl, const WPtrs& P, unsigned char* ws, int l, int first, int stride) {
    const int i = l >> 1, odd = l & 1; unsigned char* wr = ws + WS_W + (size_t)(l & 1) * WREG;
    const float* ng = P.in[2] + (size_t)l * 3 * DM;
    const int nGU = 44 * 16, nD = 8 * 44, nIN = odd ? 32 * 16 : 30 * 16, nOUT = 8 * 16, nBA = odd ? 16 : 0;
    const int t1 = nGU, t2 = t1 + nD, t3 = t2 + nGU, t4 = t3 + nD, t5 = t4 + nIN, t6 = t5 + nOUT, t7 = t6 + nBA;
    for (int t = first; t < t7; t += stride) {
        if (t < t1) { const size_t wo = ((size_t)l * 2 + 0) * DM * DFF; conv_tile(tl, 1, P.in[3] + wo, P.in[4] + wo, ng + 0 * DM, (bf16_t*)(wr + WO_GU0), DM, DFF, t); }
        else if (t < t2) { const size_t wo = ((size_t)l * 2 + 0) * DM * DFF; conv_tile(tl, 0, P.in[5] + wo, nullptr, nullptr, (bf16_t*)(wr + WO_D0), DFF, DM, t - t1); }
        else if (t < t3) { const size_t wo = ((size_t)l * 2 + 1) * DM * DFF; conv_tile(tl, 1, P.in[3] + wo, P.in[4] + wo, ng + 2 * DM, (bf16_t*)(wr + WO_GU1), DM, DFF, t - t2); }
        else if (t < t4) { const size_t wo = ((size_t)l * 2 + 1) * DM * DFF; conv_tile(tl, 0, P.in[5] + wo, nullptr, nullptr, (bf16_t*)(wr + WO_D1), DFF, DM, t - t3); }
        else if (t < t5) { if (!odd) conv_tile(tl, 2, P.in[6] + (size_t)i * DM * 3656, nullptr, ng + DM, (bf16_t*)(wr + WO_MIN), DM, 3656, t - t4);
                           else conv_tile(tl, 0, P.in[9] + (size_t)i * DM * 4112, nullptr, ng + DM, (bf16_t*)(wr + WO_MIN), DM, 4112, t - t4); }
        else if (t < t6) { conv_tile(tl, 0, (odd ? P.in[14] : P.in[8]) + (size_t)i * DM * DM, nullptr, nullptr, (bf16_t*)(wr + WO_MOUT), DM, DM, t - t5); }
        else { conv_tile(tl, 3, P.in[9] + (size_t)i * DM * 4112, nullptr, ng + DM, (bf16_t*)(wr + WO_BA), DM, 4112, t - t6); }
    }
}

struct EpiGateUp {
    static constexpr bool PERM = true, AFTER_DRAIN = false, RESID_LDS = false; static constexpr int KROT = 0;
    bf16_t* H; const float* ss;
    __device__ __forceinline__ void operator()(const f32x4 (&acc)[2][2][4][2], const Unit& u, int wr, int wc, int fr, int fq) const {
        const int row0 = u.pm * 256 + wr * 64 + fr;
        bf16_t* const ht = H + ((size_t)(u.pm * (DFF / 64) + u.pn * 2 + (wc >> 1)) * 256 + wr * 64 + fr) * 64 + (wc & 1) * 32 + 8 * fq;
#ifndef EPX_GU
#define EPX_GU 1
#endif
        for (int epx_ = 0; epx_ < EPX_GU; ++epx_)
#pragma unroll
        for (int ai = 0; ai < 2; ++ai) { float rs[4]; rows_rstd4(ss, row0 + ai * 128, fr, fq, rs);
#pragma unroll
            for (int m = 0; m < 4; ++m) { const int row = row0 + ai * 128 + m * 16; const float r = rs[m];
                float h[8];
#pragma unroll
                for (int n = 0; n < 2; ++n)
#pragma unroll
                    for (int j = 0; j < 4; ++j) h[n * 4 + j] = silu_f(acc[ai][0][m][n][j] * r) * (acc[ai][1][m][n][j] * r);
                u32x4 w; w.x = pk2(h[0], h[1]); w.y = pk2(h[2], h[3]); w.z = pk2(h[4], h[5]); w.w = pk2(h[6], h[7]);
                *(u32x4*)(ht + (ai * 128 + m * 16) * 64) = w; } }
    }
};
template <int KR> struct EpiResidT {
    static constexpr bool PERM = true, AFTER_DRAIN = false, RESID_LDS = true; static constexpr int KROT = KR;
    bf16_t* XB; float* ss; float alpha;
    __device__ __forceinline__ void operator()(const f32x4 (&acc)[2][2][4][2], const Unit& u, int wr, int wc, int fr, int fq) const {
        const int row0 = u.pm * 256 + wr * 64 + fr;
        const unsigned loff = (unsigned)(fr * DM + 8 * fq) * 2u;
        char* const ub = (char*)(XB + (size_t)(u.pm * 256 + wr * 64) * DM + u.pn * 256 + wc * 32);
#ifdef EPX_SKIP
        if (alpha == 0.f) return;
#endif
        u32x4 xv[2][4][2];
#pragma unroll
        for (int ai = 0; ai < 2; ++ai)
#pragma unroll
            for (int m = 0; m < 4; ++m)
#pragma unroll
                for (int bj = 0; bj < 2; ++bj) xv[ai][m][bj] = *(const u32x4*)(ub + (size_t)((ai * 128 + m * 16) * DM + bj * 128) * 2 + loff);
        asm volatile("" ::: "memory");
#pragma unroll
        for (int ai = 0; ai < 2; ++ai) {
#pragma unroll
            for (int m = 0; m < 4; ++m) { const int row = row0 + ai * 128 + m * 16; float s = 0.f;
#pragma unroll
                for (int bj = 0; bj < 2; ++bj) { const u32x4 x = xv[ai][m][bj]; const f32x4 d0 = acc[ai][bj][m][0] * alpha, d1 = acc[ai][bj][m][1] * alpha;
                    u32x4 w; w.x = pk2(__uint_as_float(x.x << 16) + d0[0], __uint_as_float(x.x & 0xffff0000u) + d0[1]); w.y = pk2(__uint_as_float(x.y << 16) + d0[2], __uint_as_float(x.y & 0xffff0000u) + d0[3]);
                    w.z = pk2(__uint_as_float(x.z << 16) + d1[0], __uint_as_float(x.z & 0xffff0000u) + d1[1]); w.w = pk2(__uint_as_float(x.w << 16) + d1[2], __uint_as_float(x.w & 0xffff0000u) + d1[3]);
                    *(u32x4*)(ub + (size_t)((ai * 128 + m * 16) * DM + bj * 128) * 2 + loff) = w;
                    const float a0 = __uint_as_float(w.x << 16), a1 = __uint_as_float(w.x & 0xffff0000u), a2 = __uint_as_float(w.y << 16), a3 = __uint_as_float(w.y & 0xffff0000u);
                    const float b0 = __uint_as_float(w.z << 16), b1 = __uint_as_float(w.z & 0xffff0000u), b2 = __uint_as_float(w.w << 16), b3 = __uint_as_float(w.w & 0xffff0000u);
                    s += (a0 * a0 + a1 * a1) + (a2 * a2 + a3 * a3) + (b0 * b0 + b1 * b1) + (b2 * b2 + b3 * b3); }
                s += __shfl_xor(s, 16); s += __shfl_xor(s, 32);
                if (fq == 0) ss[(size_t)row * 16 + u.pn * 4 + wc] = s; }
        }
    }
    __device__ __forceinline__ const char* resid_tile(const Unit& u) const { return (const char*)(XB + (size_t)u.pm * 256 * DM + u.pn * 256); }
    __device__ __forceinline__ int resid_ld() const { return DM; }
    __device__ __forceinline__ void resid_lds(const f32x4 (&acc)[2][2][4][2], const Unit& u, int wr, int wc, int fr, int fq, LAS unsigned char* lds) const {
        const int row0 = u.pm * 256 + wr * 64 + fr;
        const unsigned loff = (unsigned)(fr * DM + 8 * fq) * 2u;
        char* const ub = (char*)(XB + (size_t)(u.pm * 256 + wr * 64) * DM + u.pn * 256 + wc * 32);
        const bool gl = wc >= 2; u32x4 xg[4];
        if (gl) {
#pragma unroll
            for (int m = 0; m < 4; ++m) xg[m] = *(const u32x4*)(ub + (size_t)((128 + m * 16) * DM + 128) * 2 + loff);
            asm volatile("s_waitcnt vmcnt(4)" ::: "memory"); }
        else asm volatile("s_waitcnt vmcnt(0)" ::: "memory");
        if (wr == 0) __builtin_amdgcn_s_barrier();
        __builtin_amdgcn_s_barrier(); asm volatile("" ::: "memory");
        const unsigned lo = (unsigned)pg8::lds_byte(wr * 64 + fr, (wc & 1) * 32 + 8 * fq) + (unsigned)(wc >> 1) * (unsigned)(2 * pg8::HTB);
#pragma unroll
        for (int ai = 0; ai < 2; ++ai) {
            u32x4 xv[4][2];
#pragma unroll
            for (int m = 0; m < 4; ++m) {
                xv[m][0] = *(const LAS u32x4*)(lds + (4 + ai) * pg8::HTB + lo + m * 2048);
                if (ai == 1) { if (gl) xv[m][1] = xg[m]; else xv[m][1] = *(const LAS u32x4*)(lds + ai * pg8::HTB + lo + m * 2048); }
                else xv[m][1] = *(const LAS u32x4*)(lds + ai * pg8::HTB + lo + m * 2048); }
#pragma unroll
            for (int m = 0; m < 4; ++m) { const int row = row0 + ai * 128 + m * 16; float s = 0.f;
#pragma unroll
                for (int bj = 0; bj < 2; ++bj) { const u32x4 x = xv[m][bj]; const f32x4 d0 = acc[ai][bj][m][0] * alpha, d1 = acc[ai][bj][m][1] * alpha;
                    u32x4 w; w.x = pk2(__uint_as_float(x.x << 16) + d0[0], __uint_as_float(x.x & 0xffff0000u) + d0[1]); w.y = pk2(__uint_as_float(x.y << 16) + d0[2], __uint_as_float(x.y & 0xffff0000u) + d0[3]);
                    w.z = pk2(__uint_as_float(x.z << 16) + d1[0], __uint_as_float(x.z & 0xffff0000u) + d1[1]); w.w = pk2(__uint_as_float(x.w << 16) + d1[2], __uint_as_float(x.w & 0xffff0000u) + d1[3]);
                    *(u32x4*)(ub + (size_t)((ai * 128 + m * 16) * DM + bj * 128) * 2 + loff) = w;
                    const float a0 = __uint_as_float(w.x << 16), a1 = __uint_as_float(w.x & 0xffff0000u), a2 = __uint_as_float(w.y << 16), a3 = __uint_as_float(w.y & 0xffff0000u);
                    const float b0 = __uint_as_float(w.z << 16), b1 = __uint_as_float(w.z & 0xffff0000u), b2 = __uint_as_float(w.w << 16), b3 = __uint_as_float(w.w & 0xffff0000u);
                    s += (a0 * a0 + a1 * a1) + (a2 * a2 + a3 * a3) + (b0 * b0 + b1 * b1) + (b2 * b2 + b3 * b3); }
                s += __shfl_xor(s, 16); s += __shfl_xor(s, 32);
                if (fq == 0) ss[(size_t)row * 16 + u.pn * 4 + wc] = s; }
        }
    }
};
typedef EpiResidT<0> EpiResid;
typedef EpiResidT<2> EpiResidRev;

constexpr size_t EV_U = 0, EV_B = 16 * MB, EV_Q = 32 * MB, EV_K = 48 * MB, EV_V = 64 * MB, EV_QI = 80 * MB, EV_KI = 96 * MB, EV_WI = 98 * MB, EV_Y = 100 * MB, EV_S16 = 132 * MB, EV_BM = 196 * MB;

struct EpiEvIn {
    static constexpr bool PERM = true, AFTER_DRAIN = false, RESID_LDS = false; static constexpr int KROT = 0;
    unsigned char* mx; const float* ss; const float* cs; const float* sn;
    __device__ __forceinline__ void operator()(const f32x4 (&acc)[2][2][4][2], const Unit& u, int wr, int wc, int fr, int fq) const {
        const int row0 = u.pm * 256 + wr * 64 + fr, pn = u.pn;
#pragma unroll
        for (int ai = 0; ai < 2; ++ai) { float rs[4]; rows_rstd4(ss, row0 + ai * 128, fr, fq, rs);
#pragma unroll
            for (int m = 0; m < 4; ++m) { const int row = row0 + ai * 128 + m * 16; const float r = rs[m];
                if (pn < 4) {
                    float h[8]; const float r2 = r * r;
#pragma unroll
                    for (int n = 0; n < 2; ++n)
#pragma unroll
                        for (int j = 0; j < 4; ++j) h[n * 4 + j] = acc[ai][0][m][n][j] * acc[ai][1][m][n][j] * r2;
                    u32x4 w; w.x = pk2(h[0], h[1]); w.y = pk2(h[2], h[3]); w.z = pk2(h[4], h[5]); w.w = pk2(h[6], h[7]);
                    *(u32x4*)((bf16_t*)(mx + EV_U) + (size_t)row * 512 + pn * 128 + wc * 32 + 8 * fq) = w;
                } else if (pn < 6) {
#pragma unroll
                    for (int bj = 0; bj < 2; ++bj) { const f32x4 a = acc[ai][bj][m][0] * r, b = acc[ai][bj][m][1] * r;
                        u32x4 w; w.x = pk2(a[0], a[1]); w.y = pk2(a[2], a[3]); w.z = pk2(b[0], b[1]); w.w = pk2(b[2], b[3]);
                        *(u32x4*)((bf16_t*)(mx + EV_B) + (size_t)row * 512 + (pn - 4) * 256 + bj * 128 + wc * 32 + 8 * fq) = w; }
                } else if (pn < 14) {
                    const int sec = (pn - 6) >> 1; bf16_t* dst = (bf16_t*)(mx + (sec == 0 ? EV_Q : sec == 1 ? EV_K : sec == 2 ? EV_V : EV_QI));
                    const bool rope = (sec != 2) && ((wc & 1) == 0) && (fq < 2);
                    f32x4 c4 = {1.f, 1.f, 1.f, 1.f}, s4 = {0.f, 0.f, 0.f, 0.f};
                    if (rope) { c4 = *(const f32x4*)(cs + (size_t)row * 8 + 4 * fq); s4 = *(const f32x4*)(sn + (size_t)row * 8 + 4 * fq); }
                    const float rq = sec == 0 ? r * 0.18033688011112042f : r;
#pragma unroll
                    for (int bj = 0; bj < 2; ++bj) { const f32x4 x1 = acc[ai][bj][m][0] * rq, x2 = acc[ai][bj][m][1] * rq;
                        const f32x4 a = rope ? x1 * c4 - x2 * s4 : x1, b = rope ? x2 * c4 + x1 * s4 : x2;
                        u32x4 w; w.x = pk2(a[0], a[1]); w.y = pk2(a[2], a[3]); w.z = pk2(b[0], b[1]); w.w = pk2(b[2], b[3]);
                        *(u32x4*)(dst + (size_t)row * 512 + ((pn - 6) & 1) * 256 + bj * 128 + wc * 32 + 8 * fq) = w; }
                } else {
                    const f32x4 x1 = acc[ai][0][m][0] * r, x2 = acc[ai][0][m][1] * r;
                    if (wc < 2) { const bool rope = (wc == 0) && (fq < 2);
                        f32x4 c4 = {1.f, 1.f, 1.f, 1.f}, s4 = {0.f, 0.f, 0.f, 0.f};
                        if (rope) { c4 = *(const f32x4*)(cs + (size_t)row * 8 + 4 * fq); s4 = *(const f32x4*)(sn + (size_t)row * 8 + 4 * fq); }
                        const f32x4 a = rope ? x1 * c4 - x2 * s4 : x1, b = rope ? x2 * c4 + x1 * s4 : x2;
                        u32x4 w; w.x = pk2(a[0], a[1]); w.y = pk2(a[2], a[3]); w.z = pk2(b[0], b[1]); w.w = pk2(b[2], b[3]);
                        *(u32x4*)((bf16_t*)(mx + EV_KI) + (size_t)row * 64 + wc * 32 + 8 * fq) = w;
                    } else if (wc == 2 && fq == 0) { float* wi = (float*)(mx + EV_WI) + (size_t)row * 8; *(f32x4*)wi = x1; *(f32x4*)(wi + 4) = x2; }
                }
            } }
    }
};

__device__ __forceinline__ void ph_yconv(unsigned char* mx, const float* convw, int G, int bid) {
    const bf16_t* U = (const bf16_t*)(mx + EV_U); const bf16_t* Bb = (const bf16_t*)(mx + EV_B); bf16_t* Y = (bf16_t*)(mx + EV_Y);
    for (int it = bid * 512 + otid(); it < NTOK * 64; it += G * 512) { const int row = it >> 6, c = (it & 63) * 8, t = row & (SEQ - 1);
        float acc[8] = {0.f, 0.f, 0.f, 0.f, 0.f, 0.f, 0.f, 0.f};
#pragma unroll
        for (int j = 0; j < 3; ++j) if (t - 2 + j >= 0) { const u32x4 uv = *(const u32x4*)(U + (size_t)(row - 2 + j) * 512 + c);
            const f32x4 w0 = *(const f32x4*)(convw + j * 512 + c), w1 = *(const f32x4*)(convw + j * 512 + c + 4);
            acc[0] += w0[0] * __uint_as_float(uv.x << 16); acc[1] += w0[1] * __uint_as_float(uv.x & 0xffff0000u); acc[2] += w0[2] * __uint_as_float(uv.y << 16); acc[3] += w0[3] * __uint_as_float(uv.y & 0xffff0000u);
            acc[4] += w1[0] * __uint_as_float(uv.z << 16); acc[5] += w1[1] * __uint_as_float(uv.z & 0xffff0000u); acc[6] += w1[2] * __uint_as_float(uv.w << 16); acc[7] += w1[3] * __uint_as_float(uv.w & 0xffff0000u); }
        const u32x4 bv = *(const u32x4*)(Bb + (size_t)row * 512 + c);
        u32x4 w; w.x = pk2(acc[0] * __uint_as_float(bv.x << 16), acc[1] * __uint_as_float(bv.x & 0xffff0000u)); w.y = pk2(acc[2] * __uint_as_float(bv.y << 16), acc[3] * __uint_as_float(bv.y & 0xffff0000u));
        w.z = pk2(acc[4] * __uint_as_float(bv.z << 16), acc[5] * __uint_as_float(bv.z & 0xffff0000u)); w.w = pk2(acc[6] * __uint_as_float(bv.w << 16), acc[7] * __uint_as_float(bv.w & 0xffff0000u));
        *(u32x4*)(Y + (size_t)row * 1024 + c) = w; }
}

__device__ __forceinline__ int wave_excl_scan_i(int v, int lane) {
    int s = v;
#pragma unroll
    for (int o = 1; o < 64; o <<= 1) { const int t = __shfl_up(s, o); if (lane >= o) s += t; }
    return s - v;
}
__device__ __forceinline__ unsigned f16key2(float a, float b) {
    const unsigned x = __builtin_bit_cast(unsigned, __builtin_amdgcn_cvt_pkrtz(a, b));
    const unsigned s = (x >> 15) & 0x00010001u; return x ^ ((s * 0x7FFFu) | 0x80008000u);
}
typedef float f32x4c __attribute__((ext_vector_type(4)));
typedef unsigned short u16x2v __attribute__((ext_vector_type(2)));
__device__ __forceinline__ unsigned pk_sub16(unsigned a, unsigned b) { return __builtin_bit_cast(unsigned, (u16x2v)(__builtin_bit_cast(u16x2v, a) - __builtin_bit_cast(u16x2v, b))); }
__device__ __forceinline__ unsigned pk_add16(unsigned a, unsigned b) { return __builtin_bit_cast(unsigned, (u16x2v)(__builtin_bit_cast(u16x2v, a) + __builtin_bit_cast(u16x2v, b))); }
__device__ __forceinline__ unsigned pk_shr15(unsigned a) { return __builtin_bit_cast(unsigned, (u16x2v)(__builtin_bit_cast(u16x2v, a) >> (u16x2v){15, 15})); }
__device__ __forceinline__ unsigned pk_min16(unsigned a, unsigned b) { return __builtin_bit_cast(unsigned, __builtin_elementwise_min(__builtin_bit_cast(u16x2v, a), __builtin_bit_cast(u16x2v, b))); }
__device__ __forceinline__ void ph_ev_index(unsigned char* mx, int G, int bid) {
    const int tid = otid(), lane = tid & 63, wid = __builtin_amdgcn_readfirstlane(tid >> 6), n16 = lane & 15, g4 = lane >> 4;
    const bf16_t* Qi = (const bf16_t*)(mx + EV_QI); const bf16_t* Ki = (const bf16_t*)(mx + EV_KI); const float* Wi = (const float*)(mx + EV_WI);
    unsigned short* S16 = (unsigned short*)(mx + EV_S16) + (size_t)bid * 16 * 8192; unsigned* BM = (unsigned*)(mx + EV_BM);
    for (int p = bid; p < 256; p += G)
    for (int it = 0; it < 4; ++it) {
        const int b = it >> 1, grp = (it & 1) ? 511 - p : p, q0 = grp * 16, tokbase = b * SEQ;
        const int nt = (q0 + 16 + 63) >> 6;
#ifndef EVX_SC
#define EVX_SC 1
#define EVX_SEL 1
#define EVX_YC 1
#endif
        for (int rp_ = 0; rp_ < EVX_SC; ++rp_)
        {
            bf16x8 qf[8][2]; float wv[8];
            { const bf16_t* qp = Qi + (size_t)(tokbase + q0 + n16) * 512 + g4 * 8;
#pragma unroll
              for (int h = 0; h < 8; ++h) { qf[h][0] = *(const bf16x8*)(qp + h * 64); qf[h][1] = *(const bf16x8*)(qp + h * 64 + 32); }
              const f32x4 w0 = *(const f32x4*)(Wi + (size_t)(tokbase + q0 + n16) * 8), w1 = *(const f32x4*)(Wi + (size_t)(tokbase + q0 + n16) * 8 + 4);
              wv[0] = 0.5f * w0[0]; wv[1] = 0.5f * w0[1]; wv[2] = 0.5f * w0[2]; wv[3] = 0.5f * w0[3]; wv[4] = 0.5f * w1[0]; wv[5] = 0.5f * w1[1]; wv[6] = 0.5f * w1[2]; wv[7] = 0.5f * w1[3]; }
            bf16x8 qh[2], ql[2];
#pragma unroll
            for (int ks = 0; ks < 2; ++ks) { float cq[8];
#pragma unroll
                for (int j = 0; j < 8; ++j) { float a = 0.f;
#pragma unroll
                    for (int h = 0; h < 8; ++h) a += wv[h] * __uint_as_float(((unsigned)(unsigned short)qf[h][ks][j]) << 16);
                    cq[j] = a; }
                unsigned hw[4], lw4[4];
#pragma unroll
                for (int j = 0; j < 4; ++j) { hw[j] = pk2(cq[2 * j], cq[2 * j + 1]); lw4[j] = pk2(cq[2 * j] - __uint_as_float(hw[j] << 16), cq[2 * j + 1] - __uint_as_float(hw[j] & 0xffff0000u)); }
                qh[ks] = __builtin_bit_cast(bf16x8, (u32x4){hw[0], hw[1], hw[2], hw[3]}); ql[ks] = __builtin_bit_cast(bf16x8, (u32x4){lw4[0], lw4[1], lw4[2], lw4[3]}); }
            bf16x8 afA[4][2], afB[4][2];
#define EV_KP(tt) (Ki + (size_t)(tokbase + (tt) * 64 + 16 * (n16 >> 2) + (n16 & 3)) * 64 + g4 * 8)
#define EV_LDK(dst, tt) do { const bf16_t* kp_ = EV_KP(tt); \
                _Pragma("unroll") for (int mt = 0; mt < 4; ++mt) { dst[mt][0] = *(const bf16x8*)(kp_ + (size_t)(4 * mt) * 64); dst[mt][1] = *(const bf16x8*)(kp_ + (size_t)(4 * mt) * 64 + 32); } } while (0)
#define EV_TILE(AF, AFN, tt) do { const int t_ = (tt), k0 = t_ * 64; EV_LDK(AFN, (t_ + 8 < ntl) ? t_ + 8 : t_); \
                unsigned kw[8]; \
                _Pragma("unroll") for (int mt = 0; mt < 4; ++mt) { \
                    f32x4c a[8], lh, ll; const f32x4c z4 = {0.f, 0.f, 0.f, 0.f}; \
                    _Pragma("unroll") for (int h = 0; h < 8; ++h) a[h] = __builtin_amdgcn_mfma_f32_16x16x32_bf16(AF[mt][0], qf[h][0], z4, 0, 0, 0); \
                    lh = __builtin_amdgcn_mfma_f32_16x16x32_bf16(AF[mt][0], qh[0], z4, 0, 0, 0); ll = __builtin_amdgcn_mfma_f32_16x16x32_bf16(AF[mt][0], ql[0], z4, 0, 0, 0); \
                    __builtin_amdgcn_sched_barrier(0); \
                    _Pragma("unroll") for (int h = 0; h < 8; ++h) a[h] = __builtin_amdgcn_mfma_f32_16x16x32_bf16(AF[mt][1], qf[h][1], a[h], 0, 0, 0); \
                    lh = __builtin_amdgcn_mfma_f32_16x16x32_bf16(AF[mt][1], qh[1], lh, 0, 0, 0); ll = __builtin_amdgcn_mfma_f32_16x16x32_bf16(AF[mt][1], ql[1], ll, 0, 0, 0); \
                    __builtin_amdgcn_sched_barrier(0); \
                    f32x4c sc; \
                    _Pragma("unroll") for (int r = 0; r < 4; ++r) sc[r] = __builtin_fabsf(a[0][r]) * wv[0]; \
                    _Pragma("unroll") for (int h = 1; h < 8; ++h) _Pragma("unroll") for (int r = 0; r < 4; ++r) sc[r] = __builtin_fmaf(__builtin_fabsf(a[h][r]), wv[h], sc[r]); \
                    _Pragma("unroll") for (int r = 0; r < 4; ++r) sc[r] += lh[r] + ll[r]; \
                    kw[2 * mt] = f16key2(sc[0], sc[1]); kw[2 * mt + 1] = f16key2(sc[2], sc[3]); \
                    if (k0 + 63 > q0) {     \
                        const int kb = k0 + 16 * g4 + 4 * mt, tq = q0 + n16; \
                        if (kb + 0 > tq) kw[2 * mt] &= 0xFFFF0000u; if (kb + 1 > tq) kw[2 * mt] &= 0x0000FFFFu; \
                        if (kb + 2 > tq) kw[2 * mt + 1] &= 0xFFFF0000u; if (kb + 3 > tq) kw[2 * mt + 1] &= 0x0000FFFFu; } \
                    __builtin_amdgcn_sched_barrier(0); } \
                unsigned short* dst = S16 + (size_t)n16 * 8192 + k0 + 16 * g4; \
                u32x4 s0, s1; s0.x = kw[0]; s0.y = kw[1]; s0.z = kw[2]; s0.w = kw[3]; s1.x = kw[4]; s1.y = kw[5]; s1.z = kw[6]; s1.w = kw[7]; \
                *(u32x4*)dst = s0; *(u32x4*)(dst + 8) = s1; } while (0)
#if defined(EVX_MODE) && EVX_MODE == 3
            const int ntl = (rp_ + 1 == EVX_SC) ? nt : (nt < 8 ? nt : 8);
#else
            const int ntl = nt;
#endif
            if (wid < ntl) { EV_LDK(afB, wid);
                for (int t = wid; t < ntl; t += 8) {
#pragma unroll
                    for (int mt = 0; mt < 4; ++mt) { afA[mt][0] = afB[mt][0]; afA[mt][1] = afB[mt][1]; }
                    EV_TILE(afA, afB, t); } }
#undef EV_TILE
#undef EV_LDK
#undef EV_KP
        }
        asm volatile("s_waitcnt vmcnt(0)" ::: "memory"); __syncthreads();
        for (int rp_ = 0; rp_ < EVX_SEL; ++rp_)
        for (int rr = 0; rr < 2; ++rr) { const int row = 2 * wid + rr, t = q0 + row, n = t + 1;
            unsigned* bm = BM + (size_t)(tokbase + t) * 256;
            if (n <= 256) { if (lane < 8) { const int lo = lane * 32; bm[lane] = (n >= lo + 32) ? 0xFFFFFFFFu : (n > lo ? ((1u << (n - lo)) - 1u) : 0u); } }
            else {
                const int npad = nt * 64, jmax = (npad + 511) >> 9; const unsigned short* srow = S16 + (size_t)row * 8192;
                u32x4 x[16];
#pragma unroll
                for (int j = 0; j < 16; ++j) { x[j] = (u32x4){0u, 0u, 0u, 0u}; if (j < jmax) { const int c = 64 * j + lane; if (8 * c < npad) x[j] = *(const u32x4*)(srow + 8 * c); } }
                int cpos = 0;
#pragma unroll
                for (int j = 0; j < 16; ++j) if (j < jmax) {
#pragma unroll
                    for (int q = 0; q < 4; ++q) { const unsigned v = x[j][q]; cpos += (int)(v >> 31) + (int)((v >> 15) & 1u); } }
                cpos = wave_sum_i(cpos); const bool hi = cpos >= 256;
                u32x4 w[16];
#pragma unroll
                for (int j = 0; j < 16; ++j) { w[j] = (u32x4){0u, 0u, 0u, 0u}; if (j < jmax) {
#pragma unroll
                    for (int q = 0; q < 4; ++q) { const unsigned v = x[j][q]; if (hi) { const unsigned m = v & 0x80008000u; w[j][q] = v & (m - (m >> 15)); } else w[j][q] = pk_min16(v, 0x7FFF7FFFu); } } }
                const int ntot = jmax * 512; unsigned lo15 = 0u;
                for (int bit = 14; bit >= 0; --bit) { const unsigned c = lo15 | (1u << bit), c2 = c * 0x10001u; unsigned acc = 0u;
#pragma unroll
                    for (int j = 0; j < 16; ++j) if (j < jmax) {
#pragma unroll
                        for (int q = 0; q < 4; ++q) acc = pk_add16(acc, pk_shr15(pk_sub16(w[j][q], c2))); }
                    const int lt = wave_sum_i((int)((acc & 0xFFFFu) + (acc >> 16))); if (ntot - lt >= 256) lo15 = c; }
                const unsigned lo = hi ? (0x8000u | lo15) : lo15;
                const unsigned tau = lo; int cg = 0;
#pragma unroll
                for (int j = 0; j < 16; ++j) if (j < jmax) {
#pragma unroll
                    for (int q = 0; q < 4; ++q) { const unsigned v = x[j][q]; cg += ((v & 0xFFFFu) > tau ? 1 : 0) + ((v >> 16) > tau ? 1 : 0); } }
                const int need = 256 - wave_sum_i(cg); int R = 0;
#pragma unroll
                for (int j = 0; j < 16; ++j) if (j < jmax) {
                    int tc = 0;
#pragma unroll
                    for (int q = 0; q < 4; ++q) { const unsigned v = x[j][q]; tc += ((v & 0xFFFFu) == tau ? 1 : 0) + ((v >> 16) == tau ? 1 : 0); }
                    const int Tj = wave_sum_i(tc); int quota = (R + Tj <= need) ? tc : 0;
                    if (R < need && R + Tj > need) { const int P = wave_excl_scan_i(tc, lane); quota = min(max(need - R - P, 0), tc); }
                    R += Tj;
                    unsigned byte = 0u; int taken = 0;
#pragma unroll
                    for (int e = 0; e < 8; ++e) { const unsigned k = (e & 1) ? (x[j][e >> 1] >> 16) : (x[j][e >> 1] & 0xFFFFu);
                        bool s = k > tau; if (k == tau) { s = taken < quota; ++taken; } byte |= (s ? 1u : 0u) << e; }
                    unsigned w = byte << (8 * (lane & 3)); w |= (unsigned)dpp_i((int)w, 0xB1); w |= (unsigned)dpp_i((int)w, 0x4E);
                    if ((lane & 3) == 0) bm[(64 * j + lane) >> 2] = w; }
            }
        }
        __syncthreads();
    }
}

namespace at64 {
using bf16 = unsigned short;
using bf16x8 = __attribute__((ext_vector_type(8))) short;
using s16x4 = __attribute__((ext_vector_type(4))) short;
using f32x16 = __attribute__((ext_vector_type(16))) float;
using u32x4 = __attribute__((ext_vector_type(4))) unsigned;
constexpr int BATCH = 2, NHEAD = 8, SEQ = 8192, D = 64, DM = NHEAD * D, DMO = 1024, OCOL = 512;
#define ATTN64_THR 8
#define ATTN64_BROKEN 0
constexpr int NW = 8, QBLK = 32, QB = QBLK * NW, KVBLK = 64, NQB = SEQ / QB;
constexpr float C2 = 0.125f * 1.4426950408889634f;
constexpr int SLOTB = 8192, LDS_K = 0, LDS_V = 3 * SLOTB, LDS_WS = 6 * SLOTB, LDS_OST = LDS_WS + NW * 256, LDS_MSK = LDS_OST + NW * 4096, LDS_BYTES = LDS_MSK + NW * 2048;
#define SBAR() __builtin_amdgcn_sched_barrier(0)
#define PIN(x) asm volatile("" : "+v"(x))
#define MFMA(a, b, c) __builtin_amdgcn_mfma_f32_32x32x16_bf16(a, b, c, 0, 0, 0)
#define WAIT_BAR(N) asm volatile("s_waitcnt vmcnt(" #N ") lgkmcnt(0)\n\ts_barrier" ::: "memory")

__device__ __forceinline__ int crow(int r, int hi) { return (r & 3) + 8 * (r >> 2) + 4 * hi; }
__device__ __forceinline__ unsigned cvtpk(float lo, float hi) { unsigned r; asm("v_cvt_pk_bf16_f32 %0, %1, %2" : "=v"(r) : "v"(lo), "v"(hi)); return r; }
__device__ __forceinline__ void glds16(const void* g, unsigned lds_base) {
    unsigned sv; asm volatile("s_mov_b32 %0, m0\n\ts_mov_b32 m0, %2\n\ts_nop 0\n\tglobal_load_lds_dwordx4 %1, off\n\ts_mov_b32 m0, %0" : "=&s"(sv) : "v"(g), "s"(lds_base) : "memory"); }
typedef __attribute__((address_space(3))) const char* lds_cptr;
typedef short v4i16_t __attribute__((ext_vector_type(4)));
__device__ __forceinline__ void kload2(bf16x8* kf, lds_cptr kp, int d0) { kf[2 * d0] = *(const __attribute__((address_space(3))) bf16x8*)(kp + d0 * 2048); kf[2 * d0 + 1] = *(const __attribute__((address_space(3))) bf16x8*)(kp + d0 * 2048 + 512); }
__device__ __forceinline__ s16x4 vtr(lds_cptr p) { return __builtin_bit_cast(s16x4, __builtin_amdgcn_ds_read_tr16_b64_v4i16((__attribute__((address_space(3))) v4i16_t*)p)); }
#define MX3(a, b, c) __builtin_fmaxf(__builtin_fmaxf((a), (b)), (c))
__device__ __forceinline__ float rowmax(const f32x16& p0, const f32x16& p1) {
    float a = MX3(p0[0], p0[1], p1[0]), b = MX3(p0[2], p0[3], p1[1]); a = MX3(a, p1[2], p1[3]);
#pragma unroll
    for (int r = 4; r < 16; r += 4) { a = MX3(a, p0[r], p0[r + 1]); b = MX3(b, p0[r + 2], p0[r + 3]); a = MX3(a, p1[r], p1[r + 1]); b = MX3(b, p1[r + 2], p1[r + 3]); }
    float m = __builtin_fmaxf(a, b); auto rr = __builtin_amdgcn_permlane32_swap(__float_as_uint(m), __float_as_uint(m), false, false);
    return __builtin_fmaxf(__uint_as_float(rr[0]), __uint_as_float(rr[1])); }
__device__ __forceinline__ void cmask(f32x16& p0, f32x16& p1, int jb, int qrel, int hi) {
    const int kb = 64 * jb + 4 * hi;
#pragma unroll
    for (int r = 0; r < 16; ++r) { const int kv = kb + (r & 3) + 8 * (r >> 2); if (kv > qrel) p0[r] = -INFINITY; if (kv + 32 > qrel) p1[r] = -INFINITY; } }

__device__ __forceinline__ void attn64_unit(int b, int h, int qb, const bf16* Q, const bf16* __restrict__ K, const bf16* __restrict__ V, const unsigned* __restrict__ BM, bf16* O, char* lds) {
    int tid_ = threadIdx.x; asm volatile("" : "+v"(tid_)); const int tid = tid_, lane = tid & 63, r32 = lane & 31, hi = lane >> 5; const int wid = __builtin_amdgcn_readfirstlane(tid >> 6);
    const long rowbase = (long)b * SEQ; const int q0 = qb * QB, NT = (q0 + QB) / KVBLK;
    const bf16* Qw = Q + (rowbase + q0 + wid * QBLK) * DM + h * D;
    const unsigned lds0 = (unsigned)(uintptr_t)lds; float* wsf = (float*)(lds + LDS_WS) + wid * 64;
    const bf16* ksrc = K + rowbase * DM + h * D + (long)lane * DM + wid * 8;
    const bf16* vsrc = V + rowbase * DM + h * D + (long)(16 * (wid & 3) + (lane >> 2)) * DM + (wid >> 2) * 32 + (lane & 3) * 8;
    const unsigned kdst = lds0 + LDS_K + wid * 1024, vdst = lds0 + LDS_V + wid * 1024;
#define DMA_K(t, slot) glds16(ksrc + (long)(t) * KVBLK * DM, (unsigned)__builtin_amdgcn_readfirstlane(kdst + (slot)))
#define DMA_V(t, slot) glds16(vsrc + (long)(t) * KVBLK * DM, (unsigned)__builtin_amdgcn_readfirstlane(vdst + (slot)))
    const unsigned* msrc = BM + (size_t)(rowbase + q0 + wid * QBLK + r32) * 256;
    const unsigned mdst = lds0 + LDS_MSK + wid * 2048;
    const lds_cptr mrd = (lds_cptr)lds + LDS_MSK + wid * 2048 + r32 * 16;
#define DMA_M(c) glds16(msrc + (c) * 4, (unsigned)__builtin_amdgcn_readfirstlane(mdst + ((c) & 1) * 1024))
#define BMASK(P0, P1, t) do { const unsigned long long mw_ = *(const __attribute__((address_space(3))) unsigned long long*)(mrd + (((t) >> 1) & 1) * 1024 + ((t) & 1) * 8); \
        const unsigned w0_ = (unsigned)mw_ >> (4 * hi), w1_ = (unsigned)(mw_ >> 32) >> (4 * hi); \
        _Pragma("unroll") for (int r = 0; r < 16; ++r) { const int bp_ = (r & 3) + 8 * (r >> 2); \
            const unsigned m0_ = (unsigned)(((int)(w0_ << (31 - bp_))) >> 31), m1_ = (unsigned)(((int)(w1_ << (31 - bp_))) >> 31); \
            P0[r] = __uint_as_float((__float_as_uint(P0[r]) & m0_) | (0xFF800000u & ~m0_)); P1[r] = __uint_as_float((__float_as_uint(P1[r]) & m1_) | (0xFF800000u & ~m1_)); } } while (0)
    const lds_cptr vp0 = (lds_cptr)lds + LDS_V + ((lane >> 4) & 1) * 32 + (lane & 3) * 8 + (4 * hi + ((lane & 15) >> 2)) * 64;
    const lds_cptr kp0 = (lds_cptr)lds + LDS_K + hi * 1024 + r32 * 16;
    DMA_M(0);
    DMA_K(0, 0); DMA_V(0, 0); DMA_K(1, SLOTB);
    bf16x8 qr[4];
#pragma unroll
    for (int d0 = 0; d0 < 4; ++d0) qr[d0] = *reinterpret_cast<const bf16x8*>(&Qw[(long)r32 * DM + d0 * 16 + hi * 8]);
    float mhat = 0.f, l_reg = 0.f; f32x16 o[2]; o[0] = f32x16{}; o[1] = f32x16{};
    f32x16 zero16 = f32x16{}; PIN(zero16);
    const int qrel = wid * QBLK + r32; bool resc = false;
    f32x16 pA0, pA1, pB0, pB1; bf16x8 kf[8]; s16x4 vlo[8], vhi[8]; u32x4 pw0, pw1, pw2, pw3;
    int sl_prev = 0, sl_cur = 0, sl_next = SLOTB;
#define ROT() do { sl_prev = sl_cur; sl_cur = sl_next; sl_next = (sl_next == 2 * SLOTB) ? 0 : sl_next + SLOTB; } while (0)
#define EX(v) __builtin_amdgcn_exp2f(v)
#define RESC() do { if (resc && !ATTN64_BROKEN) { _Pragma("unroll") for (int d_ = 0; d_ < 2; ++d_) _Pragma("unroll") for (int r = 0; r < 16; ++r) o[d_][r] *= wsf[crow(r, hi)]; } } while (0)
    DMA_K(2, 2 * SLOTB);
    WAIT_BAR(3);
    _Pragma("unroll") for (int d0 = 0; d0 < 4; ++d0) kload2(kf, kp0, d0);
    pA0 = MFMA(kf[0], qr[0], zero16); pA1 = MFMA(kf[1], qr[0], zero16); pA0 = MFMA(kf[2], qr[1], pA0); pA1 = MFMA(kf[3], qr[1], pA1);
    pA0 = MFMA(kf[4], qr[2], pA0); pA1 = MFMA(kf[5], qr[2], pA1); pA0 = MFMA(kf[6], qr[3], pA0); pA1 = MFMA(kf[7], qr[3], pA1);
    if (NT == 4) cmask(pA0, pA1, 0, qrel, hi);
    BMASK(pA0, pA1, 0);
    { const float rm = rowmax(pA0, pA1); mhat = __builtin_fmaxf(rm, -200.f); const float nmh = -mhat;
#pragma unroll
      for (int r = 0; r < 16; ++r) { pA0[r] = EX(pA0[r] + nmh); pA1[r] = EX(pA1[r] + nmh); }
#pragma unroll
      for (int r = 0; r < 16; ++r) zero16[r] = nmh;
      PIN(zero16); }
    WAIT_BAR(0);
    DMA_K(3, 0); DMA_V(1, SLOTB); ROT();
    _Pragma("unroll") for (int d0 = 0; d0 < 4; ++d0) kload2(kf, kp0 + sl_cur, d0);
    WAIT_BAR(2);
#define PKW(P, i) cvtpk(P[i], P[i + 1])
#define PAF(k) __builtin_bit_cast(bf16x8, pw##k)
#define VFR(i) (bf16x8){vlo[i][0], vlo[i][1], vlo[i][2], vlo[i][3], vhi[i][0], vhi[i][1], vhi[i][2], vhi[i][3]}
#define VRD(i) do { vlo[i] = vtr(vp_ + (((i) >> 2) * 4096 + ((i) & 3) * 1024)); vhi[i] = vtr(vp_ + (((i) >> 2) * 4096 + ((i) & 3) * 1024 + 512)); } while (0)
#define KRD(G, d0) do { if (G) { kload2(kf, kp0 + sl_next, d0); SBAR(); } } while (0)
#define GAPA(MF, a0, a1, a2, a3, W0, W1, PW) do { MF; sacc += a0; sacc += a1; sacc += a2; sacc += a3; W0; W1; PIN(PW); PIN(sacc); SBAR(); } while (0)
#define GAPB(MF, X, i) do { MF; X[i] = EX(X[i]); X[i + 1] = EX(X[i + 1]); X[i + 2] = EX(X[i + 2]); X[i + 3] = EX(X[i + 3]); PIN(X); SBAR(); } while (0)
#define STEP(C0, C1, P0, P1, t, MASK, GK, GV, GL, GM) do { SBAR(); \
    const lds_cptr vp_ = vp0 + sl_prev; \
    VRD(0); SBAR(); float sacc = P0[0] + P0[1];                                                                                                       \
                    GAPA(C0 = MFMA(kf[0], qr[0], zero16), P0[2], P0[3], P0[4], P0[5],     pw0[0] = PKW(P0, 0),  pw0[1] = PKW(P0, 2),  pw0); \
    VRD(4); SBAR(); GAPA(C1 = MFMA(kf[1], qr[0], zero16), P0[6], P0[7], P0[8], P0[9],     pw0[2] = PKW(P0, 4),  pw0[3] = PKW(P0, 6),  pw0); \
    VRD(1); SBAR(); GAPA(C0 = MFMA(kf[2], qr[1], C0),    P0[10], P0[11], P0[12], P0[13], pw1[0] = PKW(P0, 8),  pw1[1] = PKW(P0, 10), pw1); \
    VRD(5); SBAR(); GAPA(C1 = MFMA(kf[3], qr[1], C1),    P0[14], P0[15], P1[0], P1[1],   pw1[2] = PKW(P0, 12), pw1[3] = PKW(P0, 14), pw1); \
    VRD(2); SBAR(); GAPA(C0 = MFMA(kf[4], qr[2], C0),    P1[2], P1[3], P1[4], P1[5],     pw2[0] = PKW(P1, 0),  pw2[1] = PKW(P1, 2),  pw2); \
    VRD(6); SBAR(); GAPA(C1 = MFMA(kf[5], qr[2], C1),    P1[6], P1[7], P1[8], P1[9],     pw2[2] = PKW(P1, 4),  pw2[3] = PKW(P1, 6),  pw2); \
    VRD(3); SBAR(); GAPA(C0 = MFMA(kf[6], qr[3], C0),    P1[10], P1[11], P1[12], P1[13], pw3[0] = PKW(P1, 8),  pw3[1] = PKW(P1, 10), pw3); \
    VRD(7); SBAR(); GAPA(C1 = MFMA(kf[7], qr[3], C1),    P1[14], P1[15], 0.f, 0.f,       pw3[2] = PKW(P1, 12), pw3[3] = PKW(P1, 14), pw3); \
    l_reg += sacc; \
    if (GM) DMA_M(((t) + 1) >> 1); if (GK) DMA_K((t) + 3, sl_cur); if (GV) DMA_V((t) + 1, sl_next);                                                       \
    if (MASK) cmask(C0, C1, (t) - (NT - 4), qrel, hi); BMASK(C0, C1, (t)); \
    { const float rm = rowmax(C0, C1); resc = false;                                                                       \
      if (__builtin_expect(__any(rm > (float)ATTN64_THR), 0)) { const float dl = __builtin_fmaxf(rm, 0.f); mhat += dl;     \
          const float f = __builtin_amdgcn_exp2f(-dl); l_reg *= f; if (hi == 0) wsf[r32] = f; resc = true; \
          _Pragma("unroll") for (int r = 0; r < 16; ++r) { C0[r] -= dl; C1[r] -= dl; zero16[r] = -mhat; } PIN(zero16); } } \
    SBAR(); \
    GAPB(o[0] = MFMA(PAF(0), VFR(0), o[0]), C0, 0);              GAPB(o[1] = MFMA(PAF(0), VFR(4), o[1]), C0, 4); \
    KRD(GL, 0); GAPB(o[0] = MFMA(PAF(1), VFR(1), o[0]), C0, 8);  KRD(GL, 1); GAPB(o[1] = MFMA(PAF(1), VFR(5), o[1]), C0, 12);                                     \
    KRD(GL, 2); GAPB(o[0] = MFMA(PAF(2), VFR(2), o[0]), C1, 0);  KRD(GL, 3); GAPB(o[1] = MFMA(PAF(2), VFR(6), o[1]), C1, 4); \
    GAPB(o[0] = MFMA(PAF(3), VFR(3), o[0]), C1, 8);              GAPB(o[1] = MFMA(PAF(3), VFR(7), o[1]), C1, 12); \
    } while (0)
    int t = 1;
    for (; t + 5 < NT; t += 2) {
        STEP(pB0, pB1, pA0, pA1, t, false, true, true, true, true);     WAIT_BAR(2); RESC(); ROT();
        STEP(pA0, pA1, pB0, pB1, t + 1, false, true, true, true, false); WAIT_BAR(2); RESC(); ROT();
    }
#define ENDW(tt) do { if ((tt) + 3 < NT) { WAIT_BAR(2); } else if ((tt) + 2 < NT) { WAIT_BAR(1); } else { WAIT_BAR(0); } } while (0)
    for (; t + 1 < NT; t += 2) {
        STEP(pB0, pB1, pA0, pA1, t, true, (t + 3 < NT), (t + 1 < NT), (t + 1 < NT), (t + 1 < NT));         ENDW(t);     RESC(); ROT();
        STEP(pA0, pA1, pB0, pB1, t + 1, true, (t + 4 < NT), (t + 2 < NT), (t + 2 < NT), false);     ENDW(t + 1); RESC(); ROT();
    }
    STEP(pB0, pB1, pA0, pA1, NT - 1, true, false, false, false, false); RESC();
    { float sacc = pB0[0] + pB0[1];
#pragma unroll
      for (int r = 2; r < 16; ++r) sacc += pB0[r];
#pragma unroll
      for (int r = 0; r < 16; ++r) sacc += pB1[r];
      l_reg += sacc;
      pw0 = (u32x4){PKW(pB0, 0), PKW(pB0, 2), PKW(pB0, 4), PKW(pB0, 6)}; pw1 = (u32x4){PKW(pB0, 8), PKW(pB0, 10), PKW(pB0, 12), PKW(pB0, 14)};
      pw2 = (u32x4){PKW(pB1, 0), PKW(pB1, 2), PKW(pB1, 4), PKW(pB1, 6)}; pw3 = (u32x4){PKW(pB1, 8), PKW(pB1, 10), PKW(pB1, 12), PKW(pB1, 14)};
      const lds_cptr vp_ = vp0 + sl_cur; _Pragma("unroll") for (int i = 0; i < 8; ++i) VRD(i);
      o[0] = MFMA(PAF(0), VFR(0), o[0]); o[1] = MFMA(PAF(0), VFR(4), o[1]); o[0] = MFMA(PAF(1), VFR(1), o[0]); o[1] = MFMA(PAF(1), VFR(5), o[1]);
      o[0] = MFMA(PAF(2), VFR(2), o[0]); o[1] = MFMA(PAF(2), VFR(6), o[1]); o[0] = MFMA(PAF(3), VFR(3), o[0]); o[1] = MFMA(PAF(3), VFR(7), o[1]); }
    { auto rr = __builtin_amdgcn_permlane32_swap(__float_as_uint(l_reg), __float_as_uint(l_reg), false, false); l_reg = __uint_as_float(rr[0]) + __uint_as_float(rr[1]); }
    if (hi == 0) wsf[32 + r32] = l_reg; asm volatile("s_waitcnt lgkmcnt(0)" ::: "memory");
    float rli[16];
#pragma unroll
    for (int r = 0; r < 16; ++r) rli[r] = __builtin_amdgcn_rcpf(wsf[32 + crow(r, hi)]);
    bf16* Ow = O + (rowbase + q0 + wid * QBLK) * DMO + OCOL + h * D; bf16* stg = (bf16*)(lds + LDS_OST) + wid * 2048;
#pragma unroll
    for (int r = 0; r < 16; ++r) { const int orow = crow(r, hi);
#pragma unroll
        for (int d0 = 0; d0 < 2; ++d0) stg[orow * 64 + d0 * 32 + r32] = (bf16)(cvtpk(o[d0][r] * rli[r], 0.f) & 0xffffu); }
    asm volatile("s_waitcnt lgkmcnt(0)" ::: "memory");
#pragma unroll
    for (int i = 0; i < 4; ++i) { const int row = i * 8 + (lane >> 3), ch = lane & 7; *(u32x4*)(Ow + (long)row * DMO + ch * 8) = *(const u32x4*)(stg + row * 64 + ch * 8); }
    asm volatile("s_waitcnt lgkmcnt(0)\n\ts_barrier" ::: "memory");
#undef DMA_K
#undef DMA_V
#undef DMA_M
#undef BMASK
#undef ROT
#undef EX
#undef RESC
#undef PKW
#undef PAF
#undef VFR
#undef VRD
#undef KRD
#undef ENDW
#undef GAPA
#undef GAPB
#undef STEP
}
#undef SBAR
#undef PIN
#undef MFMA
#undef WAIT_BAR
#undef MX3
}

constexpr size_t OD_PRE = 0, OD_SSN = 0, OD_Y = 64 * MB, OD_ZS = 96 * MB, OD_ITEMS = 128 * MB, OD_EG = 272 * MB, OD_EK = OD_EG + 512 * 1024, OD_DL = OD_EK + 512 * 1024;
constexpr int IT_WP = 0, IT_QP = 8192, IT_KT = 16384, IT_IN = 24576, IT_UT = 28672, IT_ELEMS = 36864;

struct EpiOdIn {
    static constexpr bool PERM = true, AFTER_DRAIN = false, RESID_LDS = false; static constexpr int KROT = 0;
    unsigned char* mx; const float* ss;
    __device__ __forceinline__ void operator()(const f32x4 (&acc)[2][2][4][2], const Unit& u, int wr, int wc, int fr, int fq) const {
        const int row0 = u.pm * 256 + wr * 64 + fr, pn = u.pn;
#pragma unroll
        for (int ai = 0; ai < 2; ++ai) { float rs[4]; rows_rstd4(ss, row0 + ai * 128, fr, fq, rs);
#pragma unroll
            for (int m = 0; m < 4; ++m) { const int row = row0 + ai * 128 + m * 16; const float r = rs[m];
#pragma unroll
                for (int bj = 0; bj < 2; ++bj) { f32x4 a = acc[ai][bj][m][0] * r, b = acc[ai][bj][m][1] * r;
                    if (pn >= 12) {
#pragma unroll
                        for (int j = 0; j < 4; ++j) { a[j] = silu_f(a[j]); b[j] = silu_f(b[j]); } }
                    u32x4 w; w.x = pk2(a[0], a[1]); w.y = pk2(a[2], a[3]); w.z = pk2(b[0], b[1]); w.w = pk2(b[2], b[3]);
                    if (pn < 12) *(u32x4*)((bf16_t*)(mx + OD_PRE) + (size_t)row * 3072 + pn * 256 + bj * 128 + wc * 32 + 8 * fq) = w;
                    else *(u32x4*)((bf16_t*)(mx + OD_ZS) + (size_t)row * 1024 + (pn - 12) * 256 + bj * 128 + wc * 32 + 8 * fq) = w; }
            } }
    }
};

typedef short s16x4v __attribute__((ext_vector_type(4)));
__device__ __forceinline__ bf16x8 tr_frag(LAS const unsigned char* p) {
    const s16x4v lo = __builtin_amdgcn_ds_read_tr16_b64_v4i16((LAS s16x4v*)p);
    const s16x4v hi = __builtin_amdgcn_ds_read_tr16_b64_v4i16((LAS s16x4v*)(p + 4 * 272));
    return (bf16x8){lo[0], lo[1], lo[2], lo[3], hi[0], hi[1], hi[2], hi[3]};
}
typedef float f32x4d __attribute__((ext_vector_type(4)));
typedef unsigned u32x2 __attribute__((ext_vector_type(2)));

constexpr int PL_Q = 0, PL_K = 17408, PL_V = 34816, PL_AM = 52224, PL_T1 = 69632, PL_T2 = 78848, PL_BA = 88064, PL_BETA = 96256, PL_GC = 98304, PL_CW = 100352, PL_END = 112640;

__device__ __forceinline__ void ph_od_prep(LAS unsigned char* lds, unsigned char* mx, const bf16_t* xb, const float* ss, const bf16_t* Wba, const float* convw, const float* a_log, const float* dt_bias, int G, int bid) {
    const int tid = otid(), lane = tid & 63, wid = __builtin_amdgcn_readfirstlane(tid >> 6), n16 = lane & 15, g4 = lane >> 4;
    const bf16_t* PRE = (const bf16_t*)(mx + OD_PRE); bf16_t* ITEMS = (bf16_t*)(mx + OD_ITEMS);
    float* EG = (float*)(mx + OD_EG); float* EK = (float*)(mx + OD_EK); float* DL = (float*)(mx + OD_DL);
    LAS float* BA = (LAS float*)(lds + PL_BA); LAS float* betaS = (LAS float*)(lds + PL_BETA); LAS float* gcS = (LAS float*)(lds + PL_GC);
    LAS float* Am = (LAS float*)(lds + PL_AM);
    for (int bc = bid; bc < 256; bc += G) { const int b = bc >> 7, c = bc & 127, t0 = b * SEQ + 64 * c;
        if (tid < 384) { const int i4 = tid * 4, js = i4 >> 7, ch = i4 & 127; *(LAS f32x4*)(lds + PL_CW + i4 * 4) = *(const f32x4*)(convw + (js / 3) * 3072 + (js % 3) * 1024 + ch); }
        { const int mt = wid & 3, kh = wid >> 2; f32x4d acc = {0.f, 0.f, 0.f, 0.f}, acc1 = {0.f, 0.f, 0.f, 0.f};
          const bf16_t* ap = xb + (size_t)(t0 + 16 * mt + n16) * DM + kh * 512 + g4 * 8; const bf16_t* bp = Wba + (size_t)n16 * DM + kh * 512 + g4 * 8;
          bf16x8 fa[16], fb[16];
#pragma unroll
          for (int ks = 0; ks < 16; ++ks) { fa[ks] = *(const bf16x8*)(ap + ks * 32); fb[ks] = *(const bf16x8*)(bp + ks * 32); }
#pragma unroll
          for (int ks = 0; ks < 16; ks += 2) { acc = __builtin_amdgcn_mfma_f32_16x16x32_bf16(fa[ks], fb[ks], acc, 0, 0, 0); acc1 = __builtin_amdgcn_mfma_f32_16x16x32_bf16(fa[ks + 1], fb[ks + 1], acc1, 0, 0, 0); }
          acc += acc1;
#pragma unroll
          for (int r = 0; r < 4; ++r) BA[(kh * 64 + 16 * mt + 4 * g4 + r) * 16 + n16] = acc[r]; }
        __syncthreads();
        { const int h = wid, tok = lane; const float rs = row_rstd(ss, t0 + tok);
          const float braw = (BA[tok * 16 + h] + BA[(64 + tok) * 16 + h]) * rs, araw = (BA[tok * 16 + 8 + h] + BA[(64 + tok) * 16 + 8 + h]) * rs;
          const float beta = 1.0f / (1.0f + expf(-braw)); const float xs = araw + dt_bias[h]; const float sp = fmaxf(xs, 0.f) + __logf(1.0f + __expf(-fabsf(xs)));
          float gc = -expf(a_log[h]) * sp;
#pragma unroll
          for (int o = 1; o < 64; o <<= 1) { const float t = __shfl_up(gc, o); if (lane >= o) gc += t; }
          const float gl = __shfl(gc, 63);
          betaS[h * 64 + tok] = beta; gcS[h * 64 + tok] = gc;
          const size_t so = (size_t)(b * 8 + h) * SEQ + 64 * c + tok; EG[so] = expf(gc); EK[so] = expf(gl - gc); if (lane == 0) DL[(b * 8 + h) * 128 + c] = expf(gl); }
        __syncthreads();
        for (int h = 0; h < 8; ++h) { bf16_t* itp = ITEMS + (size_t)((b * 8 + h) * 128 + c) * IT_ELEMS;
            const int tid = otid(), lane = tid & 63, n16 = lane & 15, g4 = lane >> 4;
            LAS const float* beta = betaS + h * 64; LAS const float* gc = gcS + h * 64;
#ifndef PRX_B1
#define PRX_B1 1
#define PRX_B2 1
#define PRX_B3 1
#define PRX_B4 1
#endif
            for (int rp1_ = 0; rp1_ < PRX_B1; ++rp1_)
            if (tid < 384) { const int sec = tid >> 7, tg = (tid >> 4) & 7, c8 = tid & 15, chn = sec * 1024 + h * 128 + 8 * c8;
                LAS const float* cw = (LAS const float*)(lds + PL_CW + (h & 1) * 6144) + sec * 128 + 8 * c8;
                u32x4 xr[11];
#pragma unroll
                for (int i = 0; i < 11; ++i) { const int tt = 64 * c + 8 * tg - 3 + i; xr[i] = *(const u32x4*)(PRE + (size_t)(b * SEQ + (tt >= 0 ? tt : 0)) * 3072 + chn); if (tt < 0) xr[i] = (u32x4){0u, 0u, 0u, 0u}; }
#pragma unroll
                for (int tt = 0; tt < 8; ++tt) { float acc[8];
#pragma unroll
                    for (int e = 0; e < 8; ++e) acc[e] = 0.f;
#pragma unroll
                    for (int j = 0; j < 4; ++j) { const u32x4 xv = xr[tt + j]; const f32x4 wl = *(LAS const f32x4*)(cw + j * 384), wh = *(LAS const f32x4*)(cw + j * 384 + 4);
                        acc[0] += wl[0] * __uint_as_float(xv.x << 16); acc[1] += wl[1] * __uint_as_float(xv.x & 0xffff0000u); acc[2] += wl[2] * __uint_as_float(xv.y << 16); acc[3] += wl[3] * __uint_as_float(xv.y & 0xffff0000u);
                        acc[4] += wh[0] * __uint_as_float(xv.z << 16); acc[5] += wh[1] * __uint_as_float(xv.z & 0xffff0000u); acc[6] += wh[2] * __uint_as_float(xv.w << 16); acc[7] += wh[3] * __uint_as_float(xv.w & 0xffff0000u); }
                    float sq = 0.f;
#pragma unroll
                    for (int e = 0; e < 8; ++e) { acc[e] = acc[e] * __builtin_amdgcn_rcpf(1.0f + __expf(-acc[e])); sq += acc[e] * acc[e]; }
                    if (sec < 2) { sq += dpp_f(sq, 0xB1); sq += dpp_f(sq, 0x4E); sq += dpp_f(sq, 0x141); sq += dpp_f(sq, 0x140);
                        const float sc = (1.0f / sqrtf(sq + EPS)) * (sec == 0 ? 0.08838834764831845f : 1.0f);
#pragma unroll
                        for (int e = 0; e < 8; ++e) acc[e] *= sc; }
                    const int tok = 8 * tg + tt; const unsigned p0 = pk2(acc[0], acc[1]), p1 = pk2(acc[2], acc[3]), p2 = pk2(acc[4], acc[5]), p3 = pk2(acc[6], acc[7]);
                    *(LAS u32x4*)(lds + (sec == 0 ? PL_Q : sec == 1 ? PL_K : PL_V) + tok * 272 + c8 * 16) = (u32x4){p0, p1, p2, p3};
                    if (sec == 0) { bf16_t* qd = itp + IT_QP + ((tok >> 4) * 4 + (c8 >> 2)) * 512 + ((2 * (c8 & 1)) * 16 + (tok & 15)) * 8 + 4 * ((c8 >> 1) & 1);
                        *(u32x2*)qd = (u32x2){p0, p1}; *(u32x2*)(qd + 128) = (u32x2){p2, p3}; }
                }
            } else { for (int i = tid - 384; i < 64 * 68; i += 128) Am[i] = 0.f; }
            if (h < 7 && tid < 384) { const int i4 = tid * 4, js = i4 >> 7, ch = i4 & 127; *(LAS f32x4*)(lds + PL_CW + ((h + 1) & 1) * 6144 + i4 * 4) = *(const f32x4*)(convw + (js / 3) * 3072 + (js % 3) * 1024 + (h + 1) * 128 + ch); }
            __syncthreads();
            for (int rp2_ = 0; rp2_ < PRX_B2; ++rp2_)
            for (int tk = wid; tk < 26; tk += 8) {
                if (tk >= 20) { const int z = tk - 20; const int it = z < 3 ? 0 : (z < 5 ? 1 : 2), jt = z < 3 ? z + 1 : (z < 5 ? z - 1 : 3);
                    *(u32x2*)(itp + IT_IN + (it * 2 + (jt >> 1)) * 512 + (g4 * 16 + n16) * 8 + 4 * (jt & 1)) = (u32x2){0u, 0u}; continue; }
                const int kind = tk >= 10, ix = kind ? tk - 10 : tk; const int it = ix < 1 ? 0 : (ix < 3 ? 1 : (ix < 6 ? 2 : 3)), jt = ix - (it * (it + 1)) / 2;
                f32x4d acc = {0.f, 0.f, 0.f, 0.f};
                if (!kind) {
#pragma unroll
                    for (int ks = 0; ks < 4; ++ks) acc = __builtin_amdgcn_mfma_f32_16x16x32_bf16(*(LAS const bf16x8*)(lds + PL_K + (16 * it + n16) * 272 + ks * 64 + g4 * 16), *(LAS const bf16x8*)(lds + PL_K + (16 * jt + n16) * 272 + ks * 64 + g4 * 16), acc, 0, 0, 0);
                    const int j = 16 * jt + n16; const float gj = gc[j];
#pragma unroll
                    for (int r = 0; r < 4; ++r) { const int i = 16 * it + 4 * g4 + r; Am[i * 68 + j] = (i > j) ? acc[r] * beta[i] * expf(gc[i] - gj) : 0.f; }
                } else {
#pragma unroll
                    for (int ks = 0; ks < 4; ++ks) acc = __builtin_amdgcn_mfma_f32_16x16x32_bf16(*(LAS const bf16x8*)(lds + PL_K + (16 * jt + n16) * 272 + ks * 64 + g4 * 16), *(LAS const bf16x8*)(lds + PL_Q + (16 * it + n16) * 272 + ks * 64 + g4 * 16), acc, 0, 0, 0);
                    const int i = 16 * it + n16; const float gi = gc[i]; float v[4];
#pragma unroll
                    for (int r = 0; r < 4; ++r) { const int j = 16 * jt + 4 * g4 + r; v[r] = (i >= j) ? acc[r] * expf(gi - gc[j]) : 0.f; }
                    *(u32x2*)(itp + IT_IN + (it * 2 + (jt >> 1)) * 512 + (g4 * 16 + n16) * 8 + 4 * (jt & 1)) = (u32x2){pk2(v[0], v[1]), pk2(v[2], v[3])};
                }
            }
            __syncthreads();
            for (int rp3_ = 0; rp3_ < PRX_B3; ++rp3_)
            { const int grp = wid < 4 ? wid : 11 - wid; const int cl = lane >> 3, p = lane & 7, ccol = 8 * grp + cl; float tj[8];
#pragma unroll
              for (int s8 = 0; s8 < 8; ++s8) tj[s8] = 0.f;
#pragma unroll
              for (int bi = 0; bi < 8; ++bi) { if (bi < grp) continue; f32x4 a0[8], a1[8];
#pragma unroll
                  for (int r = 0; r < 8; ++r) { a0[r] = *(LAS const f32x4*)(lds + PL_AM + (8 * bi + r) * 272 + p * 32); a1[r] = *(LAS const f32x4*)(lds + PL_AM + (8 * bi + r) * 272 + p * 32 + 16); }
                  float tn[8];
#pragma unroll
                  for (int r = 0; r < 8; ++r) { float sp = (a0[r][0] * tj[0] + a0[r][1] * tj[1]) + (a0[r][2] * tj[2] + a0[r][3] * tj[3]) + (a1[r][0] * tj[4] + a1[r][1] * tj[5]) + (a1[r][2] * tj[6] + a1[r][3] * tj[7]);
                      sp = sum8_f(sp);
                      float acc = ((8 * bi + r) == ccol ? 1.0f : 0.0f) - sp;
#pragma unroll
                      for (int q = 0; q < r; ++q) acc -= (q < 4 ? a0[r][q] : a1[r][q - 4]) * tn[q];
                      tn[r] = acc; }
                  if (p == bi) {
#pragma unroll
                      for (int r = 0; r < 8; ++r) tj[r] = tn[r]; } }
              const float bc1 = beta[ccol], bc2 = bc1 * expf(gc[ccol]);
#pragma unroll
              for (int s8 = 0; s8 < 8; ++s8) { const int j = 8 * p + s8;
                  *(LAS unsigned short*)(lds + PL_T1 + j * 144 + ccol * 2) = (unsigned short)(pk2(tj[s8] * bc1, 0.f) & 0xffffu);
                  *(LAS unsigned short*)(lds + PL_T2 + j * 144 + ccol * 2) = (unsigned short)(pk2(tj[s8] * bc2, 0.f) & 0xffffu); } }
            __syncthreads();
            for (int rp4_ = 0; rp4_ < PRX_B4; ++rp4_)
            { const int q4 = (lane & 15) >> 2, p4 = lane & 3;
              bf16x8 bv[2], ak[2];
#pragma unroll
              for (int ks = 0; ks < 2; ++ks) { bv[ks] = tr_frag(lds + PL_V + (32 * ks + 8 * g4 + q4) * 272 + (16 * wid + 4 * p4) * 2); ak[ks] = tr_frag(lds + PL_K + (32 * ks + 8 * g4 + q4) * 272 + (16 * wid + 4 * p4) * 2); }
#pragma unroll
              for (int it = 0; it < 4; ++it) { f32x4d au = {0.f, 0.f, 0.f, 0.f}, aw = {0.f, 0.f, 0.f, 0.f};
#pragma unroll
                  for (int ks = 0; ks < 2; ++ks) { au = __builtin_amdgcn_mfma_f32_16x16x32_bf16(*(LAS const bf16x8*)(lds + PL_T1 + (16 * it + n16) * 144 + ks * 64 + g4 * 16), bv[ks], au, 0, 0, 0);
                      aw = __builtin_amdgcn_mfma_f32_16x16x32_bf16(ak[ks], *(LAS const bf16x8*)(lds + PL_T2 + (16 * it + n16) * 144 + ks * 64 + g4 * 16), aw, 0, 0, 0); }
                  *(u32x2*)(itp + IT_UT + (16 * wid + n16) * 64 + 16 * it + 4 * g4) = (u32x2){pk2(au[0], au[1]), pk2(au[2], au[3])};
                  *(u32x2*)(itp + IT_WP + (it * 4 + (wid >> 1)) * 512 + (g4 * 16 + n16) * 8 + 4 * (wid & 1)) = (u32x2){pk2(aw[0], aw[1]), pk2(aw[2], aw[3])}; }
              { const int dk = tid >> 2, ksq = (tid >> 1) & 1, aq = tid & 1;
#pragma unroll
                for (int kq = 0; kq < 4; ++kq) { const int j0 = 32 * ksq + 16 * aq + 4 * kq; unsigned short e[4];
#pragma unroll
                    for (int r = 0; r < 4; ++r) e[r] = *(LAS const unsigned short*)(lds + PL_K + (j0 + r) * 272 + dk * 2);
                    *(u32x2*)(itp + IT_KT + ((dk >> 4) * 2 + ksq) * 512 + (kq * 16 + (dk & 15)) * 8 + 4 * aq) = (u32x2){(unsigned)e[0] | ((unsigned)e[1] << 16), (unsigned)e[2] | ((unsigned)e[3] << 16)}; } }
            }
            __syncthreads();
        }
    }
}

__device__ __forceinline__ void glds16(const void* g, unsigned lds_base) {
    unsigned sv; asm volatile("s_mov_b32 %0, m0\n\ts_mov_b32 m0, %2\n\ts_nop 0\n\tglobal_load_lds_dwordx4 %1, off\n\ts_mov_b32 m0, %0" : "=&s"(sv) : "v"(g), "s"(lds_base) : "memory"); }
__device__ __forceinline__ void glds4(const void* g, unsigned lds_base) {
    unsigned sv; asm volatile("s_mov_b32 %0, m0\n\ts_mov_b32 m0, %2\n\ts_nop 0\n\tglobal_load_lds_dword %1, off\n\ts_mov_b32 m0, %0" : "=&s"(sv) : "v"(g), "s"(lds_base) : "memory"); }
__device__ __forceinline__ void glds16s(const void* sbase, unsigned voff, unsigned lds_base) {
    unsigned sv; asm volatile("s_mov_b32 %0, m0\n\ts_mov_b32 m0, %3\n\ts_nop 0\n\tglobal_load_lds_dwordx4 %1, %2\n\ts_mov_b32 m0, %0" : "=&s"(sv) : "v"(voff), "s"(sbase), "s"(lds_base) : "memory"); }
constexpr int SC_BUF = 35840;
#ifndef SC_TOUCH_ON
#define SC_TOUCH_ON 0
#endif
#define SC_BAR() do { __builtin_amdgcn_s_barrier(); asm volatile("" ::: "memory"); } while (0)
#define SC_LBAR() do { asm volatile("s_waitcnt lgkmcnt(0)" ::: "memory"); __builtin_amdgcn_s_barrier(); asm volatile("" ::: "memory"); } while (0)
__device__ __forceinline__ void ph_od_scan(unsigned char* lds_generic, LAS unsigned char* lds, unsigned char* mx, unsigned* tickets, int& role_out, int G, int bid) {
    const int tid = otid(), lane = tid & 63, wid = __builtin_amdgcn_readfirstlane(tid >> 6), n16 = lane & 15, g4 = lane >> 4;
    bf16_t* ITEMS = (bf16_t*)(mx + OD_ITEMS); const float* EG = (const float*)(mx + OD_EG); const float* EK = (const float*)(mx + OD_EK); const float* DL = (const float*)(mx + OD_DL);
    unsigned char* SSN = mx + OD_SSN;
    const unsigned lds0 = (unsigned)(uintptr_t)lds_generic;
    const int wk0 = bid; role_out = bid;
    for (int wk = wk0; wk < 128; wk += G) { const int bh = (wk & 7) + 8 * (wk >> 6), slice = (wk >> 3) & 7, dv0 = slice * 16;
        bf16_t* item0 = ITEMS + (size_t)(bh * 128) * IT_ELEMS;
        if (wid >= 2 && wid <= 4) {
            const int lw = wid - 2; const unsigned lane16 = (unsigned)lane * 16u;
#define SC_LOAD(nn, dbase) do { const char* src_ = (const char*)(item0 + (size_t)(nn) * IT_ELEMS); const size_t so_ = (size_t)bh * SEQ + 64 * (nn); \
                const char* sb_ = src_ + lw * 1024; unsigned md_ = (unsigned)__builtin_amdgcn_readfirstlane((dbase) + lw * 1024); \
                _Pragma("unroll 1") for (int k_ = lw; k_ < 16; k_ += 3) { glds16s(sb_, lane16, md_); glds16s(sb_ + IT_KT * 2, lane16, md_ + 16384); sb_ += 3072; md_ += 3072; } \
                const char* g_ = lw == 1 ? (lane < 16 ? (const char*)(EG + so_ + lane * 4) : lane < 32 ? (const char*)(EK + so_ + (lane - 16) * 4) : lane == 32 ? (const char*)(DL + bh * 128 + ((nn) & ~3)) : (const char*)(EG + so_)) \
                                         : src_ + IT_UT * 2 + dv0 * 128 + (lw == 0 ? 1024 : 0) + lane * 16; \
                glds16(g_, (unsigned)__builtin_amdgcn_readfirstlane((dbase) + (lw == 0 ? 33 : lw == 1 ? 34 : 32) * 1024)); } while (0)
            SC_LOAD(0, lds0); SC_LOAD(1, lds0 + SC_BUF);
            if (lw == 0) asm volatile("s_waitcnt vmcnt(13)" ::: "memory"); else asm volatile("s_waitcnt vmcnt(11)" ::: "memory");
            SC_BAR();
#pragma unroll 1
            for (int n = 0; n < 128; ++n) {
                if (n + 2 < 128) { SC_LOAD(n + 2, lds0 + ((n + 2) % 3) * SC_BUF); if (lw == 0) asm volatile("s_waitcnt vmcnt(13)" ::: "memory"); else asm volatile("s_waitcnt vmcnt(11)" ::: "memory"); }
                else asm volatile("s_waitcnt vmcnt(0)" ::: "memory");
#ifdef SCX_LDELAY
                __builtin_amdgcn_s_sleep(15);
#endif
                SC_BAR();
            }
#undef SC_LOAD
        } else if (wid != 0) {
            SC_BAR();
#pragma unroll 1
            for (int n = 0; n < 128; ++n) SC_BAR();
        } else {
            f32x4d S[8];
#pragma unroll
            for (int mt = 0; mt < 8; ++mt) S[mt] = (f32x4d){0.f, 0.f, 0.f, 0.f};
            SC_BAR();
#pragma unroll 1
            for (int n = 0; n < 128; ++n) { LAS const unsigned char* buf = lds + (n % 3) * SC_BUF;
                bf16x8 wf[16];
#pragma unroll
                for (int f = 0; f < 16; ++f) wf[f] = *(LAS const bf16x8*)(buf + f * 1024 + lane * 16);
                const float dl = *(LAS const float*)(buf + 34 * 1024 + 512 + (n & 3) * 4); f32x4 ek[4]; u32x2 uu[4];
#pragma unroll
                for (int it = 0; it < 4; ++it) { ek[it] = *(LAS const f32x4*)(buf + 34 * 1024 + 256 + (16 * it + 4 * g4) * 4); uu[it] = *(LAS const u32x2*)(buf + 32 * 1024 + (n16 * 64 + 16 * it + 4 * g4) * 2); }
                __builtin_amdgcn_sched_barrier(0);
                bf16x8 sb[4]; unsigned char* ssn = SSN + ((size_t)(bh * 128 + n) * 8 + slice) * 4096 + lane * 16;
#pragma unroll
                for (int ks = 0; ks < 4; ++ks) { const unsigned a0 = pk2(S[2 * ks][0], S[2 * ks][1]), a1 = pk2(S[2 * ks][2], S[2 * ks][3]), a2 = pk2(S[2 * ks + 1][0], S[2 * ks + 1][1]), a3 = pk2(S[2 * ks + 1][2], S[2 * ks + 1][3]);
                    sb[ks] = __builtin_bit_cast(bf16x8, (u32x4){a0, a1, a2, a3}); *(bf16x8*)(ssn + ks * 1024) = sb[ks]; }
                asm volatile("s_waitcnt lgkmcnt(0)" ::: "memory"); __builtin_amdgcn_sched_barrier(0);
                bf16x8 kf[16];
#pragma unroll
                for (int f = 0; f < 16; ++f) kf[f] = *(LAS const bf16x8*)(buf + 16384 + f * 1024 + lane * 16);
                __builtin_amdgcn_sched_barrier(0);
                f32x4d aw[4];
#pragma unroll
                for (int it = 0; it < 4; ++it) aw[it] = (f32x4d){0.f, 0.f, 0.f, 0.f};
#pragma unroll
                for (int ks = 0; ks < 4; ++ks)
#pragma unroll
                    for (int it = 0; it < 4; ++it) aw[it] = __builtin_amdgcn_mfma_f32_16x16x32_bf16(wf[it * 4 + ks], sb[ks], aw[it], 0, 0, 0);
                f32x4d vn[4];
#pragma unroll
                for (int it = 0; it < 4; ++it) { vn[it][0] = __uint_as_float(uu[it].x << 16) - aw[it][0]; vn[it][1] = __uint_as_float(uu[it].x & 0xffff0000u) - aw[it][1]; vn[it][2] = __uint_as_float(uu[it].y << 16) - aw[it][2]; vn[it][3] = __uint_as_float(uu[it].y & 0xffff0000u) - aw[it][3]; }
                bf16x8 vk[2]; unsigned char* vdst = (unsigned char*)(item0 + (size_t)n * IT_ELEMS) + IT_UT * 2 + dv0 * 128 + lane * 16;
#pragma unroll
                for (int ks = 0; ks < 2; ++ks) { const f32x4d x0 = vn[2 * ks], x1 = vn[2 * ks + 1], y0 = x0 * ek[2 * ks], y1 = x1 * ek[2 * ks + 1];
                    *(bf16x8*)(vdst + ks * 1024) = __builtin_bit_cast(bf16x8, (u32x4){pk2(x0[0], x0[1]), pk2(x0[2], x0[3]), pk2(x1[0], x1[1]), pk2(x1[2], x1[3])});
                    vk[ks] = __builtin_bit_cast(bf16x8, (u32x4){pk2(y0[0], y0[1]), pk2(y0[2], y0[3]), pk2(y1[0], y1[1]), pk2(y1[2], y1[3])}); }
#pragma unroll
                for (int mt = 0; mt < 8; ++mt) S[mt] = S[mt] * dl;
                asm volatile("s_waitcnt lgkmcnt(0)" ::: "memory"); __builtin_amdgcn_sched_barrier(0);
#pragma unroll
                for (int ks = 0; ks < 2; ++ks)
#pragma unroll
                    for (int mt = 0; mt < 8; ++mt) S[mt] = __builtin_amdgcn_mfma_f32_16x16x32_bf16(kf[mt * 2 + ks], vk[ks], S[mt], 0, 0, 0);
#ifdef SCX_ADELAY
                __builtin_amdgcn_s_sleep(15);
#endif
                SC_LBAR();
            }
        }
        __syncthreads();
    }
}
#undef SC_BAR
#undef SC_LBAR

constexpr int OL_QP = 0, OL_IN = 16384, OL_RED = 24576, OL_RS = 26624, OL_T = 27136;
__device__ __forceinline__ void ph_od_out(LAS unsigned char* lds, unsigned char* mx, const float* o_gain, int G, int bid) {
    const int tid = otid(), lane = tid & 63, wid = __builtin_amdgcn_readfirstlane(tid >> 6), n16 = lane & 15, g4 = lane >> 4;
    const bf16_t* ITEMS = (const bf16_t*)(mx + OD_ITEMS); const float* EG = (const float*)(mx + OD_EG); const unsigned char* SSN = mx + OD_SSN;
    const bf16_t* ZS = (const bf16_t*)(mx + OD_ZS); bf16_t* Y = (bf16_t*)(mx + OD_Y);
    LAS float* red = (LAS float*)(lds + OL_RED); LAS float* rsv = (LAS float*)(lds + OL_RS);
    for (int item = bid; item < 2048; item += G) { const int bh = item >> 7, c = item & 127, b = bh >> 3, h = bh & 7;
        const unsigned char* itb = (const unsigned char*)(ITEMS + (size_t)item * IT_ELEMS);
        u32x4 st[3];
#pragma unroll
        for (int i = 0; i < 3; ++i) { const int piece = tid + 512 * i; st[i] = *(const u32x4*)(itb + (piece < 1024 ? IT_QP * 2 + piece * 16 : IT_IN * 2 + (piece - 1024) * 16)); }
        bf16x8 sb[4], vb[2]; f32x4 eg[4];
#pragma unroll
        for (int ks = 0; ks < 4; ++ks) sb[ks] = *(const bf16x8*)(SSN + ((size_t)item * 8 + wid) * 4096 + ks * 1024 + lane * 16);
#pragma unroll
        for (int ks = 0; ks < 2; ++ks) vb[ks] = *(const bf16x8*)(itb + IT_UT * 2 + wid * 2048 + ks * 1024 + lane * 16);
#pragma unroll
        for (int it = 0; it < 4; ++it) eg[it] = *(const f32x4*)(EG + (size_t)bh * SEQ + 64 * c + 16 * it + 4 * g4);
#pragma unroll
        for (int i = 0; i < 3; ++i) *(LAS u32x4*)(lds + (tid + 512 * i) * 16) = st[i];
        __syncthreads();
        f32x4d o[4];
        { bf16x8 qf[16], nf[8];
#pragma unroll
          for (int f = 0; f < 16; ++f) qf[f] = *(LAS const bf16x8*)(lds + OL_QP + f * 1024 + lane * 16);
#pragma unroll
          for (int f = 0; f < 8; ++f) nf[f] = *(LAS const bf16x8*)(lds + OL_IN + f * 1024 + lane * 16);
          asm volatile("s_waitcnt lgkmcnt(0)" ::: "memory"); __builtin_amdgcn_sched_barrier(0);
          f32x4d aq[4];
#pragma unroll
          for (int it = 0; it < 4; ++it) aq[it] = (f32x4d){0.f, 0.f, 0.f, 0.f};
#pragma unroll
          for (int ks = 0; ks < 4; ++ks)
#pragma unroll
              for (int it = 0; it < 4; ++it) aq[it] = __builtin_amdgcn_mfma_f32_16x16x32_bf16(qf[it * 4 + ks], sb[ks], aq[it], 0, 0, 0);
#pragma unroll
          for (int it = 0; it < 4; ++it) o[it] = aq[it] * eg[it];
#pragma unroll
          for (int ks = 0; ks < 2; ++ks)
#pragma unroll
              for (int it = 0; it < 4; ++it) o[it] = __builtin_amdgcn_mfma_f32_16x16x32_bf16(nf[it * 2 + ks], vb[ks], o[it], 0, 0, 0); }
#pragma unroll
        for (int it = 0; it < 4; ++it)
#pragma unroll
            for (int r = 0; r < 4; ++r) { float q = o[it][r] * o[it][r]; q += dpp_f(q, 0xB1); q += dpp_f(q, 0x4E); q += dpp_f(q, 0x141); q += dpp_f(q, 0x140);
                if (n16 == 0) red[wid * 64 + 16 * it + 4 * g4 + r] = q; }
        __syncthreads();
        if (tid < 64) { float tot = 0.f;
#pragma unroll
            for (int w = 0; w < 8; ++w) tot += red[w * 64 + tid];
            rsv[tid] = 1.0f / sqrtf(tot * (1.0f / 128.0f) + EPS); }
        __syncthreads();
        { const float gn = o_gain[16 * wid + n16];
#pragma unroll
          for (int it = 0; it < 4; ++it) { const f32x4 rs4 = *(LAS const f32x4*)(rsv + 16 * it + 4 * g4);
#pragma unroll
              for (int r = 0; r < 4; ++r) *(LAS unsigned short*)(lds + OL_T + (16 * it + 4 * g4 + r) * 272 + (16 * wid + n16) * 2) = (unsigned short)(pk2(o[it][r] * rs4[r] * gn, 0.f) & 0xffffu); } }
        __syncthreads();
        { const int tok = tid >> 3, dg = tid & 7; const size_t ro = (size_t)(b * SEQ + 64 * c + tok) * 1024 + h * 128 + dg * 16;
          const u32x4 t0 = *(LAS const u32x4*)(lds + OL_T + tok * 272 + dg * 32), t1 = *(LAS const u32x4*)(lds + OL_T + tok * 272 + dg * 32 + 16);
          const u32x4 z0 = *(const u32x4*)(ZS + ro), z1 = *(const u32x4*)(ZS + ro + 8);
          u32x4 w0, w1;
#define OD_MUL2(t, z) pk2(__uint_as_float((t) << 16) * __uint_as_float((z) << 16), __uint_as_float((t) & 0xffff0000u) * __uint_as_float((z) & 0xffff0000u))
          w0.x = OD_MUL2(t0.x, z0.x); w0.y = OD_MUL2(t0.y, z0.y); w0.z = OD_MUL2(t0.z, z0.z); w0.w = OD_MUL2(t0.w, z0.w);
          w1.x = OD_MUL2(t1.x, z1.x); w1.y = OD_MUL2(t1.y, z1.y); w1.z = OD_MUL2(t1.z, z1.z); w1.w = OD_MUL2(t1.w, z1.w);
#undef OD_MUL2
          *(u32x4*)(Y + ro) = w0; *(u32x4*)(Y + ro + 8) = w1; }
        __syncthreads();
    }
}

constexpr int LDS_BYTES = 147456;
constexpr int MISC_OFF = 146432;

__global__ void __launch_bounds__(512, 2) mk_fwd(Args a) {
    extern __shared__ __attribute__((aligned(16))) unsigned char lds_raw[];
    LAS unsigned char* lds = (LAS unsigned char*)lds_raw;
    const int G = gridDim.x, bid = blockIdx.x;
    unsigned char* ws = a.ws;
    float* ss = (float*)(ws + WS_SS); float* cs = (float*)(ws + WS_ROPE); float* sn = cs + NTOK * 8;
    bf16_t* xb = (bf16_t*)(ws + WS_XB);
    const Args& P = a;
    const int lo = a.ph_lo, hi = a.ph_hi; int pc = 0;
    int vcu = bid; bool locok = false;
#if MK_ONE_LAUNCH
    LAS unsigned* misc = (LAS unsigned*)(lds + MISC_OFF);
    if (threadIdx.x < 4) misc[threadIdx.x] = 0u;
    __syncthreads();
    XcdBarrier bar = xcd_barrier_post((unsigned*)(ws + WS_BAR), (volatile LAS unsigned*)misc);
    if (threadIdx.x == 0) { const unsigned r = xb_add((unsigned*)(ws + WS_BAR) + 8 + (bar.x & 15u), 1u); misc[16] = (bar.x & 15u) + 8u * r; }
#define GRID_BAR() xcd_barrier(bar)
#else
#define GRID_BAR() do { } while (0)
#endif
#ifndef PROBE_PC
#define PROBE_PC -1
#define PROBE_REP 0
#endif
#ifndef GX_NT
#define GX_NT 0
#endif
#ifndef GX_KZ
#define GX_KZ 0
#endif
#ifndef GX_AT
#define GX_AT 0
#endif
#define PH_BEGIN if (pc >= lo && pc < hi) { const int nrep_ = (PROBE_PC >= 0 && pc == PROBE_PC) ? 1 + PROBE_REP : 1; for (int rep_ = 0; rep_ < nrep_; ++rep_) { if (rep_) GRID_BAR();
#define PH_END   } if (pc + 1 < hi) GRID_BAR(); } ++pc;
#define PH_END_L PH_END_C(true)
#define PH_END_C(c) } if (pc + 1 < hi) xcd_barrier(bar, locok && (c)); } ++pc;

    PH_BEGIN
        ph_xprep(a.in[0], xb, ss, G, bid);
        ph_rope((const int*)a.in[1], cs, sn, G, bid);
        if (bid == 0 && threadIdx.x < 32) ((unsigned*)(ws + WS_TICK))[threadIdx.x] = 0u;
        convert_layer((LAS float*)lds, P, ws, 0, bid, G);
#ifdef PRX_CV
        for (int q_ = 0; q_ < PRX_CV; ++q_) convert_layer((LAS float*)lds, P, ws, 0, bid, G);
#endif
    PH_END
#if MK_ONE_LAUNCH
    if (lo == 0 && hi > 1 && G == 256) {
        if (threadIdx.x == 0) { unsigned ok = 1u;
            for (unsigned j = 0; j < 16; ++j) { const unsigned c = xb_ld((unsigned*)(ws + WS_BAR) + XB_XCNT(j)); ok &= (c == (j < 8u ? 32u : 0u)) ? 1u : 0u; }
            misc[17] = (ok && misc[16] < 256u) ? 1u : 0u; }
        __syncthreads();
        locok = __builtin_amdgcn_readfirstlane((int)misc[17]) != 0; if (locok) vcu = __builtin_amdgcn_readfirstlane((int)misc[16]); }
#endif
    for (int s = 0; s < 8; ++s) {
        const int l = s >> 1; unsigned char* wr = ws + WS_W + (size_t)(l & 1) * WREG;
        bf16_t* H = (bf16_t*)(ws + WS_MIX + ((l & 1) ? (size_t)128 * MB : ((s & 1) ? (size_t)0 : (size_t)100 * MB)));
        PH_BEGIN
            pg8::Gemm g{xb, (const bf16_t*)(wr + ((s & 1) ? WO_GU1 : WO_GU0)), NTOK, 2 * DFF, DM}; pg8::StaticOrder S; S.init(NTOK, 2 * DFF, G, vcu);
            EpiGateUp E{H, ss};
            pg8::gemm_phase<EpiGateUp, pg8::StaticOrder, true, true>(lds, g, S, E);
            if (l < 3 && !(l & 1) && G == 256 && vcu >= 128) { __syncthreads(); convert_layer((LAS float*)lds, P, ws, l + 1, (s & 1) + 2 * (vcu - 128), 256); }
        PH_END_L
        PH_BEGIN
            pg8::Gemm g{H, (const bf16_t*)(wr + ((s & 1) ? WO_D1 : WO_D0)), NTOK, DM, DFF, rep_ ? GX_NT : 0, rep_ ? GX_KZ : 0, 1}; pg8::StaticOrder S; S.init(NTOK, DM, G, vcu);
            EpiResid E{xb, ss, rep_ ? 0.f : 0.5f};
            pg8::gemm_phase<EpiResid, pg8::StaticOrder, false, true>(lds, g, S, E);
            if ((s & 1) && l < 3 && G != 256) { __syncthreads(); convert_layer((LAS float*)lds, P, ws, l + 1, bid, G); }
        PH_END_C(!(s & 1))
        if (!(s & 1)) {
            unsigned char* mx = ws + WS_MIX;
            if (!(l & 1)) {
                PH_BEGIN
                    pg8::Gemm g{xb, (const bf16_t*)(wr + WO_MIN), NTOK, 3840, DM}; pg8::StaticOrder S; S.init(NTOK, 3840, G, vcu);
                    EpiEvIn E{mx, ss, cs, sn};
                    pg8::gemm_phase<EpiEvIn, pg8::StaticOrder, true, true>(lds, g, S, E);
                PH_END
                PH_BEGIN
                    for (int rp_ = 0; rp_ < EVX_YC; ++rp_) ph_yconv(mx, a.in[7] + (size_t)(l >> 1) * 3 * 512, G, bid);
                    ph_ev_index(mx, G, bid);
                PH_END
                PH_BEGIN
                    for (int p = bid; p < 256; p += G) { const int x8 = p & 7, kk = p >> 3, bh = x8 + 8 * (kk >> 4), j = kk & 15;
                        at64::attn64_unit(bh >> 3, bh & 7, j, (const bf16_t*)(mx + EV_Q), (const bf16_t*)(mx + EV_K), (const bf16_t*)(mx + EV_V), (const unsigned*)(mx + EV_BM), (bf16_t*)(mx + EV_Y), (char*)lds_raw);
                        at64::attn64_unit(bh >> 3, bh & 7, 31 - j, (const bf16_t*)(mx + EV_Q), (const bf16_t*)(mx + EV_K), (const bf16_t*)(mx + EV_V), (const unsigned*)(mx + EV_BM), (bf16_t*)(mx + EV_Y), (char*)lds_raw); }
                PH_END
                PH_BEGIN
                    pg8::Gemm g{(const bf16_t*)(mx + EV_Y), (const bf16_t*)(wr + WO_MOUT), NTOK, DM, DM, rep_ ? GX_NT : 0, rep_ ? GX_KZ : 0}; pg8::StaticOrder S; S.init(NTOK, DM, G, vcu);
                    EpiResid E{xb, ss, rep_ ? 0.f : 1.0f};
                    pg8::gemm_phase<EpiResid, pg8::StaticOrder, false, true>(lds, g, S, E);
                PH_END_L
            } else {
                const int io = l >> 1;
                PH_BEGIN
                    pg8::Gemm g{xb, (const bf16_t*)(wr + WO_MIN), NTOK, 4096, DM}; pg8::StaticOrder S; S.init(NTOK, 4096, G, vcu);
                    EpiOdIn E{mx, ss};
                    pg8::gemm_phase<EpiOdIn, pg8::StaticOrder, true, true>(lds, g, S, E);
                PH_END
                PH_BEGIN
                    ph_od_prep(lds, mx, xb, ss, (const bf16_t*)(wr + WO_BA), a.in[10] + (size_t)io * 4 * 3072, a.in[11] + io * 8, a.in[12] + io * 8, G, bid);
                PH_END
                PH_BEGIN
                    int role = bid; ph_od_scan(lds_raw, lds, mx, (unsigned*)(ws + WS_TICK) + (l >> 1) * 16, role, G, bid);
                    if (l < 3 && G == 256 && role >= 128) convert_layer((LAS float*)lds, P, ws, l + 1, role - 128, 128);
                PH_END
                PH_BEGIN
                    ph_od_out(lds, mx, a.in[13] + io * 128, G, bid);
                PH_END
                PH_BEGIN
                    pg8::Gemm g{(const bf16_t*)(mx + OD_Y), (const bf16_t*)(wr + WO_MOUT), NTOK, DM, DM}; pg8::StaticOrder S; S.init(NTOK, DM, G, vcu);
                    EpiResid E{xb, ss, rep_ ? 0.f : 1.0f};
                    pg8::gemm_phase<EpiResid, pg8::StaticOrder, false, true>(lds, g, S, E);
                PH_END_L
            }
        }
    }
#ifdef BARX
    for (int q_ = 0; q_ < BARX; ++q_) GRID_BAR();
#endif
    PH_BEGIN
        const float* fg = a.in[15]; const int tid = otid(), wid = tid >> 6, lane = tid & 63;
        for (int row = bid * 8 + wid; row < NTOK; row += G * 8) { const float r = row_rstd(ss, row); float* orow = a.out + (size_t)row * DM;
#pragma unroll
            for (int q = 0; q < 2; ++q) { const int c = q * 512 + lane * 8; const u32x4 xv = *(const u32x4*)(xb + (size_t)row * DM + c); const f32x4 g0 = *(const f32x4*)(fg + c), g1 = *(const f32x4*)(fg + c + 4);
                f32x4 v0, v1; v0[0] = __uint_as_float(xv.x << 16); v0[1] = __uint_as_float(xv.x & 0xffff0000u); v0[2] = __uint_as_float(xv.y << 16); v0[3] = __uint_as_float(xv.y & 0xffff0000u);
                v1[0] = __uint_as_float(xv.z << 16); v1[1] = __uint_as_float(xv.z & 0xffff0000u); v1[2] = __uint_as_float(xv.w << 16); v1[3] = __uint_as_float(xv.w & 0xffff0000u);
                *(f32x4*)(orow + c) = v0 * r * g0; *(f32x4*)(orow + c + 4) = v1 * r * g1; } }
    PH_END
}
}

#ifndef MK_SPLIT
#define MK_SPLIT 0
#endif
static void launch_phases(const mk::Args& base, int lo, int hi, int grid, hipStream_t st) {
    mk::Args a = base; a.ph_lo = lo; a.ph_hi = hi;
    if (hi - lo > 1) (void)hipMemsetAsync(base.ws + mk::WS_BAR, 0, XCD_BAR_WORDS * sizeof(unsigned), st);
    hipLaunchKernelGGL(mk::mk_fwd, dim3(grid), dim3(512), mk::LDS_BYTES, st, a);
}
constexpr int N_PHASES = 1 + 8 * 2 + 2 * 4 + 2 * 5 + 1;

extern "C" void kernel_launch(void* const* d_in, const int* in_sizes, int n_in, void* d_out, int out_size, void* d_ws, size_t ws_size, hipStream_t stream) {
    static int grid = 0;
    if (grid == 0) {
        int dev = 0, cus = 0;
        if (hipGetDevice(&dev) != hipSuccess || hipDeviceGetAttribute(&cus, hipDeviceAttributeMultiprocessorCount, dev) != hipSuccess) { grid = -1; return; }
        if (hipFuncSetAttribute((const void*)mk::mk_fwd, hipFuncAttributeMaxDynamicSharedMemorySize, mk::LDS_BYTES) != hipSuccess) { grid = -1; return; }
        if (cus < 256) { fprintf(stderr, "kernel_launch: needs 256 compute units (one output tile per workgroup in the residual GEMM phases), found %d\n", cus); grid = -1; return; }
        grid = cus;
        if (ws_size < (size_t)404 * mk::MB || n_in != 16) { fprintf(stderr, "kernel_launch: unexpected workspace/inputs: %zu %d\n", ws_size, n_in); grid = -1; return; }
    }
    if (grid < 0) return;
    mk::Args a{}; for (int i = 0; i < 16; ++i) a.in[i] = (const float*)d_in[i];
    a.out = (float*)d_out; a.ws = (unsigned char*)d_ws;
#if MK_SPLIT
    for (int p = 0; p < N_PHASES; ++p) launch_phases(a, p, p + 1, grid, stream);
#else
    launch_phases(a, 0, N_PHASES, grid, stream);
#endif
}
```

```cpp
#include <hip/hip_runtime.h>
#include <stdint.h>
#include <cstdio>
#ifndef MK_ONE_LAUNCH
#define MK_ONE_LAUNCH 1
#endif
#ifndef MK_VCU
#define MK_VCU 0
#endif
#define LAS __attribute__((address_space(3)))
namespace pg8 {
#define PG8_LAS __attribute__((address_space(3)))
typedef unsigned short bf16_t;
typedef short bf16x8 __attribute__((ext_vector_type(8)));
typedef float f32x4 __attribute__((ext_vector_type(4)));
typedef unsigned u32x4 __attribute__((ext_vector_type(4)));
constexpr int BM = 256, BK = 64, HALF = 128, HTB = HALF * BK * 2  , STAGE_BYTES = 8 * HTB, NXCD = 8, WGM = 8;

__host__ __device__ __forceinline__ int lds_byte(int r, int c) { const int st = (r >> 4) * 2 + (c >> 5), rr = r & 15, cc = c & 31, ob = rr * 64 + cc * 2; return st * 1024 + (ob ^ (((ob >> 9) & 1) << 5)); }
__host__ __device__ __forceinline__ void stage_rc(int b, int& R, int& C) { const int st = b / 1024, sb = b % 1024, swz = sb ^ (((sb >> 9) & 1) << 5); R = (st >> 1) * 16 + swz / 64; C = (st & 1) * 32 + (swz % 64) / 2; }
__host__ __device__ __forceinline__ int perm32(int rho) { const int n = rho >> 4, i = rho & 15; return 8 * (i >> 2) + 4 * n + (i & 3); }

struct Unit { int pm, pn; };
struct Gemm { const bf16_t* A; const bf16_t* Bt; int M, N, K; int ntov; int kz; };

struct StaticOrder {
    int nM, nN, nwg, G, c;
    __host__ __device__ void init(int M, int N, int G_, int c_) { nM = M / BM; nN = N / BM; nwg = nM * nN; G = G_; c = c_; }
    __host__ __device__ bool next(int i, Unit& u) const {
        const long L = (long)i * G + c; if (L >= nwg) return false;
        int wgid = (int)L; { const int q = nwg / NXCD, r = nwg % NXCD, xcd = wgid % NXCD, off = wgid / NXCD; wgid = (xcd < r ? xcd * (q + 1) : r * (q + 1) + (xcd - r) * q) + off; }
        const int nig = WGM * nN, gid = wgid / nig, fm = gid * WGM, gsz = (nM - fm) < WGM ? (nM - fm) : WGM;
        u.pm = fm + ((wgid % nig) % gsz); u.pn = (wgid % nig) / gsz; return true;
    }
    __device__ __forceinline__ void a_ready(const Unit&) const {}
    __device__ __forceinline__ void done(const Unit&) const {}
};__device__ __forceinline__ unsigned cvt_pk_bf16(float lo, float hi) { unsigned r; asm volatile("v_cvt_pk_bf16_f32 %0, %1, %2" : "=v"(r) : "v"(lo), "v"(hi)); return r; }
template <class Epi, class Sched, bool ALIGN_EPI = false, bool SP2 = false>
__device__ __forceinline__ void gemm_phase(PG8_LAS unsigned char* lds, const Gemm g, const Sched& S, const Epi& E) {
    int tid_ = threadIdx.x; asm volatile("" : "+v"(tid_));
    const int tid = tid_, wid = __builtin_amdgcn_readfirstlane(tid >> 6), lane = tid & 63, wr = wid >> 2, wc = wid & 3, fr = lane & 15, fq = lane >> 4;
    const int K = g.K, nt = g.ntov ? g.ntov : K / BK;
    unsigned voffA[2], voffB[2];
#pragma unroll
    for (int i = 0; i < 2; ++i) { int R, C; stage_rc(tid * 16 + i * 8192, R, C); const int Rb = Epi::PERM ? ((R & ~31) + perm32(R & 31)) : R;
        voffA[i] = (unsigned)(R * K + C) * 2u; voffB[i] = (unsigned)(Rb * K + C) * 2u; }
    const size_t kstep = g.kz ? (size_t)0 : (size_t)(BK * 2);
    size_t hstep = (size_t)HALF * K * 2;
    const size_t tstep = 2 * hstep;
    const unsigned ldsw = (unsigned)wid * 1024u;
    const int aoff = lds_byte(wr * 64 + fr, fq * 8), boff = lds_byte(wc * 32 + fr, fq * 8);
#define PG8_SA(b, h) (((b) * 2 + (h)) * HTB)
#define PG8_SB(b, h) ((4 + (b) * 2 + (h)) * HTB)
#define PG8_STAGE(bufoff, gbase, voff) do { _Pragma("unroll") for (int _i = 0; _i < 2; ++_i) \
        __builtin_amdgcn_global_load_lds((const unsigned*)((const char*)(gbase) + (voff)[_i]), (PG8_LAS unsigned*)(lds + (bufoff) + ldsw + _i * 8192), 16, 0, 0); } while (0)
#define PG8_LDA(dst, b, h) do { _Pragma("unroll") for (int m = 0; m < 4; ++m) _Pragma("unroll") for (int k = 0; k < 2; ++k) dst[m][k] = *(const PG8_LAS bf16x8*)(lds + PG8_SA(b, h) + aoff + m * 2048 + k * 1024); } while (0)
#define PG8_LDB(dst, b, h) do { _Pragma("unroll") for (int n = 0; n < 2; ++n) _Pragma("unroll") for (int k = 0; k < 2; ++k) dst[n][k] = *(const PG8_LAS bf16x8*)(lds + PG8_SB(b, h) + boff + n * 2048 + k * 1024); } while (0)
#define PG8_MMA(ai, bj, At, Bt) do { __builtin_amdgcn_s_setprio(1); _Pragma("unroll") for (int m = 0; m < 4; ++m) _Pragma("unroll") for (int n = 0; n < 2; ++n) _Pragma("unroll") for (int k = 0; k < 2; ++k) \
        acc[ai][bj][m][n] = __builtin_amdgcn_mfma_f32_16x16x32_bf16(Bt[n][k], At[m][k], acc[ai][bj][m][n], 0, 0, 0); __builtin_amdgcn_s_setprio(0); } while (0)
#define PG8_WAIT_V(n) asm volatile("s_waitcnt vmcnt(" #n ")" ::: "memory")
#define PG8_WAIT_L(n) asm volatile("s_waitcnt lgkmcnt(" #n ")" ::: "memory")
#define PG8_BAR __builtin_amdgcn_s_barrier()
#define PG8_SCHED __builtin_amdgcn_sched_barrier(0)
    Unit cur, nxt; int ui = 0;
    if (!S.next(0, cur)) return;
    f32x4 acc[2][2][4][2];
#pragma unroll
    for (int a = 0; a < 2; ++a)
#pragma unroll
        for (int b = 0; b < 2; ++b)
#pragma unroll
            for (int m = 0; m < 4; ++m)
#pragma unroll
                for (int n = 0; n < 2; ++n) acc[a][b][m][n] = (f32x4){0.f, 0.f, 0.f, 0.f};
    bf16x8 At[4][2], B0[2][2], B1[2][2];
    const char* cA = (const char*)g.A + (size_t)cur.pm * tstep; const char* cB = (const char*)g.Bt + (size_t)cur.pn * tstep;
    const int rot = Epi::KROT == 1 ? (cur.pn & 3) * ((nt >> 2) & ~1) : 0;
#define PG8_KT(t) (Epi::KROT == 2 ? (size_t)(nt - 2 - ((t) & ~1) + ((t) & 1)) : (size_t)((t) + rot >= nt ? (t) + rot - nt : (t) + rot))
    const char* cA0 = cA + PG8_KT(0) * kstep; const char* cB0 = cB + PG8_KT(0) * kstep;
    S.a_ready(cur);
    if constexpr (SP2) {
        PG8_STAGE(PG8_SB(0, 0), cB0, voffB); PG8_STAGE(PG8_SB(0, 1), cB0 + hstep, voffB); PG8_STAGE(PG8_SA(0, 0), cA0, voffA); PG8_STAGE(PG8_SA(0, 1), cA0 + hstep, voffA);
        E.pre();
        if (wr == 1) PG8_BAR;
        PG8_WAIT_V(2); PG8_BAR;
        PG8_STAGE(PG8_SB(1, 0), cB0 + kstep, voffB); PG8_STAGE(PG8_SA(1, 0), cA0 + kstep, voffA); PG8_STAGE(PG8_SB(1, 1), cB0 + hstep + kstep, voffB);
        PG8_WAIT_V(6); PG8_BAR;
    } else {
        PG8_STAGE(PG8_SB(0, 0), cB, voffB); PG8_STAGE(PG8_SA(0, 0), cA, voffA); PG8_STAGE(PG8_SB(0, 1), cB + hstep, voffB); PG8_STAGE(PG8_SA(0, 1), cA + hstep, voffA);
        if (wr == 1) PG8_BAR;
        PG8_WAIT_V(4); PG8_BAR;
        PG8_STAGE(PG8_SB(1, 0), cB0 + kstep, voffB); PG8_STAGE(PG8_SA(1, 0), cA0 + kstep, voffA); PG8_STAGE(PG8_SB(1, 1), cB0 + hstep + kstep, voffB);
        PG8_WAIT_V(6); PG8_BAR;
    }
    for (;;) {
        const bool has_next = S.next(ui + 1, nxt);
        const char* nA = has_next ? (const char*)g.A + (size_t)nxt.pm * tstep : cA; const char* nB = has_next ? (const char*)g.Bt + (size_t)nxt.pn * tstep : cB;
        if constexpr (Epi::RESID_LDS) { if (!has_next) { nB = E.resid_tile(cur); nA = nB + 256; } }
        for (int t = 0; t < nt; t += 2) {
            const bool last = (t == nt - 2);
            const char* a1 = cA + PG8_KT(t + 1) * kstep;
            const char* a2 = last ? nA : cA + PG8_KT(t + 2) * kstep; const char* b2 = last ? nB : cB + PG8_KT(t + 2) * kstep;
            const char* a3 = a2 + kstep; const char* b3 = b2 + kstep;
            if (last && has_next) S.a_ready(nxt);
            if constexpr (SP2) {
            bool lastx = false; if constexpr (Epi::RESID_LDS) lastx = last && !has_next;
            PG8_LDB(B0, 0, 0); PG8_LDB(B1, 0, 1); PG8_SCHED; PG8_LDA(At, 0, 0); PG8_STAGE(PG8_SA(1, 1), a1 + hstep, voffA);
            PG8_WAIT_V(8); PG8_WAIT_L(0); PG8_BAR; PG8_MMA(0, 0, At, B0); PG8_MMA(0, 1, At, B1); PG8_BAR; PG8_SCHED;
            if constexpr (Epi::RESID_LDS) { if (lastx) {
                int t2 = threadIdx.x; asm volatile("" : "+v"(t2));
#pragma unroll
                for (int i = 0; i < 2; ++i) { int R, C; stage_rc(t2 * 16 + i * 8192, R, C); voffA[i] = voffB[i] = (unsigned)(R * E.resid_ld() + C) * 2u; }
                hstep = (size_t)HALF * E.resid_ld() * 2; } }
            PG8_LDA(At, 0, 1); PG8_STAGE(PG8_SB(0, 0), b2, voffB); PG8_STAGE(PG8_SB(0, 1), b2 + hstep, voffB); PG8_STAGE(PG8_SA(0, 0), a2, voffA);
            PG8_WAIT_V(8); PG8_WAIT_L(0); PG8_BAR; PG8_MMA(1, 0, At, B0); PG8_MMA(1, 1, At, B1); PG8_BAR; PG8_SCHED;
            PG8_LDB(B0, 1, 0); PG8_LDB(B1, 1, 1); PG8_SCHED; PG8_LDA(At, 1, 0); PG8_STAGE(PG8_SA(0, 1), a2 + hstep, voffA);
            PG8_WAIT_V(8); PG8_WAIT_L(0); PG8_BAR; PG8_MMA(0, 0, At, B0); PG8_MMA(0, 1, At, B1); PG8_BAR; PG8_SCHED;
            PG8_LDA(At, 1, 1); PG8_STAGE(PG8_SB(1, 0), b3, voffB); PG8_STAGE(PG8_SB(1, 1), b3 + hstep, voffB); PG8_STAGE(PG8_SA(1, 0), a3, voffA);
            if (lastx) PG8_WAIT_V(14); else PG8_WAIT_V(8);
            PG8_WAIT_L(0); PG8_BAR; PG8_MMA(1, 0, At, B0); PG8_MMA(1, 1, At, B1); PG8_BAR; PG8_SCHED;
            } else {
            PG8_LDB(B0, 0, 0); PG8_SCHED; PG8_LDA(At, 0, 0); PG8_STAGE(PG8_SA(1, 1), a1 + hstep, voffA);
            PG8_WAIT_L(8); PG8_BAR; PG8_WAIT_L(0); PG8_MMA(0, 0, At, B0); PG8_BAR; PG8_SCHED;
            PG8_LDB(B1, 0, 1); PG8_STAGE(PG8_SB(0, 0), b2, voffB);
            PG8_BAR; PG8_WAIT_L(0); PG8_MMA(0, 1, At, B1); PG8_BAR;
            PG8_LDA(At, 0, 1); PG8_STAGE(PG8_SA(0, 0), a2, voffA);
            PG8_BAR; PG8_WAIT_L(0); PG8_MMA(1, 0, At, B0); PG8_BAR; PG8_SCHED;
            PG8_STAGE(PG8_SB(0, 1), b2 + hstep, voffB);
            PG8_WAIT_V(6); PG8_BAR; PG8_MMA(1, 1, At, B1); PG8_BAR;
            PG8_LDB(B0, 1, 0); PG8_SCHED; PG8_LDA(At, 1, 0); PG8_STAGE(PG8_SA(0, 1), a2 + hstep, voffA);
            PG8_WAIT_L(8); PG8_BAR; PG8_WAIT_L(0); PG8_MMA(0, 0, At, B0); PG8_BAR; PG8_SCHED;
            PG8_LDB(B1, 1, 1); PG8_STAGE(PG8_SB(1, 0), b3, voffB);
            PG8_BAR; PG8_WAIT_L(0); PG8_MMA(0, 1, At, B1); PG8_BAR;
            PG8_LDA(At, 1, 1); PG8_STAGE(PG8_SA(1, 0), a3, voffA);
            PG8_BAR; PG8_WAIT_L(0); PG8_MMA(1, 0, At, B0); PG8_BAR; PG8_SCHED;
            PG8_STAGE(PG8_SB(1, 1), b3 + hstep, voffB);
            PG8_WAIT_V(6); PG8_BAR; PG8_MMA(1, 1, At, B1); PG8_BAR;
            }
        }
        if constexpr (ALIGN_EPI) { if (wr == 0) PG8_BAR; }
        if constexpr (Epi::RESID_LDS) { E.resid_lds(acc, cur, wr, wc, fr, fq, lds); S.done(cur); return; }
        else if constexpr (!Epi::AFTER_DRAIN) { E(acc, cur, wr, wc, fr, fq); S.done(cur); }
        if (!has_next) break;
#pragma unroll
        for (int a = 0; a < 2; ++a)
#pragma unroll
            for (int b = 0; b < 2; ++b)
#pragma unroll
                for (int m = 0; m < 4; ++m)
#pragma unroll
                    for (int n = 0; n < 2; ++n) acc[a][b][m][n] = (f32x4){0.f, 0.f, 0.f, 0.f};
        cur = nxt; cA = nA; cB = nB; ++ui;
        if constexpr (ALIGN_EPI) { if (wr == 1) PG8_BAR; }
    }
    PG8_WAIT_V(0);
    if constexpr (!ALIGN_EPI) { if (wr == 0) PG8_BAR; }
    PG8_BAR;
    if constexpr (Epi::AFTER_DRAIN) { E.fused(acc, cur, wr, wc, fr, fq, lds, wid, lane); S.done(cur); }
#undef PG8_SA
#undef PG8_KT
#undef PG8_SB
#undef PG8_STAGE
#undef PG8_LDA
#undef PG8_LDB
#undef PG8_MMA
#undef PG8_WAIT_V
#undef PG8_WAIT_L
#undef PG8_BAR
#undef PG8_SCHED
}
}
#define XB_TMO      128
#define XB_XCNT(j)  (256  + 64 * (j))
#define XB_XSUB(j)  (1280 + 64 * (j))
#define XB_XGEN(j)  (2304 + 64 * (j))
#define XB_TOP      3328
#define XB_TOPGEN   3392
#define XCD_BAR_WORDS 3456
#define XB_SPIN_CAP (1u << 18)

__device__ __forceinline__ unsigned xb_ld(unsigned* p)              { return __hip_atomic_load(p, __ATOMIC_RELAXED, __HIP_MEMORY_SCOPE_AGENT); }
__device__ __forceinline__ unsigned xb_add(unsigned* p, unsigned v) { return __hip_atomic_fetch_add(p, v, __ATOMIC_RELAXED, __HIP_MEMORY_SCOPE_AGENT); }
__device__ __forceinline__ unsigned xb_xcc_id() { return (unsigned)__builtin_amdgcn_s_getreg((3 << 11) | 20) & 0xFu; }
#define XB_SPIN(cond, bar) do { unsigned _sp = 0; while (cond) { __builtin_amdgcn_s_sleep(1); \
    if ((++_sp & 255u) == 0u) { if (xb_ld(&(bar)[XB_TMO])) break; if (_sp > XB_SPIN_CAP) { atomicAdd(&(bar)[XB_TMO], 1u); break; } } } } while (0)

struct XcdBarrier {
    unsigned* bar; unsigned x;
    volatile LAS unsigned* st;
};

__device__ __forceinline__ XcdBarrier xcd_barrier_post(unsigned* bar, volatile LAS unsigned* st) {
    XcdBarrier b; b.bar = bar; b.x = xb_xcc_id(); b.st = st;
    if (threadIdx.x == 0) (void)xb_add(&bar[XB_XCNT(b.x)], 1u);
    return b;
}
__device__ __forceinline__ void xcd_barrier_complete(unsigned* bar, unsigned x, unsigned& nloc, unsigned& nx) {
    const unsigned G = gridDim.x * gridDim.y * gridDim.z;
    unsigned sum, cnt, mine, sp = 0u;
    for (;;) {
        sum = 0u; cnt = 0u; mine = 0u;
#pragma unroll
        for (unsigned j = 0; j < 16; ++j) { const unsigned c = xb_ld(&bar[XB_XCNT(j)]); sum += c; cnt += (c > 0u) ? 1u : 0u; mine = (j == x) ? c : mine; }
        if (sum == G) break;
        __builtin_amdgcn_s_sleep(1);
        if ((++sp & 255u) == 0u) { if (xb_ld(&bar[XB_TMO])) break; if (sp > XB_SPIN_CAP) { atomicAdd(&bar[XB_TMO], 1u); break; } }
    }
    nloc = mine > 0u ? mine : 1u; nx = cnt > 0u ? cnt : 1u;
}

__device__ __forceinline__ void xcd_barrier(const XcdBarrier& b, const bool local = false) {
    asm volatile("s_waitcnt vmcnt(0)" ::: "memory");
    __syncthreads();
    if (threadIdx.x == 0) {
        unsigned* bar = b.bar;
        __builtin_amdgcn_s_waitcnt(0);
        unsigned nloc = b.st[0], nx = b.st[1];
        if (nloc == 0u) { xcd_barrier_complete(bar, b.x, nloc, nx); b.st[0] = nloc; b.st[1] = nx; }
        const unsigned old = xb_add(&bar[XB_XSUB(b.x)], 1u);
        const unsigned gen = old / nloc;
        if (old + 1u == (gen + 1u) * nloc) {
            if (!local) {
            __builtin_amdgcn_fence(__ATOMIC_RELEASE, "agent");
            asm volatile("s_waitcnt vmcnt(0)" ::: "memory");
            const unsigned og = xb_add(&bar[XB_TOP], 1u);
            const unsigned tg = og / nx;
            if (og + 1u == (tg + 1u) * nx) xb_add(&bar[XB_TOPGEN], 1u);
            else XB_SPIN(xb_ld(&bar[XB_TOPGEN]) == tg, bar);
            }
            __builtin_amdgcn_fence(__ATOMIC_ACQUIRE, "agent");
            xb_add(&bar[XB_XGEN(b.x)], 1u);
            asm volatile("s_waitcnt vmcnt(0)" ::: "memory");
        } else {
            XB_SPIN(xb_ld(&bar[XB_XGEN(b.x)]) == gen, bar);
            __builtin_amdgcn_fence(__ATOMIC_ACQUIRE, "agent");
            asm volatile("s_waitcnt vmcnt(0)" ::: "memory");
        }
    }
    __syncthreads();
}


namespace mk {
using pg8::bf16_t; using pg8::f32x4; using pg8::u32x4; using pg8::Unit; using pg8::bf16x8;

constexpr int DM = 1024, NTOK = 16384, SEQ = 8192, DFF = 2816;
constexpr float EPS = 1e-6f;
constexpr size_t MB = 1ull << 20;
constexpr size_t WS_BAR = 0;
constexpr size_t WS_TICK = 32 * 1024;
constexpr size_t WS_SS = 64 * 1024;
constexpr size_t WS_ROPE = WS_SS + MB;
constexpr size_t WS_XB = 4 * MB;
constexpr size_t WS_W = WS_XB + 32 * MB;
constexpr size_t WREG = 46 * MB;
constexpr size_t WO_GU0 = 0, WO_D0 = 11534336, WO_GU1 = WO_D0 + 5767168, WO_D1 = WO_GU1 + 11534336, WO_MIN = WO_D1 + 5767168, WO_MOUT = WO_MIN + 8388608, WO_BA = WO_MOUT + 2097152;
constexpr size_t WS_MIX = WS_W + 2 * WREG;
constexpr size_t WS_H = WS_MIX;

__device__ __forceinline__ int otid() { int t = threadIdx.x; asm volatile("" : "+v"(t)); return t; }
typedef float f32x2_t __attribute__((ext_vector_type(2))); typedef __bf16 bf16x2_t __attribute__((ext_vector_type(2)));
__device__ __forceinline__ unsigned pk2(float lo, float hi) { const f32x2_t v = {lo, hi}; const bf16x2_t b = __builtin_convertvector(v, bf16x2_t); return __builtin_bit_cast(unsigned, b); }
__device__ __forceinline__ int dpp_i(int v, const int ctl) { return ctl == 0xB1 ? __builtin_amdgcn_update_dpp(0, v, 0xB1, 0xF, 0xF, true) : ctl == 0x4E ? __builtin_amdgcn_update_dpp(0, v, 0x4E, 0xF, 0xF, true) : ctl == 0x141 ? __builtin_amdgcn_update_dpp(0, v, 0x141, 0xF, 0xF, true) : __builtin_amdgcn_update_dpp(0, v, 0x140, 0xF, 0xF, true); }
__device__ __forceinline__ float dpp_f(float v, const int ctl) { return __int_as_float(dpp_i(__float_as_int(v), ctl)); }
__device__ __forceinline__ float sum8_f(float s) { s += dpp_f(s, 0xB1); s += dpp_f(s, 0x4E); s += dpp_f(s, 0x141); return s; }
__device__ __forceinline__ int wave_sum_i(int v) {
    v += dpp_i(v, 0xB1); v += dpp_i(v, 0x4E); v += dpp_i(v, 0x141); v += dpp_i(v, 0x140);
    return __builtin_amdgcn_readlane(v, 0) + __builtin_amdgcn_readlane(v, 16) + __builtin_amdgcn_readlane(v, 32) + __builtin_amdgcn_readlane(v, 48);
}
__device__ __forceinline__ float bf2f(unsigned short b) { return __uint_as_float(((unsigned)b) << 16); }
__device__ __forceinline__ float silu_f(float g) { return g * __builtin_amdgcn_rcpf(1.0f + __expf(-g)); }
__device__ __forceinline__ float row_rstd(const float* ss, int row) {
    const f32x4* p = (const f32x4*)(ss + (size_t)row * 16); const f32x4 a = p[0], b = p[1], c = p[2], d = p[3];
    const float s = (((a[0] + a[1]) + (a[2] + a[3])) + ((b[0] + b[1]) + (b[2] + b[3]))) + (((c[0] + c[1]) + (c[2] + c[3])) + ((d[0] + d[1]) + (d[2] + d[3])));
    return 1.0f / sqrtf(s * (1.0f / 1024.0f) + EPS);
}

__device__ __forceinline__ void rows_rstd4(const float* ss, int rowa, int fr, int fq, float (&rs)[4]) {
    const float r0 = row_rstd(ss, rowa + fq * 16);
#pragma unroll
    for (int q = 0; q < 4; ++q) rs[q] = __shfl(r0, q * 16 + fr);
}

__device__ __forceinline__ void stage_rstd(LAS float* rl, const float* ss, int pm) {
    const int t = otid(); if (t < 256) rl[t] = row_rstd(ss, pm * 256 + t);
}
__device__ __forceinline__ void ph_xprep(const float* x, bf16_t* xb, float* ss, int G, int bid) {
    const int tid = otid(), wid = tid >> 6, lane = tid & 63;
    for (int row0 = bid * 8 + wid; row0 < NTOK; row0 += G * 8 * 4) {
        f32x4 xa[4][2], xc[4][2];
#pragma unroll
        for (int k = 0; k < 4; ++k) { const int row = row0 + k * G * 8; const float* xr = x + (size_t)(row < NTOK ? row : row0) * DM;
#pragma unroll
            for (int hlf = 0; hlf < 2; ++hlf) { const int c = hlf * 512 + lane * 8; xa[k][hlf] = *(const f32x4*)(xr + c); xc[k][hlf] = *(const f32x4*)(xr + c + 4); } }
#pragma unroll
        for (int k = 0; k < 4; ++k) { const int row = row0 + k * G * 8; if (row < NTOK) { bf16_t* br = xb + (size_t)row * DM;
#pragma unroll
            for (int hlf = 0; hlf < 2; ++hlf) { const int c = hlf * 512 + lane * 8; const f32x4 a = xa[k][hlf], b = xc[k][hlf];
                u32x4 w; w.x = pk2(a[0], a[1]); w.y = pk2(a[2], a[3]); w.z = pk2(b[0], b[1]); w.w = pk2(b[2], b[3]); *(u32x4*)(br + c) = w;
                const float a0 = __uint_as_float(w.x << 16), a1 = __uint_as_float(w.x & 0xffff0000u), a2 = __uint_as_float(w.y << 16), a3 = __uint_as_float(w.y & 0xffff0000u);
                const float b0 = __uint_as_float(w.z << 16), b1 = __uint_as_float(w.z & 0xffff0000u), b2 = __uint_as_float(w.w << 16), b3 = __uint_as_float(w.w & 0xffff0000u);
                float s = (a0 * a0 + a1 * a1) + (a2 * a2 + a3 * a3) + (b0 * b0 + b1 * b1) + (b2 * b2 + b3 * b3);
                s = sum8_f(s);
                if ((lane & 7) == 0) ss[(size_t)row * 16 + hlf * 8 + (lane >> 3)] = s; } } }
    }
}
__device__ __forceinline__ void ph_rope(const int* pos, float* cs, float* sn, int G, int bid) {
    for (int i = bid * 512 + otid(); i < NTOK * 8; i += G * 512) { const int t = i >> 3, j = i & 7;
        const float inv = (float)pow(500000.0, -(double)(2 * j) / 16.0); const float ang = (float)pos[t] * inv;
        cs[i] = (float)cos((double)ang); sn[i] = (float)sin((double)ang); }
}

__device__ __forceinline__ int hperm(int p) { return p < 16 ? ((p & 3) | ((p & 4) << 1) | ((p & 8) >> 1)) : p; }
__device__ __forceinline__ int src_col(int kind, int n, float& scale, int& mat) {
    scale = 1.0f; mat = 0;
    if (kind == 0) return n;
    if (kind == 1) { const int pn = n >> 8, j = n & 255; mat = j >> 7; return pn * 128 + (j & 127); }
    if (kind == 3) return n < 16 ? 4096 + n : -1;
    const int pn = n >> 8, j = n & 255;
    if (pn < 4) return j < 128 ? 512 + 128 * pn + j : 1024 + 128 * pn + (j - 128);
    if (pn < 6) return (pn - 4) * 256 + j;
    if (pn < 14) { const int base = 1536 + (pn - 6) * 256 + j; if (pn < 10 || pn >= 12) { const int p = base & 63; return base - p + hperm(p); } return base; }
    if (j < 64) return 3584 + hperm(j);
    if (j < 72) { scale = 0.044194173824159216f; return 3648 + (j - 64); }
    return -1;
}
struct CvD { int kind; const float* W; const float* W2; const float* gain; bf16_t* Wt; int K, Nsrc, tile; };
__device__ __forceinline__ void conv_load(const CvD& d, f32x4 (&v)[4], float (&f)[4]) {
    const int ktiles = d.K >> 6, nt = d.tile / ktiles, kt = d.tile - nt * ktiles, n0 = nt * 128, k0 = kt * 64, tid = otid();
    const int nq = (tid & 31) * 4, kr = tid >> 5; float sc; int mat; const int sc_col = src_col(d.kind, n0 + nq, sc, mat); const float* Ws = mat ? d.W2 : d.W;
#pragma unroll
    for (int i = 0; i < 4; ++i) { const int k = k0 + kr + 16 * i; v[i] = (f32x4){0.f, 0.f, 0.f, 0.f}; f[i] = 0.f;
        if (sc_col >= 0) { v[i] = *(const f32x4*)(Ws + (size_t)k * d.Nsrc + sc_col); f[i] = d.gain ? sc * d.gain[k] : sc; } }
}
__device__ __forceinline__ void conv_store(LAS float* tl, const CvD& d, const f32x4 (&v)[4], const float (&f)[4]) {
    const int ktiles = d.K >> 6, nt = d.tile / ktiles, kt = d.tile - nt * ktiles, n0 = nt * 128, k0 = kt * 64, tid = otid();
    { const int nq = (tid & 31) * 4, kr = tid >> 5;
#pragma unroll
      for (int i = 0; i < 4; ++i) *(LAS f32x4*)(tl + (kr + 16 * i) * 132 + nq) = v[i] * f[i]; }
    __syncthreads();
    { const int r = tid >> 2, kq = tid & 3; float x[16];
#pragma unroll
      for (int e = 0; e < 16; ++e) x[e] = tl[(16 * kq + e) * 132 + r];
      u32x4 w0, w1; w0.x = pk2(x[0], x[1]); w0.y = pk2(x[2], x[3]); w0.z = pk2(x[4], x[5]); w0.w = pk2(x[6], x[7]);
      w1.x = pk2(x[8], x[9]); w1.y = pk2(x[10], x[11]); w1.z = pk2(x[12], x[13]); w1.w = pk2(x[14], x[15]);
      bf16_t* dst = d.Wt + (size_t)(n0 + r) * d.K + k0 + 16 * kq; *(u32x4*)dst = w0; *(u32x4*)(dst + 8) = w1; }
    __syncthreads();
}
struct Args { const float* in[16]; float* out; unsigned char* ws; int ph_lo, ph_hi; };
typedef Args WPtrs;
__device__ __forceinline__ CvD conv_desc(const WPtrs& P, unsigned char* ws, int l, int t) {
    const int i = l >> 1, odd = l & 1; unsigned char* wr = ws + WS_W + (size_t)(l & 1) * WREG;
    const float* ng = P.in[2] + (size_t)l * 3 * DM;
    const int nGU = 44 * 16, nD = 8 * 44, nIN = odd ? 32 * 16 : 30 * 16, nOUT = 8 * 16;
    const int t1 = nGU, t2 = t1 + nD, t3 = t2 + nGU, t4 = t3 + nD, t5 = t4 + nIN, t6 = t5 + nOUT;
    if (t < t1) { const size_t wo = ((size_t)l * 2 + 0) * DM * DFF; return CvD{1, P.in[3] + wo, P.in[4] + wo, ng + 0 * DM, (bf16_t*)(wr + WO_GU0), DM, DFF, t}; }
    if (t < t2) { const size_t wo = ((size_t)l * 2 + 0) * DM * DFF; return CvD{0, P.in[5] + wo, nullptr, nullptr, (bf16_t*)(wr + WO_D0), DFF, DM, t - t1}; }
    if (t < t3) { const size_t wo = ((size_t)l * 2 + 1) * DM * DFF; return CvD{1, P.in[3] + wo, P.in[4] + wo, ng + 2 * DM, (bf16_t*)(wr + WO_GU1), DM, DFF, t - t2}; }
    if (t < t4) { const size_t wo = ((size_t)l * 2 + 1) * DM * DFF; return CvD{0, P.in[5] + wo, nullptr, nullptr, (bf16_t*)(wr + WO_D1), DFF, DM, t - t3}; }
    if (t < t5) { if (!odd) return CvD{2, P.in[6] + (size_t)i * DM * 3656, nullptr, ng + DM, (bf16_t*)(wr + WO_MIN), DM, 3656, t - t4};
                  return CvD{0, P.in[9] + (size_t)i * DM * 4112, nullptr, ng + DM, (bf16_t*)(wr + WO_MIN), DM, 4112, t - t4}; }
    if (t < t6) return CvD{0, (odd ? P.in[14] : P.in[8]) + (size_t)i * DM * DM, nullptr, nullptr, (bf16_t*)(wr + WO_MOUT), DM, DM, t - t5};
    return CvD{3, P.in[9] + (size_t)i * DM * 4112, nullptr, ng + DM, (bf16_t*)(wr + WO_BA), DM, 4112, t - t6};
}
__device__ __forceinline__ void convert_layer(LAS float* tl, const WPtrs& P, unsigned char* ws, int l, int first, int stride) {
    const int odd = l & 1, t7 = 44 * 16 * 2 + 8 * 44 * 2 + (odd ? 32 * 16 : 30 * 16) + 8 * 16 + (odd ? 16 : 0);
    if (first >= t7) return;
    CvD d = conv_desc(P, ws, l, first); f32x4 v[4]; float f[4]; conv_load(d, v, f);
    for (int t = first; t < t7; t += stride) {
        const int tn = t + stride < t7 ? t + stride : t;
        const CvD dn = conv_desc(P, ws, l, tn); f32x4 vn[4]; float fn[4]; conv_load(dn, vn, fn);
        conv_store(tl, d, v, f);
        d = dn;
#pragma unroll
        for (int i = 0; i < 4; ++i) { v[i] = vn[i]; f[i] = fn[i]; }
    }
}

struct EpiGateUp {
    static constexpr bool PERM = true, AFTER_DRAIN = false, RESID_LDS = false; static constexpr int KROT = 0;
    bf16_t* H; const float* ss; LAS float* rl; int pm0;
    __device__ __forceinline__ void pre() const { stage_rstd(rl, ss, pm0); }
    __device__ __forceinline__ void operator()(const f32x4 (&acc)[2][2][4][2], const Unit& u, int wr, int wc, int fr, int fq) const {
        const int row0 = u.pm * 256 + wr * 64 + fr, hc = u.pn * 128 + wc * 32 + 8 * fq;
#ifndef EPX_GU
#define EPX_GU 1
#endif
        for (int epx_ = 0; epx_ < EPX_GU; ++epx_)
#pragma unroll
        for (int ai = 0; ai < 2; ++ai) { float rs[4];
#pragma unroll
            for (int m = 0; m < 4; ++m) rs[m] = rl[wr * 64 + fr + ai * 128 + m * 16];
#pragma unroll
            for (int m = 0; m < 4; ++m) { const int row = row0 + ai * 128 + m * 16; const float r = rs[m], rn = r * -1.4426950408889634f, r2 = r * r;
                float h[8];
#pragma unroll
                for (int n = 0; n < 2; ++n)
#pragma unroll
                    for (int j = 0; j < 4; ++j) { const float g = acc[ai][0][m][n][j]; h[n * 4 + j] = (g * acc[ai][1][m][n][j]) * (r2 * __builtin_amdgcn_rcpf(1.0f + __builtin_amdgcn_exp2f(g * rn))); }
                u32x4 w; w.x = pk2(h[0], h[1]); w.y = pk2(h[2], h[3]); w.z = pk2(h[4], h[5]); w.w = pk2(h[6], h[7]);
                *(u32x4*)(H + (size_t)row * DFF + hc) = w; } }
    }
};
template <int KR> struct EpiResidT {
    static constexpr bool PERM = true, AFTER_DRAIN = false, RESID_LDS = true; static constexpr int KROT = KR;
    bf16_t* XB; float* ss; float alpha;
    __device__ __forceinline__ void pre() const {}
    __device__ __forceinline__ void operator()(const f32x4 (&acc)[2][2][4][2], const Unit& u, int wr, int wc, int fr, int fq) const {
        const int row0 = u.pm * 256 + wr * 64 + fr;
        const unsigned loff = (unsigned)(fr * DM + 8 * fq) * 2u;
        char* const ub = (char*)(XB + (size_t)(u.pm * 256 + wr * 64) * DM + u.pn * 256 + wc * 32);
#ifdef EPX_SKIP
        if (alpha == 0.f) return;
#endif
        u32x4 xv[2][4][2];
#pragma unroll
        for (int ai = 0; ai < 2; ++ai)
#pragma unroll
            for (int m = 0; m < 4; ++m)
#pragma unroll
                for (int bj = 0; bj < 2; ++bj) xv[ai][m][bj] = *(const u32x4*)(ub + (size_t)((ai * 128 + m * 16) * DM + bj * 128) * 2 + loff);
        asm volatile("" ::: "memory");
#pragma unroll
        for (int ai = 0; ai < 2; ++ai) {
#pragma unroll
            for (int m = 0; m < 4; ++m) { const int row = row0 + ai * 128 + m * 16; float s = 0.f;
#pragma unroll
                for (int bj = 0; bj < 2; ++bj) { const u32x4 x = xv[ai][m][bj]; const f32x4 d0 = acc[ai][bj][m][0] * alpha, d1 = acc[ai][bj][m][1] * alpha;
                    u32x4 w; w.x = pk2(__uint_as_float(x.x << 16) + d0[0], __uint_as_float(x.x & 0xffff0000u) + d0[1]); w.y = pk2(__uint_as_float(x.y << 16) + d0[2], __uint_as_float(x.y & 0xffff0000u) + d0[3]);
                    w.z = pk2(__uint_as_float(x.z << 16) + d1[0], __uint_as_float(x.z & 0xffff0000u) + d1[1]); w.w = pk2(__uint_as_float(x.w << 16) + d1[2], __uint_as_float(x.w & 0xffff0000u) + d1[3]);
                    *(u32x4*)(ub + (size_t)((ai * 128 + m * 16) * DM + bj * 128) * 2 + loff) = w;
                    const float a0 = __uint_as_float(w.x << 16), a1 = __uint_as_float(w.x & 0xffff0000u), a2 = __uint_as_float(w.y << 16), a3 = __uint_as_float(w.y & 0xffff0000u);
                    const float b0 = __uint_as_float(w.z << 16), b1 = __uint_as_float(w.z & 0xffff0000u), b2 = __uint_as_float(w.w << 16), b3 = __uint_as_float(w.w & 0xffff0000u);
                    s += (a0 * a0 + a1 * a1) + (a2 * a2 + a3 * a3) + (b0 * b0 + b1 * b1) + (b2 * b2 + b3 * b3); }
                s += __shfl_xor(s, 16); s += __shfl_xor(s, 32);
                if (fq == 0) ss[(size_t)row * 16 + u.pn * 4 + wc] = s; }
        }
    }
    __device__ __forceinline__ const char* resid_tile(const Unit& u) const { return (const char*)(XB + (size_t)u.pm * 256 * DM + u.pn * 256); }
    __device__ __forceinline__ int resid_ld() const { return DM; }
    __device__ __forceinline__ void resid_lds(const f32x4 (&acc)[2][2][4][2], const Unit& u, int wr, int wc, int fr, int fq, LAS unsigned char* lds) const {
        const int row0 = u.pm * 256 + wr * 64 + fr;
        const unsigned loff = (unsigned)(fr * DM + 8 * fq) * 2u;
        char* const ub = (char*)(XB + (size_t)(u.pm * 256 + wr * 64) * DM + u.pn * 256 + wc * 32);
        const bool gl = wc >= 2; u32x4 xg[4];
        if (gl) {
#pragma unroll
            for (int m = 0; m < 4; ++m) xg[m] = *(const u32x4*)(ub + (size_t)((128 + m * 16) * DM + 128) * 2 + loff);
            asm volatile("s_waitcnt vmcnt(4)" ::: "memory"); }
        else asm volatile("s_waitcnt vmcnt(0)" ::: "memory");
        if (wr == 0) __builtin_amdgcn_s_barrier();
        __builtin_amdgcn_s_barrier(); asm volatile("" ::: "memory");
        const unsigned lo = (unsigned)pg8::lds_byte(wr * 64 + fr, (wc & 1) * 32 + 8 * fq) + (unsigned)(wc >> 1) * (unsigned)(2 * pg8::HTB);
#pragma unroll
        for (int ai = 0; ai < 2; ++ai) {
            u32x4 xv[4][2];
#pragma unroll
            for (int m = 0; m < 4; ++m) {
                xv[m][0] = *(const LAS u32x4*)(lds + (4 + ai) * pg8::HTB + lo + m * 2048);
                if (ai == 1) { if (gl) xv[m][1] = xg[m]; else xv[m][1] = *(const LAS u32x4*)(lds + ai * pg8::HTB + lo + m * 2048); }
                else xv[m][1] = *(const LAS u32x4*)(lds + ai * pg8::HTB + lo + m * 2048); }
#pragma unroll
            for (int m = 0; m < 4; ++m) { const int row = row0 + ai * 128 + m * 16; float s = 0.f;
#pragma unroll
                for (int bj = 0; bj < 2; ++bj) { const u32x4 x = xv[m][bj]; const f32x4 d0 = acc[ai][bj][m][0] * alpha, d1 = acc[ai][bj][m][1] * alpha;
                    u32x4 w; w.x = pk2(__uint_as_float(x.x << 16) + d0[0], __uint_as_float(x.x & 0xffff0000u) + d0[1]); w.y = pk2(__uint_as_float(x.y << 16) + d0[2], __uint_as_float(x.y & 0xffff0000u) + d0[3]);
                    w.z = pk2(__uint_as_float(x.z << 16) + d1[0], __uint_as_float(x.z & 0xffff0000u) + d1[1]); w.w = pk2(__uint_as_float(x.w << 16) + d1[2], __uint_as_float(x.w & 0xffff0000u) + d1[3]);
                    *(u32x4*)(ub + (size_t)((ai * 128 + m * 16) * DM + bj * 128) * 2 + loff) = w;
                    const float a0 = __uint_as_float(w.x << 16), a1 = __uint_as_float(w.x & 0xffff0000u), a2 = __uint_as_float(w.y << 16), a3 = __uint_as_float(w.y & 0xffff0000u);
                    const float b0 = __uint_as_float(w.z << 16), b1 = __uint_as_float(w.z & 0xffff0000u), b2 = __uint_as_float(w.w << 16), b3 = __uint_as_float(w.w & 0xffff0000u);
                    s += (a0 * a0 + a1 * a1) + (a2 * a2 + a3 * a3) + (b0 * b0 + b1 * b1) + (b2 * b2 + b3 * b3); }
                s += __shfl_xor(s, 16); s += __shfl_xor(s, 32);
                if (fq == 0) ss[(size_t)row * 16 + u.pn * 4 + wc] = s; }
        }
    }
};
typedef EpiResidT<0> EpiResid;
typedef EpiResidT<2> EpiResidRev;

constexpr size_t EV_U = 0, EV_B = 16 * MB, EV_Q = 32 * MB, EV_K = 48 * MB, EV_V = 64 * MB, EV_QI = 80 * MB, EV_KI = 96 * MB, EV_WI = 98 * MB, EV_Y = 100 * MB, EV_S16 = 132 * MB  , EV_BM = 260 * MB;

struct EpiEvIn {
    static constexpr bool PERM = true, AFTER_DRAIN = false, RESID_LDS = false; static constexpr int KROT = 0;
    unsigned char* mx; const float* ss; const float* cs; const float* sn; LAS float* rl; int pm0;
    __device__ __forceinline__ void pre() const { stage_rstd(rl, ss, pm0); }
    __device__ __forceinline__ void operator()(const f32x4 (&acc)[2][2][4][2], const Unit& u, int wr, int wc, int fr, int fq) const {
        const int row0 = u.pm * 256 + wr * 64 + fr, pn = u.pn;
#pragma unroll
        for (int ai = 0; ai < 2; ++ai) { float rs[4];
#pragma unroll
            for (int m = 0; m < 4; ++m) rs[m] = rl[wr * 64 + fr + ai * 128 + m * 16];
            f32x4 c4a[4], s4a[4]; const bool rpl = (pn >= 6 && pn < 14) ? ((((pn - 6) >> 1) != 2) && ((wc & 1) == 0) && (fq < 2)) : (pn == 14 && wc == 0 && fq < 2);
#pragma unroll
            for (int m = 0; m < 4; ++m) { c4a[m] = (f32x4){1.f, 1.f, 1.f, 1.f}; s4a[m] = (f32x4){0.f, 0.f, 0.f, 0.f};
                if (rpl) { const size_t ro = (size_t)(row0 + ai * 128 + m * 16) * 8 + 4 * fq; c4a[m] = *(const f32x4*)(cs + ro); s4a[m] = *(const f32x4*)(sn + ro); } }
            asm volatile("" ::: "memory");
#pragma unroll
            for (int m = 0; m < 4; ++m) { const int row = row0 + ai * 128 + m * 16; const float r = rs[m];
                if (pn < 4) {
                    float h[8]; const float r2 = r * r;
#pragma unroll
                    for (int n = 0; n < 2; ++n)
#pragma unroll
                        for (int j = 0; j < 4; ++j) h[n * 4 + j] = acc[ai][0][m][n][j] * acc[ai][1][m][n][j] * r2;
                    u32x4 w; w.x = pk2(h[0], h[1]); w.y = pk2(h[2], h[3]); w.z = pk2(h[4], h[5]); w.w = pk2(h[6], h[7]);
                    *(u32x4*)((bf16_t*)(mx + EV_U) + (size_t)row * 512 + pn * 128 + wc * 32 + 8 * fq) = w;
                } else if (pn < 6) {
#pragma unroll
                    for (int bj = 0; bj < 2; ++bj) { const f32x4 a = acc[ai][bj][m][0] * r, b = acc[ai][bj][m][1] * r;
                        u32x4 w; w.x = pk2(a[0], a[1]); w.y = pk2(a[2], a[3]); w.z = pk2(b[0], b[1]); w.w = pk2(b[2], b[3]);
                        *(u32x4*)((bf16_t*)(mx + EV_B) + (size_t)row * 512 + (pn - 4) * 256 + bj * 128 + wc * 32 + 8 * fq) = w; }
                } else if (pn < 14) {
                    const int sec = (pn - 6) >> 1; bf16_t* dst = (bf16_t*)(mx + (sec == 0 ? EV_Q : sec == 1 ? EV_K : sec == 2 ? EV_V : EV_QI));
                    const bool rope = (sec != 2) && ((wc & 1) == 0) && (fq < 2);
                    const f32x4 c4 = c4a[m], s4 = s4a[m];
                    const float rq = sec == 0 ? r * 0.18033688011112042f : r;
#pragma unroll
                    for (int bj = 0; bj < 2; ++bj) { const f32x4 x1 = acc[ai][bj][m][0] * rq, x2 = acc[ai][bj][m][1] * rq;
                        const f32x4 a = rope ? x1 * c4 - x2 * s4 : x1, b = rope ? x2 * c4 + x1 * s4 : x2;
                        u32x4 w; w.x = pk2(a[0], a[1]); w.y = pk2(a[2], a[3]); w.z = pk2(b[0], b[1]); w.w = pk2(b[2], b[3]);
                        *(u32x4*)(dst + (size_t)row * 512 + ((pn - 6) & 1) * 256 + bj * 128 + wc * 32 + 8 * fq) = w; }
                } else {
                    const f32x4 x1 = acc[ai][0][m][0] * r, x2 = acc[ai][0][m][1] * r;
                    if (wc < 2) { const bool rope = (wc == 0) && (fq < 2);
                        const f32x4 c4 = c4a[m], s4 = s4a[m];
                        const f32x4 a = rope ? x1 * c4 - x2 * s4 : x1, b = rope ? x2 * c4 + x1 * s4 : x2;
                        u32x4 w; w.x = pk2(a[0], a[1]); w.y = pk2(a[2], a[3]); w.z = pk2(b[0], b[1]); w.w = pk2(b[2], b[3]);
                        *(u32x4*)((bf16_t*)(mx + EV_KI) + (size_t)row * 64 + wc * 32 + 8 * fq) = w;
                    } else if (wc == 2 && fq == 0) { float* wi = (float*)(mx + EV_WI) + (size_t)row * 8; *(f32x4*)wi = x1; *(f32x4*)(wi + 4) = x2; }
                }
            } }
    }
};

__device__ __forceinline__ void ph_yconv(unsigned char* mx, const float* convw, int G, int bid) {
    const bf16_t* U = (const bf16_t*)(mx + EV_U); const bf16_t* Bb = (const bf16_t*)(mx + EV_B); bf16_t* Y = (bf16_t*)(mx + EV_Y);
    const int it0 = bid * 512 + otid(), c = (it0 & 63) * 8;
    f32x4 w0[3], w1[3];
#pragma unroll
    for (int j = 0; j < 3; ++j) { w0[j] = *(const f32x4*)(convw + j * 512 + c); w1[j] = *(const f32x4*)(convw + j * 512 + c + 4); }
#define YC_LOAD(UV, BV, it_) do { const int row_ = (it_) >> 6, t_ = row_ & (SEQ - 1); \
        _Pragma("unroll") for (int j = 0; j < 3; ++j) UV[j] = *(const u32x4*)(U + (size_t)(t_ - 2 + j >= 0 ? row_ - 2 + j : row_) * 512 + c); \
        BV = *(const u32x4*)(Bb + (size_t)row_ * 512 + c); } while (0)
    u32x4 un[3], bn, um[3], bm2; if (it0 < NTOK * 64) { YC_LOAD(un, bn, it0); YC_LOAD(um, bm2, it0 + G * 512 < NTOK * 64 ? it0 + G * 512 : it0); }
    for (int it = it0; it < NTOK * 64; it += G * 512) { const int row = it >> 6, t = row & (SEQ - 1);
        u32x4 uv[3], bv;
#pragma unroll
        for (int j = 0; j < 3; ++j) { uv[j] = un[j]; un[j] = um[j]; }
        bv = bn; bn = bm2;
        { const int nx = it + 2 * G * 512 < NTOK * 64 ? it + 2 * G * 512 : it; YC_LOAD(um, bm2, nx); }
        float acc[8] = {0.f, 0.f, 0.f, 0.f, 0.f, 0.f, 0.f, 0.f};
#pragma unroll
        for (int j = 0; j < 3; ++j) if (t - 2 + j >= 0) { const u32x4 u4 = uv[j];
            acc[0] += w0[j][0] * __uint_as_float(u4.x << 16); acc[1] += w0[j][1] * __uint_as_float(u4.x & 0xffff0000u); acc[2] += w0[j][2] * __uint_as_float(u4.y << 16); acc[3] += w0[j][3] * __uint_as_float(u4.y & 0xffff0000u);
            acc[4] += w1[j][0] * __uint_as_float(u4.z << 16); acc[5] += w1[j][1] * __uint_as_float(u4.z & 0xffff0000u); acc[6] += w1[j][2] * __uint_as_float(u4.w << 16); acc[7] += w1[j][3] * __uint_as_float(u4.w & 0xffff0000u); }
        u32x4 w; w.x = pk2(acc[0] * __uint_as_float(bv.x << 16), acc[1] * __uint_as_float(bv.x & 0xffff0000u)); w.y = pk2(acc[2] * __uint_as_float(bv.y << 16), acc[3] * __uint_as_float(bv.y & 0xffff0000u));
        w.z = pk2(acc[4] * __uint_as_float(bv.z << 16), acc[5] * __uint_as_float(bv.z & 0xffff0000u)); w.w = pk2(acc[6] * __uint_as_float(bv.w << 16), acc[7] * __uint_as_float(bv.w & 0xffff0000u));
        *(u32x4*)(Y + (size_t)row * 1024 + c) = w; }
#undef YC_LOAD
}

__device__ __forceinline__ int wave_excl_scan_i(int v, int lane) {
    int s = v;
#pragma unroll
    for (int o = 1; o < 64; o <<= 1) { const int t = __shfl_up(s, o); if (lane >= o) s += t; }
    return s - v;
}
__device__ __forceinline__ unsigned f16key2(float a, float b) {
    const unsigned x = __builtin_bit_cast(unsigned, __builtin_amdgcn_cvt_pkrtz(a, b));
    typedef short s16x2v __attribute__((ext_vector_type(2)));
    const unsigned m = __builtin_bit_cast(unsigned, (s16x2v)(__builtin_bit_cast(s16x2v, x) >> (s16x2v){15, 15}));
    return x ^ (m | 0x80008000u);
}
typedef float f32x4c __attribute__((ext_vector_type(4)));
typedef unsigned short u16x2v __attribute__((ext_vector_type(2)));
__device__ __forceinline__ unsigned pk_sub16(unsigned a, unsigned b) { return __builtin_bit_cast(unsigned, (u16x2v)(__builtin_bit_cast(u16x2v, a) - __builtin_bit_cast(u16x2v, b))); }
__device__ __forceinline__ unsigned pk_add16(unsigned a, unsigned b) { return __builtin_bit_cast(unsigned, (u16x2v)(__builtin_bit_cast(u16x2v, a) + __builtin_bit_cast(u16x2v, b))); }
__device__ __forceinline__ unsigned pk_shr15(unsigned a) { return __builtin_bit_cast(unsigned, (u16x2v)(__builtin_bit_cast(u16x2v, a) >> (u16x2v){15, 15})); }
__device__ __forceinline__ unsigned pk_max16s(unsigned a, unsigned b) { typedef short s16x2w __attribute__((ext_vector_type(2))); return __builtin_bit_cast(unsigned, __builtin_elementwise_max(__builtin_bit_cast(s16x2w, a), __builtin_bit_cast(s16x2w, b))); }
__device__ __forceinline__ unsigned pk_min16(unsigned a, unsigned b) { return __builtin_bit_cast(unsigned, __builtin_elementwise_min(__builtin_bit_cast(u16x2v, a), __builtin_bit_cast(u16x2v, b))); }
__device__ __forceinline__ void ph_ev_index(unsigned char* mx, int G, int bid) {
    const int tid = otid(), lane = tid & 63, wid = __builtin_amdgcn_readfirstlane(tid >> 6), n16 = lane & 15, g4 = lane >> 4;
    const bf16_t* Qi = (const bf16_t*)(mx + EV_QI); const bf16_t* Ki = (const bf16_t*)(mx + EV_KI); const float* Wi = (const float*)(mx + EV_WI);
    unsigned short* S16b = (unsigned short*)(mx + EV_S16) + (size_t)bid * 16 * 8192; unsigned* BM = (unsigned*)(mx + EV_BM);
    const int p = bid;
    for (int step = 0; step <= 4; ++step) {
    for (int half = 0; half < 2; ++half) {
        const bool doA = (half == 0) == (wid < 4); const int it = doA ? step : step - 1;
        if (it < 0 || it > 3) continue;
        const int b = it >> 1, grp = (it == 1 || it == 2) ? 511 - p : p, q0 = grp * 16, tokbase = b * SEQ;
        const int nt = (q0 + 16 + 63) >> 6;
        unsigned short* S16 = S16b + (size_t)(it & 1) * ((size_t)32 * 1024 * 1024);
#ifndef EVX_SC
#define EVX_SC 1
#define EVX_SEL 1
#define EVX_YC 1
#endif
        if (doA)
        for (int rp_ = 0; rp_ < EVX_SC; ++rp_)
        {
            bf16x8 qf[8][2]; float wv[8];
            { const bf16_t* qp = Qi + (size_t)(tokbase + q0 + n16) * 512 + g4 * 8;
#pragma unroll
              for (int h = 0; h < 8; ++h) { qf[h][0] = *(const bf16x8*)(qp + h * 64); qf[h][1] = *(const bf16x8*)(qp + h * 64 + 32); }
              const f32x4 w0 = *(const f32x4*)(Wi + (size_t)(tokbase + q0 + n16) * 8), w1 = *(const f32x4*)(Wi + (size_t)(tokbase + q0 + n16) * 8 + 4);
              wv[0] = 0.5f * w0[0]; wv[1] = 0.5f * w0[1]; wv[2] = 0.5f * w0[2]; wv[3] = 0.5f * w0[3]; wv[4] = 0.5f * w1[0]; wv[5] = 0.5f * w1[1]; wv[6] = 0.5f * w1[2]; wv[7] = 0.5f * w1[3]; }
            bf16x8 qh[2], ql[2];
#pragma unroll
            for (int ks = 0; ks < 2; ++ks) { float cq[8];
#pragma unroll
                for (int j = 0; j < 8; ++j) { float a = 0.f;
#pragma unroll
                    for (int h = 0; h < 8; ++h) a += wv[h] * __uint_as_float(((unsigned)(unsigned short)qf[h][ks][j]) << 16);
                    cq[j] = a; }
                unsigned hw[4], lw4[4];
#pragma unroll
                for (int j = 0; j < 4; ++j) { hw[j] = pk2(cq[2 * j], cq[2 * j + 1]); lw4[j] = pk2(cq[2 * j] - __uint_as_float(hw[j] << 16), cq[2 * j + 1] - __uint_as_float(hw[j] & 0xffff0000u)); }
                qh[ks] = __builtin_bit_cast(bf16x8, (u32x4){hw[0], hw[1], hw[2], hw[3]}); ql[ks] = __builtin_bit_cast(bf16x8, (u32x4){lw4[0], lw4[1], lw4[2], lw4[3]}); }
            bf16x8 afA[4][2], afB[4][2];
#define EV_KP(tt) (Ki + (size_t)(tokbase + (tt) * 64 + 16 * (n16 >> 2) + (n16 & 3)) * 64 + g4 * 8)
#define EV_LDK(dst, tt) do { const bf16_t* kp_ = EV_KP(tt); \
                _Pragma("unroll") for (int mt = 0; mt < 4; ++mt) { dst[mt][0] = *(const bf16x8*)(kp_ + (size_t)(4 * mt) * 64); dst[mt][1] = *(const bf16x8*)(kp_ + (size_t)(4 * mt) * 64 + 32); } } while (0)
#define EV_TILE(AF, AFN, tt) do { const int t_ = (tt), k0 = t_ * 64; EV_LDK(AFN, (t_ + 8 < ntl) ? t_ + 8 : t_); \
                unsigned kw[8]; \
                _Pragma("unroll") for (int mt = 0; mt < 4; ++mt) { \
                    f32x4c a[8], lh, ll; const f32x4c z4 = {0.f, 0.f, 0.f, 0.f}; \
                    _Pragma("unroll") for (int h = 0; h < 8; ++h) a[h] = __builtin_amdgcn_mfma_f32_16x16x32_bf16(AF[mt][0], qf[h][0], z4, 0, 0, 0); \
                    lh = __builtin_amdgcn_mfma_f32_16x16x32_bf16(AF[mt][0], qh[0], z4, 0, 0, 0); ll = __builtin_amdgcn_mfma_f32_16x16x32_bf16(AF[mt][0], ql[0], z4, 0, 0, 0); \
                    __builtin_amdgcn_sched_barrier(0); \
                    _Pragma("unroll") for (int h = 0; h < 8; ++h) a[h] = __builtin_amdgcn_mfma_f32_16x16x32_bf16(AF[mt][1], qf[h][1], a[h], 0, 0, 0); \
                    lh = __builtin_amdgcn_mfma_f32_16x16x32_bf16(AF[mt][1], qh[1], lh, 0, 0, 0); ll = __builtin_amdgcn_mfma_f32_16x16x32_bf16(AF[mt][1], ql[1], ll, 0, 0, 0); \
                    __builtin_amdgcn_sched_barrier(0); \
                    f32x4c sc; \
                    _Pragma("unroll") for (int r = 0; r < 4; ++r) sc[r] = __builtin_fmaf(__builtin_fabsf(a[0][r]), wv[0], lh[r]);     \
                    _Pragma("unroll") for (int h = 1; h < 8; ++h) _Pragma("unroll") for (int r = 0; r < 4; ++r) sc[r] = __builtin_fmaf(__builtin_fabsf(a[h][r]), wv[h], sc[r]); \
                    _Pragma("unroll") for (int r = 0; r < 4; ++r) { float t_ = sc[r] + ll[r]; asm volatile("" : "+v"(t_)); sc[r] = t_; }     \
                    kw[2 * mt] = f16key2(sc[0], sc[1]); kw[2 * mt + 1] = f16key2(sc[2], sc[3]); \
                    if (k0 + 63 > q0) {     \
                        const int kb = k0 + 16 * g4 + 4 * mt, tq = q0 + n16; \
                        if (kb + 0 > tq) kw[2 * mt] &= 0xFFFF0000u; if (kb + 1 > tq) kw[2 * mt] &= 0x0000FFFFu; \
                        if (kb + 2 > tq) kw[2 * mt + 1] &= 0xFFFF0000u; if (kb + 3 > tq) kw[2 * mt + 1] &= 0x0000FFFFu; } \
                    __builtin_amdgcn_sched_barrier(0); } \
                unsigned short* dst = S16 + (size_t)n16 * 8192 + k0 + 16 * g4; \
                u32x4 s0, s1; s0.x = kw[0]; s0.y = kw[1]; s0.z = kw[2]; s0.w = kw[3]; s1.x = kw[4]; s1.y = kw[5]; s1.z = kw[6]; s1.w = kw[7]; \
                *(u32x4*)dst = s0; *(u32x4*)(dst + 8) = s1; } while (0)
#if defined(EVX_MODE) && EVX_MODE == 3
            const int ntl = (rp_ + 1 == EVX_SC) ? nt : (nt < 8 ? nt : 8);
#else
            const int ntl = nt;
#endif
            if (wid < ntl) { EV_LDK(afB, wid);
                __builtin_amdgcn_s_setprio(2);
                for (int t = wid; t < ntl; t += 8) {
#pragma unroll
                    for (int mt = 0; mt < 4; ++mt) { afA[mt][0] = afB[mt][0]; afA[mt][1] = afB[mt][1]; }
                    EV_TILE(afA, afB, t); }
                __builtin_amdgcn_s_setprio(0); }
#undef EV_TILE
#undef EV_LDK
#undef EV_KP
        }
        if (!doA)
        for (int rp_ = 0; rp_ < EVX_SEL; ++rp_)
        for (int rr = 0; rr < 2; ++rr) { const int row = 2 * wid + rr, t = q0 + row, n = t + 1;
            unsigned* bm = BM + (size_t)(tokbase + t) * 256;
            if (n <= 256) { if (lane < 8) { const int lo = lane * 32; bm[lane] = (n >= lo + 32) ? 0xFFFFFFFFu : (n > lo ? ((1u << (n - lo)) - 1u) : 0u); } }
            else {
                const int npad = nt * 64, jmax = (npad + 511) >> 9; const unsigned short* srow = S16 + (size_t)row * 8192;
                u32x4 x[16];
#pragma unroll
                for (int j = 0; j < 16; ++j) { x[j] = (u32x4){0u, 0u, 0u, 0u}; if (j < jmax) { const int c = 64 * j + lane; if (8 * c < npad) x[j] = *(const u32x4*)(srow + 8 * c); } }
                int cpos = 0;
#pragma unroll
                for (int j = 0; j < 16; ++j) if (j < jmax) {
#pragma unroll
                    for (int q = 0; q < 4; ++q) cpos = (int)pk_add16((unsigned)cpos, pk_shr15(x[j][q])); }
                cpos = wave_sum_i((cpos & 0xFFFF) + (int)((unsigned)cpos >> 16)); const bool hi = cpos >= 256;
                u32x4 w[16];
#pragma unroll
                for (int j = 0; j < 16; ++j) { w[j] = (u32x4){0u, 0u, 0u, 0u}; if (j < jmax) {
#pragma unroll
                    for (int q = 0; q < 4; ++q) { const unsigned v = x[j][q]; if (hi) w[j][q] = pk_max16s(v ^ 0x80008000u, 0u); else w[j][q] = pk_min16(v, 0x7FFF7FFFu);     } } }
                const int ntot = jmax * 512; unsigned lo15 = 0u; int cge = 0;
                for (int bit = 14; bit >= 0; --bit) { const unsigned c = lo15 | (1u << bit), c2 = c * 0x10001u; unsigned acc = 0u;
#pragma unroll
                    for (int j = 0; j < 16; ++j) if (j < jmax) {
#pragma unroll
                        for (int q = 0; q < 4; ++q) acc = pk_add16(acc, pk_shr15(pk_sub16(w[j][q], c2))); }
                    const int lt = wave_sum_i((int)((acc & 0xFFFFu) + (acc >> 16))); if (ntot - lt >= 256) { lo15 = c; cge = ntot - lt; } }
                if (lo15 != 0u && cge == 256) {
                    const unsigned c2 = lo15 * 0x10001u;
#pragma unroll
                    for (int j = 0; j < 16; ++j) if (j < jmax) { unsigned nb = 0u;
#pragma unroll
                        for (int q = 0; q < 4; ++q) { const unsigned d = pk_sub16(w[j][q], c2); nb |= ((d >> 15) & 1u) << (2 * q); nb |= (d >> 31) << (2 * q + 1); }
                        unsigned ww = (~nb & 0xFFu) << (8 * (lane & 3)); ww |= (unsigned)dpp_i((int)ww, 0xB1); ww |= (unsigned)dpp_i((int)ww, 0x4E);
                        if ((lane & 3) == 0) bm[(64 * j + lane) >> 2] = ww; }
                } else {
                const unsigned lo = hi ? (0x8000u | lo15) : lo15;
                const unsigned tau = lo; int cg = 0;
#pragma unroll
                for (int j = 0; j < 16; ++j) if (j < jmax) {
#pragma unroll
                    for (int q = 0; q < 4; ++q) { const unsigned v = x[j][q]; cg += ((v & 0xFFFFu) > tau ? 1 : 0) + ((v >> 16) > tau ? 1 : 0); } }
                const int need = 256 - wave_sum_i(cg); int R = 0;
#pragma unroll
                for (int j = 0; j < 16; ++j) if (j < jmax) {
                    int tc = 0;
#pragma unroll
                    for (int q = 0; q < 4; ++q) { const unsigned v = x[j][q]; tc += ((v & 0xFFFFu) == tau ? 1 : 0) + ((v >> 16) == tau ? 1 : 0); }
                    const int Tj = wave_sum_i(tc); int quota = (R + Tj <= need) ? tc : 0;
                    if (R < need && R + Tj > need) { const int P = wave_excl_scan_i(tc, lane); quota = min(max(need - R - P, 0), tc); }
                    R += Tj;
                    unsigned byte = 0u; int taken = 0;
#pragma unroll
                    for (int e = 0; e < 8; ++e) { const unsigned k = (e & 1) ? (x[j][e >> 1] >> 16) : (x[j][e >> 1] & 0xFFFFu);
                        bool s = k > tau; if (k == tau) { s = taken < quota; ++taken; } byte |= (s ? 1u : 0u) << e; }
                    unsigned w = byte << (8 * (lane & 3)); w |= (unsigned)dpp_i((int)w, 0xB1); w |= (unsigned)dpp_i((int)w, 0x4E);
                    if ((lane & 3) == 0) bm[(64 * j + lane) >> 2] = w; }
                }
            }
        }
    }
        asm volatile("s_waitcnt vmcnt(0)" ::: "memory"); __syncthreads();
    }
}

namespace at64 {
using bf16 = unsigned short;
using bf16x8 = __attribute__((ext_vector_type(8))) short;
using s16x4 = __attribute__((ext_vector_type(4))) short;
using f32x16 = __attribute__((ext_vector_type(16))) float;
using u32x4 = __attribute__((ext_vector_type(4))) unsigned;
constexpr int BATCH = 2, NHEAD = 8, SEQ = 8192, D = 64, DM = NHEAD * D, DMO = 1024, OCOL = 512;
#define ATTN64_THR 8
#define ATTN64_BROKEN 0
constexpr int NW = 8, QBLK = 32, QB = QBLK * NW, KVBLK = 64, NQB = SEQ / QB;
constexpr float C2 = 0.125f * 1.4426950408889634f;
constexpr int SLOTB = 8192, LDS_K = 0, LDS_V = 3 * SLOTB, LDS_WS = 6 * SLOTB, LDS_OST = LDS_WS + NW * 256, LDS_MSK = LDS_OST + NW * 4096, LDS_BYTES = LDS_MSK + NW * 2048;
#define SBAR() __builtin_amdgcn_sched_barrier(0)
#define PIN(x) asm volatile("" : "+v"(x))
#define MFMA(a, b, c) __builtin_amdgcn_mfma_f32_32x32x16_bf16(a, b, c, 0, 0, 0)
#define WAIT_BAR(N) asm volatile("s_waitcnt vmcnt(" #N ") lgkmcnt(0)\n\ts_barrier" ::: "memory")

__device__ __forceinline__ int crow(int r, int hi) { return (r & 3) + 8 * (r >> 2) + 4 * hi; }
__device__ __forceinline__ unsigned cvtpk(float lo, float hi) { unsigned r; asm("v_cvt_pk_bf16_f32 %0, %1, %2" : "=v"(r) : "v"(lo), "v"(hi)); return r; }
__device__ __forceinline__ void glds16(const void* g, unsigned lds_base) {
    unsigned sv; asm volatile("s_mov_b32 %0, m0\n\ts_mov_b32 m0, %2\n\ts_nop 0\n\tglobal_load_lds_dwordx4 %1, off\n\ts_mov_b32 m0, %0" : "=&s"(sv) : "v"(g), "s"(lds_base) : "memory"); }
typedef __attribute__((address_space(3))) const char* lds_cptr;
typedef short v4i16_t __attribute__((ext_vector_type(4)));
__device__ __forceinline__ void kload2(bf16x8* kf, lds_cptr kp, int d0) { kf[2 * d0] = *(const __attribute__((address_space(3))) bf16x8*)(kp + d0 * 2048); kf[2 * d0 + 1] = *(const __attribute__((address_space(3))) bf16x8*)(kp + d0 * 2048 + 512); }
__device__ __forceinline__ s16x4 vtr(lds_cptr p) { return __builtin_bit_cast(s16x4, __builtin_amdgcn_ds_read_tr16_b64_v4i16((__attribute__((address_space(3))) v4i16_t*)p)); }
#define MX3(a, b, c) __builtin_fmaxf(__builtin_fmaxf((a), (b)), (c))
__device__ __forceinline__ float rowmax(const f32x16& p0, const f32x16& p1) {
    float a = MX3(p0[0], p0[1], p1[0]), b = MX3(p0[2], p0[3], p1[1]); a = MX3(a, p1[2], p1[3]);
#pragma unroll
    for (int r = 4; r < 16; r += 4) { a = MX3(a, p0[r], p0[r + 1]); b = MX3(b, p0[r + 2], p0[r + 3]); a = MX3(a, p1[r], p1[r + 1]); b = MX3(b, p1[r + 2], p1[r + 3]); }
    float m = __builtin_fmaxf(a, b); auto rr = __builtin_amdgcn_permlane32_swap(__float_as_uint(m), __float_as_uint(m), false, false);
    return __builtin_fmaxf(__uint_as_float(rr[0]), __uint_as_float(rr[1])); }
__device__ __forceinline__ void cmask(f32x16& p0, f32x16& p1, int jb, int qrel, int hi) {
    const int kb = 64 * jb + 4 * hi;
#pragma unroll
    for (int r = 0; r < 16; ++r) { const int kv = kb + (r & 3) + 8 * (r >> 2); if (kv > qrel) p0[r] = -INFINITY; if (kv + 32 > qrel) p1[r] = -INFINITY; } }

__device__ __forceinline__ void attn64_unit(int b, int h, int qb, const bf16* Q, const bf16* __restrict__ K, const bf16* __restrict__ V, const unsigned* __restrict__ BM, bf16* O, char* lds) {
    int tid_ = threadIdx.x; asm volatile("" : "+v"(tid_)); const int tid = tid_, lane = tid & 63, r32 = lane & 31, hi = lane >> 5; const int wid = __builtin_amdgcn_readfirstlane(tid >> 6);
    const long rowbase = (long)b * SEQ; const int q0 = qb * QB, NT = (q0 + QB) / KVBLK;
    const bf16* Qw = Q + (rowbase + q0 + wid * QBLK) * DM + h * D;
    const unsigned lds0 = (unsigned)(uintptr_t)lds; float* wsf = (float*)(lds + LDS_WS) + wid * 64;
    const bf16* ksrc = K + rowbase * DM + h * D + (long)lane * DM + wid * 8;
    const bf16* vsrc = V + rowbase * DM + h * D + (long)(16 * (wid & 3) + (lane >> 2)) * DM + (wid >> 2) * 32 + (lane & 3) * 8;
    const unsigned kdst = lds0 + LDS_K + wid * 1024, vdst = lds0 + LDS_V + wid * 1024;
#define DMA_K(t, slot) glds16(ksrc + (long)(t) * KVBLK * DM, (unsigned)__builtin_amdgcn_readfirstlane(kdst + (slot)))
#define DMA_V(t, slot) glds16(vsrc + (long)(t) * KVBLK * DM, (unsigned)__builtin_amdgcn_readfirstlane(vdst + (slot)))
    const unsigned* msrc = BM + (size_t)(rowbase + q0 + wid * QBLK + r32) * 256;
    const unsigned mdst = lds0 + LDS_MSK + wid * 2048;
    const lds_cptr mrd = (lds_cptr)lds + LDS_MSK + wid * 2048 + r32 * 16;
#define DMA_M(c) glds16(msrc + (c) * 4, (unsigned)__builtin_amdgcn_readfirstlane(mdst + ((c) & 1) * 1024))
#define BMASK(P0, P1, t) do { const unsigned long long mw_ = *(const __attribute__((address_space(3))) unsigned long long*)(mrd + (((t) >> 1) & 1) * 1024 + ((t) & 1) * 8); \
        const unsigned w0_ = (unsigned)mw_ >> (4 * hi), w1_ = (unsigned)(mw_ >> 32) >> (4 * hi); \
        _Pragma("unroll") for (int r = 0; r < 16; ++r) { const int bp_ = (r & 3) + 8 * (r >> 2); \
            const unsigned m0_ = (unsigned)(((int)(w0_ << (31 - bp_))) >> 31), m1_ = (unsigned)(((int)(w1_ << (31 - bp_))) >> 31); \
            P0[r] = __uint_as_float((__float_as_uint(P0[r]) & m0_) | (0xFF800000u & ~m0_)); P1[r] = __uint_as_float((__float_as_uint(P1[r]) & m1_) | (0xFF800000u & ~m1_)); } } while (0)
    const lds_cptr vp0 = (lds_cptr)lds + LDS_V + ((lane >> 4) & 1) * 32 + (lane & 3) * 8 + (4 * hi + ((lane & 15) >> 2)) * 64;
    const lds_cptr kp0 = (lds_cptr)lds + LDS_K + hi * 1024 + r32 * 16;
    DMA_M(0);
    DMA_K(0, 0); DMA_V(0, 0); DMA_K(1, SLOTB);
    bf16x8 qr[4];
#pragma unroll
    for (int d0 = 0; d0 < 4; ++d0) qr[d0] = *reinterpret_cast<const bf16x8*>(&Qw[(long)r32 * DM + d0 * 16 + hi * 8]);
    float mhat = 0.f, l_reg = 0.f; f32x16 o[2]; o[0] = f32x16{}; o[1] = f32x16{};
    f32x16 zero16 = f32x16{}; PIN(zero16);
    const int qrel = wid * QBLK + r32; bool resc = false;
    f32x16 pA0, pA1, pB0, pB1; bf16x8 kf[8]; s16x4 vlo[8], vhi[8]; u32x4 pw0, pw1, pw2, pw3;
    int sl_prev = 0, sl_cur = 0, sl_next = SLOTB;
#define ROT() do { sl_prev = sl_cur; sl_cur = sl_next; sl_next = (sl_next == 2 * SLOTB) ? 0 : sl_next + SLOTB; } while (0)
#define EX(v) __builtin_amdgcn_exp2f(v)
#define RESC() do { if (resc && !ATTN64_BROKEN) { _Pragma("unroll") for (int d_ = 0; d_ < 2; ++d_) _Pragma("unroll") for (int r = 0; r < 16; ++r) o[d_][r] *= wsf[crow(r, hi)]; } } while (0)
    DMA_K(2, 2 * SLOTB);
    WAIT_BAR(3);
    _Pragma("unroll") for (int d0 = 0; d0 < 4; ++d0) kload2(kf, kp0, d0);
    pA0 = MFMA(kf[0], qr[0], zero16); pA1 = MFMA(kf[1], qr[0], zero16); pA0 = MFMA(kf[2], qr[1], pA0); pA1 = MFMA(kf[3], qr[1], pA1);
    pA0 = MFMA(kf[4], qr[2], pA0); pA1 = MFMA(kf[5], qr[2], pA1); pA0 = MFMA(kf[6], qr[3], pA0); pA1 = MFMA(kf[7], qr[3], pA1);
    if (NT == 4) cmask(pA0, pA1, 0, qrel, hi);
    BMASK(pA0, pA1, 0);
    { const float rm = rowmax(pA0, pA1); mhat = __builtin_fmaxf(rm, -200.f); const float nmh = -mhat;
#pragma unroll
      for (int r = 0; r < 16; ++r) { pA0[r] = EX(pA0[r] + nmh); pA1[r] = EX(pA1[r] + nmh); }
#pragma unroll
      for (int r = 0; r < 16; ++r) zero16[r] = nmh;
      PIN(zero16); }
    WAIT_BAR(0);
    DMA_K(3, 0); DMA_V(1, SLOTB); ROT();
    _Pragma("unroll") for (int d0 = 0; d0 < 4; ++d0) kload2(kf, kp0 + sl_cur, d0);
    WAIT_BAR(2);
#define PKW(P, i) cvtpk(P[i], P[i + 1])
#define PAF(k) __builtin_bit_cast(bf16x8, pw##k)
#define VFR(i) (bf16x8){vlo[i][0], vlo[i][1], vlo[i][2], vlo[i][3], vhi[i][0], vhi[i][1], vhi[i][2], vhi[i][3]}
#define VRD(i) do { vlo[i] = vtr(vp_ + (((i) >> 2) * 4096 + ((i) & 3) * 1024)); vhi[i] = vtr(vp_ + (((i) >> 2) * 4096 + ((i) & 3) * 1024 + 512)); } while (0)
#define KRD(G, d0) do { if (G) { kload2(kf, kp0 + sl_next, d0); SBAR(); } } while (0)
#define GAPA(MF, a0, a1, a2, a3, W0, W1, PW) do { MF; sacc += a0; sacc += a1; sacc += a2; sacc += a3; W0; W1; PIN(PW); PIN(sacc); SBAR(); } while (0)
#define GAPB(MF, X, i) do { MF; X[i] = EX(X[i]); X[i + 1] = EX(X[i + 1]); X[i + 2] = EX(X[i + 2]); X[i + 3] = EX(X[i + 3]); PIN(X); SBAR(); } while (0)
#define STEP(C0, C1, P0, P1, t, MASK, GK, GV, GL, GM) do { SBAR(); \
    const lds_cptr vp_ = vp0 + sl_prev; \
    VRD(0); SBAR(); float sacc = P0[0] + P0[1];                                                                                                       \
                    GAPA(C0 = MFMA(kf[0], qr[0], zero16), P0[2], P0[3], P0[4], P0[5],     pw0[0] = PKW(P0, 0),  pw0[1] = PKW(P0, 2),  pw0); \
    VRD(4); SBAR(); GAPA(C1 = MFMA(kf[1], qr[0], zero16), P0[6], P0[7], P0[8], P0[9],     pw0[2] = PKW(P0, 4),  pw0[3] = PKW(P0, 6),  pw0); \
    VRD(1); SBAR(); GAPA(C0 = MFMA(kf[2], qr[1], C0),    P0[10], P0[11], P0[12], P0[13], pw1[0] = PKW(P0, 8),  pw1[1] = PKW(P0, 10), pw1); \
    VRD(5); SBAR(); GAPA(C1 = MFMA(kf[3], qr[1], C1),    P0[14], P0[15], P1[0], P1[1],   pw1[2] = PKW(P0, 12), pw1[3] = PKW(P0, 14), pw1); \
    VRD(2); SBAR(); GAPA(C0 = MFMA(kf[4], qr[2], C0),    P1[2], P1[3], P1[4], P1[5],     pw2[0] = PKW(P1, 0),  pw2[1] = PKW(P1, 2),  pw2); \
    VRD(6); SBAR(); GAPA(C1 = MFMA(kf[5], qr[2], C1),    P1[6], P1[7], P1[8], P1[9],     pw2[2] = PKW(P1, 4),  pw2[3] = PKW(P1, 6),  pw2); \
    VRD(3); SBAR(); GAPA(C0 = MFMA(kf[6], qr[3], C0),    P1[10], P1[11], P1[12], P1[13], pw3[0] = PKW(P1, 8),  pw3[1] = PKW(P1, 10), pw3); \
    VRD(7); SBAR(); GAPA(C1 = MFMA(kf[7], qr[3], C1),    P1[14], P1[15], 0.f, 0.f,       pw3[2] = PKW(P1, 12), pw3[3] = PKW(P1, 14), pw3); \
    l_reg += sacc; \
    if (GM) DMA_M(((t) + 1) >> 1); if (GK) DMA_K((t) + 3, sl_cur); if (GV) DMA_V((t) + 1, sl_next);                                                       \
    if (MASK) cmask(C0, C1, (t) - (NT - 4), qrel, hi); BMASK(C0, C1, (t)); \
    { const float rm = rowmax(C0, C1); resc = false;                                                                       \
      if (__builtin_expect(__any(rm > (float)ATTN64_THR), 0)) { const float dl = __builtin_fmaxf(rm, 0.f); mhat += dl;     \
          const float f = __builtin_amdgcn_exp2f(-dl); l_reg *= f; if (hi == 0) wsf[r32] = f; resc = true; \
          _Pragma("unroll") for (int r = 0; r < 16; ++r) { C0[r] -= dl; C1[r] -= dl; zero16[r] = -mhat; } PIN(zero16); } } \
    SBAR(); \
    GAPB(o[0] = MFMA(PAF(0), VFR(0), o[0]), C0, 0);              GAPB(o[1] = MFMA(PAF(0), VFR(4), o[1]), C0, 4); \
    KRD(GL, 0); GAPB(o[0] = MFMA(PAF(1), VFR(1), o[0]), C0, 8);  KRD(GL, 1); GAPB(o[1] = MFMA(PAF(1), VFR(5), o[1]), C0, 12);                                     \
    KRD(GL, 2); GAPB(o[0] = MFMA(PAF(2), VFR(2), o[0]), C1, 0);  KRD(GL, 3); GAPB(o[1] = MFMA(PAF(2), VFR(6), o[1]), C1, 4); \
    GAPB(o[0] = MFMA(PAF(3), VFR(3), o[0]), C1, 8);              GAPB(o[1] = MFMA(PAF(3), VFR(7), o[1]), C1, 12); \
    } while (0)
    int t = 1;
    for (; t + 5 < NT; t += 2) {
        STEP(pB0, pB1, pA0, pA1, t, false, true, true, true, true);     WAIT_BAR(2); RESC(); ROT();
        STEP(pA0, pA1, pB0, pB1, t + 1, false, true, true, true, false); WAIT_BAR(2); RESC(); ROT();
    }
#define ENDW(tt) do { if ((tt) + 3 < NT) { WAIT_BAR(2); } else if ((tt) + 2 < NT) { WAIT_BAR(1); } else { WAIT_BAR(0); } } while (0)
    for (; t + 1 < NT; t += 2) {
        STEP(pB0, pB1, pA0, pA1, t, true, (t + 3 < NT), (t + 1 < NT), (t + 1 < NT), (t + 1 < NT));         ENDW(t);     RESC(); ROT();
        STEP(pA0, pA1, pB0, pB1, t + 1, true, (t + 4 < NT), (t + 2 < NT), (t + 2 < NT), false);     ENDW(t + 1); RESC(); ROT();
    }
    STEP(pB0, pB1, pA0, pA1, NT - 1, true, false, false, false, false); RESC();
    { float sacc = pB0[0] + pB0[1];
#pragma unroll
      for (int r = 2; r < 16; ++r) sacc += pB0[r];
#pragma unroll
      for (int r = 0; r < 16; ++r) sacc += pB1[r];
      l_reg += sacc;
      pw0 = (u32x4){PKW(pB0, 0), PKW(pB0, 2), PKW(pB0, 4), PKW(pB0, 6)}; pw1 = (u32x4){PKW(pB0, 8), PKW(pB0, 10), PKW(pB0, 12), PKW(pB0, 14)};
      pw2 = (u32x4){PKW(pB1, 0), PKW(pB1, 2), PKW(pB1, 4), PKW(pB1, 6)}; pw3 = (u32x4){PKW(pB1, 8), PKW(pB1, 10), PKW(pB1, 12), PKW(pB1, 14)};
      const lds_cptr vp_ = vp0 + sl_cur; _Pragma("unroll") for (int i = 0; i < 8; ++i) VRD(i);
      o[0] = MFMA(PAF(0), VFR(0), o[0]); o[1] = MFMA(PAF(0), VFR(4), o[1]); o[0] = MFMA(PAF(1), VFR(1), o[0]); o[1] = MFMA(PAF(1), VFR(5), o[1]);
      o[0] = MFMA(PAF(2), VFR(2), o[0]); o[1] = MFMA(PAF(2), VFR(6), o[1]); o[0] = MFMA(PAF(3), VFR(3), o[0]); o[1] = MFMA(PAF(3), VFR(7), o[1]); }
    { auto rr = __builtin_amdgcn_permlane32_swap(__float_as_uint(l_reg), __float_as_uint(l_reg), false, false); l_reg = __uint_as_float(rr[0]) + __uint_as_float(rr[1]); }
    if (hi == 0) wsf[32 + r32] = l_reg; asm volatile("s_waitcnt lgkmcnt(0)" ::: "memory");
    float rli[16];
#pragma unroll
    for (int r = 0; r < 16; ++r) rli[r] = __builtin_amdgcn_rcpf(wsf[32 + crow(r, hi)]);
    bf16* Ow = O + (rowbase + q0 + wid * QBLK) * DMO + OCOL + h * D; bf16* stg = (bf16*)(lds + LDS_OST) + wid * 2048;
#pragma unroll
    for (int r = 0; r < 16; ++r) { const int orow = crow(r, hi);
#pragma unroll
        for (int d0 = 0; d0 < 2; ++d0) stg[orow * 64 + d0 * 32 + r32] = (bf16)(cvtpk(o[d0][r] * rli[r], 0.f) & 0xffffu); }
    asm volatile("s_waitcnt lgkmcnt(0)" ::: "memory");
#pragma unroll
    for (int i = 0; i < 4; ++i) { const int row = i * 8 + (lane >> 3), ch = lane & 7; *(u32x4*)(Ow + (long)row * DMO + ch * 8) = *(const u32x4*)(stg + row * 64 + ch * 8); }
    asm volatile("s_waitcnt lgkmcnt(0)\n\ts_barrier" ::: "memory");
#undef DMA_K
#undef DMA_V
#undef DMA_M
#undef BMASK
#undef ROT
#undef EX
#undef RESC
#undef PKW
#undef PAF
#undef VFR
#undef VRD
#undef KRD
#undef ENDW
#undef GAPA
#undef GAPB
#undef STEP
}
#undef SBAR
#undef PIN
#undef MFMA
#undef WAIT_BAR
#undef MX3
}

constexpr size_t OD_PRE = 0, OD_SSN = 0, OD_Y = 64 * MB, OD_ZS = 96 * MB, OD_ITEMS = 128 * MB, OD_EG = 272 * MB, OD_EK = OD_EG + 512 * 1024, OD_DL = OD_EK + 512 * 1024;
constexpr int IT_WP = 0, IT_QP = 8192, IT_KT = 16384, IT_IN = 24576, IT_UT = 28672, IT_ELEMS = 36864;

struct EpiOdIn {
    static constexpr bool PERM = true, AFTER_DRAIN = false, RESID_LDS = false; static constexpr int KROT = 0;
    unsigned char* mx; const float* ss; LAS float* rl; int pm0;
    __device__ __forceinline__ void pre() const { stage_rstd(rl, ss, pm0); }
    __device__ __forceinline__ void operator()(const f32x4 (&acc)[2][2][4][2], const Unit& u, int wr, int wc, int fr, int fq) const {
        const int row0 = u.pm * 256 + wr * 64 + fr, pn = u.pn;
#pragma unroll
        for (int ai = 0; ai < 2; ++ai) { float rs[4];
#pragma unroll
            for (int m = 0; m < 4; ++m) rs[m] = rl[wr * 64 + fr + ai * 128 + m * 16];
#pragma unroll
            for (int m = 0; m < 4; ++m) { const int row = row0 + ai * 128 + m * 16; const float r = rs[m];
#pragma unroll
                for (int bj = 0; bj < 2; ++bj) { f32x4 a = acc[ai][bj][m][0] * r, b = acc[ai][bj][m][1] * r;
                    if (pn >= 12) {
#pragma unroll
                        for (int j = 0; j < 4; ++j) { a[j] = silu_f(a[j]); b[j] = silu_f(b[j]); } }
                    u32x4 w; w.x = pk2(a[0], a[1]); w.y = pk2(a[2], a[3]); w.z = pk2(b[0], b[1]); w.w = pk2(b[2], b[3]);
                    if (pn < 12) *(u32x4*)((bf16_t*)(mx + OD_PRE) + (size_t)row * 3072 + pn * 256 + bj * 128 + wc * 32 + 8 * fq) = w;
                    else *(u32x4*)((bf16_t*)(mx + OD_ZS) + (size_t)row * 1024 + (pn - 12) * 256 + bj * 128 + wc * 32 + 8 * fq) = w; }
            } }
    }
};

typedef short s16x4v __attribute__((ext_vector_type(4)));
__device__ __forceinline__ bf16x8 tr_frag(LAS const unsigned char* p) {
    const s16x4v lo = __builtin_amdgcn_ds_read_tr16_b64_v4i16((LAS s16x4v*)p);
    const s16x4v hi = __builtin_amdgcn_ds_read_tr16_b64_v4i16((LAS s16x4v*)(p + 4 * 272));
    return (bf16x8){lo[0], lo[1], lo[2], lo[3], hi[0], hi[1], hi[2], hi[3]};
}
typedef float f32x4d __attribute__((ext_vector_type(4)));
typedef unsigned u32x2 __attribute__((ext_vector_type(2)));

constexpr int PL_Q = 0, PL_K = 17408, PL_V = 34816, PL_AM = 52224, PL_T1 = 69632, PL_T2 = 78848, PL_BA = 88064, PL_BETA = 96256, PL_GC = 98304, PL_CW = 100352, PL_TT = 112640  , PL_END = 130048;

__device__ __forceinline__ void ph_od_prep(LAS unsigned char* lds, unsigned char* mx, const bf16_t* xb, const float* ss, const bf16_t* Wba, const float* convw, const float* a_log, const float* dt_bias, int G, int bid) {
    const int tid = otid(), lane = tid & 63, wid = __builtin_amdgcn_readfirstlane(tid >> 6), n16 = lane & 15, g4 = lane >> 4;
    const bf16_t* PRE = (const bf16_t*)(mx + OD_PRE); bf16_t* ITEMS = (bf16_t*)(mx + OD_ITEMS);
    float* EG = (float*)(mx + OD_EG); float* EK = (float*)(mx + OD_EK); float* DL = (float*)(mx + OD_DL);
    LAS float* BA = (LAS float*)(lds + PL_BA); LAS float* betaS = (LAS float*)(lds + PL_BETA); LAS float* gcS = (LAS float*)(lds + PL_GC);
    LAS float* Am = (LAS float*)(lds + PL_AM);
    for (int bc = bid; bc < 256; bc += G) { const int b = bc >> 7, c = bc & 127, t0 = b * SEQ + 64 * c;
        if (tid < 384) { const int i4 = tid * 4, js = i4 >> 7, ch = i4 & 127; *(LAS f32x4*)(lds + PL_CW + i4 * 4) = *(const f32x4*)(convw + (js / 3) * 3072 + (js % 3) * 1024 + ch); }
        { const int mt = wid & 3, kh = wid >> 2; f32x4d acc = {0.f, 0.f, 0.f, 0.f}, acc1 = {0.f, 0.f, 0.f, 0.f};
          const bf16_t* ap = xb + (size_t)(t0 + 16 * mt + n16) * DM + kh * 512 + g4 * 8; const bf16_t* bp = Wba + (size_t)n16 * DM + kh * 512 + g4 * 8;
          bf16x8 fa[16], fb[16];
#pragma unroll
          for (int ks = 0; ks < 16; ++ks) { fa[ks] = *(const bf16x8*)(ap + ks * 32); fb[ks] = *(const bf16x8*)(bp + ks * 32); }
#pragma unroll
          for (int ks = 0; ks < 16; ks += 2) { acc = __builtin_amdgcn_mfma_f32_16x16x32_bf16(fa[ks], fb[ks], acc, 0, 0, 0); acc1 = __builtin_amdgcn_mfma_f32_16x16x32_bf16(fa[ks + 1], fb[ks + 1], acc1, 0, 0, 0); }
          acc += acc1;
#pragma unroll
          for (int r = 0; r < 4; ++r) BA[(kh * 64 + 16 * mt + 4 * g4 + r) * 16 + n16] = acc[r]; }
        __syncthreads();
        { const int h = wid, tok = lane; const float rs = row_rstd(ss, t0 + tok);
          const float braw = (BA[tok * 16 + h] + BA[(64 + tok) * 16 + h]) * rs, araw = (BA[tok * 16 + 8 + h] + BA[(64 + tok) * 16 + 8 + h]) * rs;
          const float beta = 1.0f / (1.0f + expf(-braw)); const float xs = araw + dt_bias[h]; const float sp = fmaxf(xs, 0.f) + __logf(1.0f + __expf(-fabsf(xs)));
          float gc = -expf(a_log[h]) * sp;
#pragma unroll
          for (int o = 1; o < 64; o <<= 1) { const float t = __shfl_up(gc, o); if (lane >= o) gc += t; }
          const float gl = __shfl(gc, 63);
          betaS[h * 64 + tok] = beta; gcS[h * 64 + tok] = gc;
          const size_t so = (size_t)(b * 8 + h) * SEQ + 64 * c + tok; EG[so] = expf(gc); EK[so] = expf(gl - gc); if (lane == 0) DL[(b * 8 + h) * 128 + c] = expf(gl); }
        __syncthreads();
#define OD_PRE_LOAD(XR, hh) do { const int t_ = otid(); const bool v_ = t_ >= 256; const int sec_ = v_ ? 2 : (t_ >> 7), c8_ = t_ & 15, chn_ = sec_ * 1024 + (hh) * 128 + 8 * c8_, tb_ = v_ ? 4 * ((t_ - 256) >> 4) : 8 * ((t_ >> 4) & 7); \
            _Pragma("unroll") for (int i = 0; i < 11; ++i) if (i < 7 || !v_) { const int tt = 64 * c + tb_ - 3 + i; XR[i] = *(const u32x4*)(PRE + (size_t)(b * SEQ + (tt >= 0 ? tt : 0)) * 3072 + chn_); if (tt < 0) XR[i] = (u32x4){0u, 0u, 0u, 0u}; } } while (0)
        u32x4 xr[11];
#pragma unroll
        for (int i = 0; i < 11; ++i) xr[i] = (u32x4){0u, 0u, 0u, 0u};
        OD_PRE_LOAD(xr, 0);
        for (int h = 0; h < 8; ++h) { bf16_t* itp = ITEMS + (size_t)((b * 8 + h) * 128 + c) * IT_ELEMS;
            const int tid = otid(), lane = tid & 63, n16 = lane & 15, g4 = lane >> 4;
            LAS const float* beta = betaS + h * 64; LAS const float* gc = gcS + h * 64;
#ifndef PRX_B1
#define PRX_B1 1
#define PRX_B2 1
#define PRX_B3 1
#define PRX_B4 1
#endif
            for (int rp1_ = 0; rp1_ < PRX_B1; ++rp1_)
            { const bool vth = tid >= 256; const int sec = vth ? 2 : (tid >> 7), c8 = tid & 15, tok0 = vth ? 4 * ((tid - 256) >> 4) : 8 * ((tid >> 4) & 7), ntt = vth ? 4 : 8;
                LAS const float* cw = (LAS const float*)(lds + PL_CW + (h & 1) * 6144) + sec * 128 + 8 * c8;
#pragma unroll
                for (int tt = 0; tt < 8; ++tt) if (tt < ntt) { float acc[8];
#pragma unroll
                    for (int e = 0; e < 8; ++e) acc[e] = 0.f;
#pragma unroll
                    for (int j = 0; j < 4; ++j) { const u32x4 xv = xr[tt + j]; const f32x4 wl = *(LAS const f32x4*)(cw + j * 384), wh = *(LAS const f32x4*)(cw + j * 384 + 4);
                        acc[0] += wl[0] * __uint_as_float(xv.x << 16); acc[1] += wl[1] * __uint_as_float(xv.x & 0xffff0000u); acc[2] += wl[2] * __uint_as_float(xv.y << 16); acc[3] += wl[3] * __uint_as_float(xv.y & 0xffff0000u);
                        acc[4] += wh[0] * __uint_as_float(xv.z << 16); acc[5] += wh[1] * __uint_as_float(xv.z & 0xffff0000u); acc[6] += wh[2] * __uint_as_float(xv.w << 16); acc[7] += wh[3] * __uint_as_float(xv.w & 0xffff0000u); }
                    float sq = 0.f;
#pragma unroll
                    for (int e = 0; e < 8; ++e) { acc[e] = acc[e] * __builtin_amdgcn_rcpf(1.0f + __expf(-acc[e])); sq += acc[e] * acc[e]; }
                    if (sec < 2) { sq += dpp_f(sq, 0xB1); sq += dpp_f(sq, 0x4E); sq += dpp_f(sq, 0x141); sq += dpp_f(sq, 0x140);
                        const float sc = (1.0f / sqrtf(sq + EPS)) * (sec == 0 ? 0.08838834764831845f : 1.0f);
#pragma unroll
                        for (int e = 0; e < 8; ++e) acc[e] *= sc; }
                    const int tok = tok0 + tt; const unsigned p0 = pk2(acc[0], acc[1]), p1 = pk2(acc[2], acc[3]), p2 = pk2(acc[4], acc[5]), p3 = pk2(acc[6], acc[7]);
                    *(LAS u32x4*)(lds + (sec == 0 ? PL_Q : sec == 1 ? PL_K : PL_V) + tok * 272 + c8 * 16) = (u32x4){p0, p1, p2, p3};
                    if (sec == 0) { bf16_t* qd = itp + IT_QP + ((tok >> 4) * 4 + (c8 >> 2)) * 512 + ((2 * (c8 & 1)) * 16 + (tok & 15)) * 8 + 4 * ((c8 >> 1) & 1);
                        *(u32x2*)qd = (u32x2){p0, p1}; *(u32x2*)(qd + 128) = (u32x2){p2, p3}; }
                }
                if (vth) { for (int i = tid - 256; i < 64 * 68; i += 256) Am[i] = 0.f; } }
            if (h < 7 && tid < 384) { const int i4 = tid * 4, js = i4 >> 7, ch = i4 & 127; *(LAS f32x4*)(lds + PL_CW + ((h + 1) & 1) * 6144 + i4 * 4) = *(const f32x4*)(convw + (js / 3) * 3072 + (js % 3) * 1024 + (h + 1) * 128 + ch); }
            __syncthreads();
            for (int rp2_ = 0; rp2_ < PRX_B2; ++rp2_)
            for (int tk = wid; tk < 26; tk += 8) {
                if (tk >= 20) { const int z = tk - 20; const int it = z < 3 ? 0 : (z < 5 ? 1 : 2), jt = z < 3 ? z + 1 : (z < 5 ? z - 1 : 3);
                    *(u32x2*)(itp + IT_IN + (it * 2 + (jt >> 1)) * 512 + (g4 * 16 + n16) * 8 + 4 * (jt & 1)) = (u32x2){0u, 0u}; continue; }
                const int kind = tk >= 10, ix = kind ? tk - 10 : tk; const int it = ix < 1 ? 0 : (ix < 3 ? 1 : (ix < 6 ? 2 : 3)), jt = ix - (it * (it + 1)) / 2;
                f32x4d acc = {0.f, 0.f, 0.f, 0.f};
                if (!kind) {
#pragma unroll
                    for (int ks = 0; ks < 4; ++ks) acc = __builtin_amdgcn_mfma_f32_16x16x32_bf16(*(LAS const bf16x8*)(lds + PL_K + (16 * it + n16) * 272 + ks * 64 + g4 * 16), *(LAS const bf16x8*)(lds + PL_K + (16 * jt + n16) * 272 + ks * 64 + g4 * 16), acc, 0, 0, 0);
                    const int j = 16 * jt + n16; const float gj = gc[j];
#pragma unroll
                    for (int r = 0; r < 4; ++r) { const int i = 16 * it + 4 * g4 + r; Am[i * 68 + j] = (i > j) ? acc[r] * beta[i] * expf(gc[i] - gj) : 0.f; }
                } else {
#pragma unroll
                    for (int ks = 0; ks < 4; ++ks) acc = __builtin_amdgcn_mfma_f32_16x16x32_bf16(*(LAS const bf16x8*)(lds + PL_K + (16 * jt + n16) * 272 + ks * 64 + g4 * 16), *(LAS const bf16x8*)(lds + PL_Q + (16 * it + n16) * 272 + ks * 64 + g4 * 16), acc, 0, 0, 0);
                    const int i = 16 * it + n16; const float gi = gc[i]; float v[4];
#pragma unroll
                    for (int r = 0; r < 4; ++r) { const int j = 16 * jt + 4 * g4 + r; v[r] = (i >= j) ? acc[r] * expf(gi - gc[j]) : 0.f; }
                    *(u32x2*)(itp + IT_IN + (it * 2 + (jt >> 1)) * 512 + (g4 * 16 + n16) * 8 + 4 * (jt & 1)) = (u32x2){pk2(v[0], v[1]), pk2(v[2], v[3])};
                }
            }
            __syncthreads();
            u32x4 xn[11];
#pragma unroll
            for (int i = 0; i < 11; ++i) xn[i] = (u32x4){0u, 0u, 0u, 0u};
            OD_PRE_LOAD(xn, h < 7 ? h + 1 : h);
            for (int rp3_ = 0; rp3_ < PRX_B3; ++rp3_)
            { LAS float* TT = (LAS float*)(lds + PL_TT);
              if (wid < 4) { if (lane < 16) { const int I = wid, cc = lane; LAS const float* ad = Am + (16 * I) * 68 + 16 * I; float acc[16];
#pragma unroll
                    for (int i = 0; i < 16; ++i) acc[i] = (i == cc) ? 1.f : 0.f;
#pragma unroll
                    for (int k = 0; k < 15; ++k) { const float tk = acc[k];
#pragma unroll
                        for (int i = k + 1; i < 16; ++i) acc[i] -= ad[i * 68 + k] * tk; }
#pragma unroll
                    for (int i = 0; i < 16; ++i) TT[(16 * I + i) * 68 + 16 * I + cc] = acc[i]; } }
              else { for (int e = tid - 256; e < 6 * 256; e += 256) { const int blk = e >> 8, r = (e >> 4) & 15, cq = e & 15;
                         const int I = blk < 3 ? 0 : (blk < 5 ? 1 : 2), J = blk < 3 ? blk + 1 : (blk < 5 ? blk - 1 : 3); TT[(16 * I + r) * 68 + 16 * J + cq] = 0.f; } }
              __syncthreads();
              if (wid < 6) { const int I = wid < 1 ? 1 : (wid < 3 ? 2 : 3), K = wid < 1 ? 0 : (wid < 3 ? wid - 1 : wid - 3); f32x4d c4 = {0.f, 0.f, 0.f, 0.f};
#pragma unroll
                  for (int kc = 0; kc < 4; ++kc) c4 = __builtin_amdgcn_mfma_f32_16x16x4f32(TT[(16 * I + n16) * 68 + 16 * I + 4 * kc + g4], Am[(16 * I + 4 * kc + g4) * 68 + 16 * K + n16], c4, 0, 0, 0);
#pragma unroll
                  for (int r = 0; r < 4; ++r) Am[(16 * I + 4 * g4 + r) * 68 + 16 * K + n16] = -c4[r]; }
              __syncthreads();
#pragma unroll
              for (int I = 1; I < 4; ++I) {
                  if (wid < I) { const int J = wid; f32x4d c4 = {0.f, 0.f, 0.f, 0.f};
                      for (int K = J; K < I; ++K) {
#pragma unroll
                          for (int kc = 0; kc < 4; ++kc) c4 = __builtin_amdgcn_mfma_f32_16x16x4f32(Am[(16 * I + n16) * 68 + 16 * K + 4 * kc + g4], TT[(16 * K + 4 * kc + g4) * 68 + 16 * J + n16], c4, 0, 0, 0); }
#pragma unroll
                      for (int r = 0; r < 4; ++r) TT[(16 * I + 4 * g4 + r) * 68 + 16 * J + n16] = c4[r]; }
                  __syncthreads(); }
              { const int j = tid >> 3, c8 = (tid & 7) * 8; const f32x4 t0 = *(LAS const f32x4*)(TT + j * 68 + c8), t1 = *(LAS const f32x4*)(TT + j * 68 + c8 + 4);
                const f32x4 b0 = *(LAS const f32x4*)(beta + c8), b1 = *(LAS const f32x4*)(beta + c8 + 4), g0 = *(LAS const f32x4*)(gc + c8), g1 = *(LAS const f32x4*)(gc + c8 + 4);
                float u1[8], u2[8];
#pragma unroll
                for (int e = 0; e < 4; ++e) { u1[e] = t0[e] * b0[e]; u1[4 + e] = t1[e] * b1[e]; u2[e] = u1[e] * expf(g0[e]); u2[4 + e] = u1[4 + e] * expf(g1[e]); }
                *(LAS u32x4*)(lds + PL_T1 + j * 144 + c8 * 2) = (u32x4){pk2(u1[0], u1[1]), pk2(u1[2], u1[3]), pk2(u1[4], u1[5]), pk2(u1[6], u1[7])};
                *(LAS u32x4*)(lds + PL_T2 + j * 144 + c8 * 2) = (u32x4){pk2(u2[0], u2[1]), pk2(u2[2], u2[3]), pk2(u2[4], u2[5]), pk2(u2[6], u2[7])}; } }
            __syncthreads();
            for (int rp4_ = 0; rp4_ < PRX_B4; ++rp4_)
            { const int q4 = (lane & 15) >> 2, p4 = lane & 3;
              bf16x8 bv[2], ak[2];
#pragma unroll
              for (int ks = 0; ks < 2; ++ks) { bv[ks] = tr_frag(lds + PL_V + (32 * ks + 8 * g4 + q4) * 272 + (16 * wid + 4 * p4) * 2); ak[ks] = tr_frag(lds + PL_K + (32 * ks + 8 * g4 + q4) * 272 + (16 * wid + 4 * p4) * 2); }
#pragma unroll
              for (int it = 0; it < 4; ++it) { f32x4d au = {0.f, 0.f, 0.f, 0.f}, aw = {0.f, 0.f, 0.f, 0.f};
#pragma unroll
                  for (int ks = 0; ks < 2; ++ks) { au = __builtin_amdgcn_mfma_f32_16x16x32_bf16(*(LAS const bf16x8*)(lds + PL_T1 + (16 * it + n16) * 144 + ks * 64 + g4 * 16), bv[ks], au, 0, 0, 0);
                      aw = __builtin_amdgcn_mfma_f32_16x16x32_bf16(ak[ks], *(LAS const bf16x8*)(lds + PL_T2 + (16 * it + n16) * 144 + ks * 64 + g4 * 16), aw, 0, 0, 0); }
                  *(u32x2*)(itp + IT_UT + (16 * wid + n16) * 64 + 16 * it + 4 * g4) = (u32x2){pk2(au[0], au[1]), pk2(au[2], au[3])};
                  *(u32x2*)(itp + IT_WP + (it * 4 + (wid >> 1)) * 512 + (g4 * 16 + n16) * 8 + 4 * (wid & 1)) = (u32x2){pk2(aw[0], aw[1]), pk2(aw[2], aw[3])}; }
              { const int dk = tid >> 2, ksq = (tid >> 1) & 1, aq = tid & 1;
#pragma unroll
                for (int kq = 0; kq < 4; ++kq) { const int j0 = 32 * ksq + 16 * aq + 4 * kq; unsigned short e[4];
#pragma unroll
                    for (int r = 0; r < 4; ++r) e[r] = *(LAS const unsigned short*)(lds + PL_K + (j0 + r) * 272 + dk * 2);
                    *(u32x2*)(itp + IT_KT + ((dk >> 4) * 2 + ksq) * 512 + (kq * 16 + (dk & 15)) * 8 + 4 * aq) = (u32x2){(unsigned)e[0] | ((unsigned)e[1] << 16), (unsigned)e[2] | ((unsigned)e[3] << 16)}; } }
            }
            __syncthreads();
#pragma unroll
            for (int i = 0; i < 11; ++i) xr[i] = xn[i];
        }
#undef OD_PRE_LOAD
    }
}

__device__ __forceinline__ void glds16(const void* g, unsigned lds_base) {
    unsigned sv; asm volatile("s_mov_b32 %0, m0\n\ts_mov_b32 m0, %2\n\ts_nop 0\n\tglobal_load_lds_dwordx4 %1, off\n\ts_mov_b32 m0, %0" : "=&s"(sv) : "v"(g), "s"(lds_base) : "memory"); }
__device__ __forceinline__ void glds4(const void* g, unsigned lds_base) {
    unsigned sv; asm volatile("s_mov_b32 %0, m0\n\ts_mov_b32 m0, %2\n\ts_nop 0\n\tglobal_load_lds_dword %1, off\n\ts_mov_b32 m0, %0" : "=&s"(sv) : "v"(g), "s"(lds_base) : "memory"); }
__device__ __forceinline__ void glds16s(const void* sbase, unsigned voff, unsigned lds_base) {
    unsigned sv; asm volatile("s_mov_b32 %0, m0\n\ts_mov_b32 m0, %3\n\ts_nop 0\n\tglobal_load_lds_dwordx4 %1, %2\n\ts_mov_b32 m0, %0" : "=&s"(sv) : "v"(voff), "s"(sbase), "s"(lds_base) : "memory"); }
constexpr int SC_BUF = 35840;
#ifndef SC_TOUCH_ON
#define SC_TOUCH_ON 0
#endif
#define SC_BAR() do { __builtin_amdgcn_s_barrier(); asm volatile("" ::: "memory"); } while (0)
#define SC_LBAR() do { asm volatile("s_waitcnt lgkmcnt(0)" ::: "memory"); __builtin_amdgcn_s_barrier(); asm volatile("" ::: "memory"); } while (0)
__device__ __forceinline__ void ph_od_scan(unsigned char* lds_generic, LAS unsigned char* lds, unsigned char* mx, unsigned* tickets, int& role_out, int G, int bid) {
    const int tid = otid(), lane = tid & 63, wid = __builtin_amdgcn_readfirstlane(tid >> 6), n16 = lane & 15, g4 = lane >> 4;
    bf16_t* ITEMS = (bf16_t*)(mx + OD_ITEMS); const float* EG = (const float*)(mx + OD_EG); const float* EK = (const float*)(mx + OD_EK); const float* DL = (const float*)(mx + OD_DL);
    unsigned char* SSN = mx + OD_SSN;
    const unsigned lds0 = (unsigned)(uintptr_t)lds_generic;
    const int wk0 = bid; role_out = bid;
    for (int wk = wk0; wk < 128; wk += G) { const int bh = (wk & 7) + 8 * (wk >> 6), slice = (wk >> 3) & 7, dv0 = slice * 16;
        bf16_t* item0 = ITEMS + (size_t)(bh * 128) * IT_ELEMS;
        if (wid >= 1 && wid <= 3) {
            const int lw = wid - 1; const unsigned lane16 = (unsigned)lane * 16u;
#define SC_LOAD(nn, dbase) do { const char* src_ = (const char*)(item0 + (size_t)(nn) * IT_ELEMS); const size_t so_ = (size_t)bh * SEQ + 64 * (nn); \
                const char* sb_ = src_ + lw * 1024; unsigned md_ = (unsigned)__builtin_amdgcn_readfirstlane((dbase) + lw * 1024); \
                _Pragma("unroll 1") for (int k_ = lw; k_ < 16; k_ += 3) { glds16s(sb_, lane16, md_); glds16s(sb_ + IT_KT * 2, lane16, md_ + 16384); sb_ += 3072; md_ += 3072; } \
                const char* g_ = lw == 1 ? (lane < 16 ? (const char*)(EG + so_ + lane * 4) : lane < 32 ? (const char*)(EK + so_ + (lane - 16) * 4) : lane == 32 ? (const char*)(DL + bh * 128 + ((nn) & ~3)) : (const char*)(EG + so_)) \
                                         : src_ + IT_UT * 2 + dv0 * 128 + (lw == 0 ? 1024 : 0) + lane * 16; \
                glds16(g_, (unsigned)__builtin_amdgcn_readfirstlane((dbase) + (lw == 0 ? 33 : lw == 1 ? 34 : 32) * 1024)); } while (0)
            SC_LOAD(0, lds0); SC_LOAD(1, lds0 + SC_BUF);
            if (lw == 0) asm volatile("s_waitcnt vmcnt(13)" ::: "memory"); else asm volatile("s_waitcnt vmcnt(11)" ::: "memory");
            SC_BAR();
#pragma unroll 1
            for (int n = 0; n < 128; ++n) {
                if (n + 2 < 128) { SC_LOAD(n + 2, lds0 + ((n + 2) % 3) * SC_BUF); if (lw == 0) asm volatile("s_waitcnt vmcnt(13)" ::: "memory"); else asm volatile("s_waitcnt vmcnt(11)" ::: "memory"); }
                else asm volatile("s_waitcnt vmcnt(0)" ::: "memory");
#ifdef SCX_LDELAY
                __builtin_amdgcn_s_sleep(15);
#endif
                SC_BAR();
            }
#undef SC_LOAD
        } else if (wid != 0) {
            SC_BAR();
#pragma unroll 1
            for (int n = 0; n < 128; ++n) SC_BAR();
        } else {
            f32x4d S[8];
#pragma unroll
            for (int mt = 0; mt < 8; ++mt) S[mt] = (f32x4d){0.f, 0.f, 0.f, 0.f};
            SC_BAR();
#pragma unroll 1
            for (int n = 0; n < 128; ++n) { LAS const unsigned char* buf = lds + (n % 3) * SC_BUF;
                bf16x8 wf[16];
#pragma unroll
                for (int f = 0; f < 16; ++f) wf[f] = *(LAS const bf16x8*)(buf + f * 1024 + lane * 16);
                const float dl = *(LAS const float*)(buf + 34 * 1024 + 512 + (n & 3) * 4); f32x4 ek[4]; u32x2 uu[4];
#pragma unroll
                for (int it = 0; it < 4; ++it) { ek[it] = *(LAS const f32x4*)(buf + 34 * 1024 + 256 + (16 * it + 4 * g4) * 4); uu[it] = *(LAS const u32x2*)(buf + 32 * 1024 + (n16 * 64 + 16 * it + 4 * g4) * 2); }
                __builtin_amdgcn_sched_barrier(0);
                bf16x8 sb[4]; unsigned char* ssn = SSN + ((size_t)(bh * 128 + n) * 8 + slice) * 4096 + lane * 16;
#pragma unroll
                for (int ks = 0; ks < 4; ++ks) { const unsigned a0 = pk2(S[2 * ks][0], S[2 * ks][1]), a1 = pk2(S[2 * ks][2], S[2 * ks][3]), a2 = pk2(S[2 * ks + 1][0], S[2 * ks + 1][1]), a3 = pk2(S[2 * ks + 1][2], S[2 * ks + 1][3]);
                    sb[ks] = __builtin_bit_cast(bf16x8, (u32x4){a0, a1, a2, a3}); *(bf16x8*)(ssn + ks * 1024) = sb[ks]; }
                asm volatile("s_waitcnt lgkmcnt(0)" ::: "memory"); __builtin_amdgcn_sched_barrier(0);
                bf16x8 kf[16];
#pragma unroll
                for (int f = 0; f < 16; ++f) kf[f] = *(LAS const bf16x8*)(buf + 16384 + f * 1024 + lane * 16);
                __builtin_amdgcn_sched_barrier(0);
#define SC_PIN4(x) asm volatile("" : "+v"(x))
#define SC_SB() __builtin_amdgcn_sched_barrier(0)
#define SC_PIN1x4(x) do { float e0_ = x[0], e1_ = x[1], e2_ = x[2], e3_ = x[3]; asm volatile("" : "+v"(e0_)); asm volatile("" : "+v"(e1_)); asm volatile("" : "+v"(e2_)); asm volatile("" : "+v"(e3_)); x[0] = e0_; x[1] = e1_; x[2] = e2_; x[3] = e3_; } while (0)
#define SC_VMUL(d, a, b) asm volatile("v_mul_f32 %0, %1, %2" : "=v"(d) : "v"(a), "v"(b))
#define SC_MUL4(d, a, b) do { float t0_, t1_, t2_, t3_; SC_VMUL(t0_, a[0], b[0]); SC_VMUL(t1_, a[1], b[1]); SC_VMUL(t2_, a[2], b[2]); SC_VMUL(t3_, a[3], b[3]); d[0] = t0_; d[1] = t1_; d[2] = t2_; d[3] = t3_; } while (0)
#define SC_SCL4(d, c) do { float t0_, t1_, t2_, t3_; SC_VMUL(t0_, d[0], c); SC_VMUL(t1_, d[1], c); SC_VMUL(t2_, d[2], c); SC_VMUL(t3_, d[3], c); d[0] = t0_; d[1] = t1_; d[2] = t2_; d[3] = t3_; } while (0)
                f32x4d aw[4];
#pragma unroll
                for (int it = 0; it < 4; ++it) aw[it] = (f32x4d){0.f, 0.f, 0.f, 0.f};
#pragma unroll
                for (int ks = 0; ks < 4; ++ks) {
                    aw[0] = __builtin_amdgcn_mfma_f32_16x16x32_bf16(wf[0 * 4 + ks], sb[ks], aw[0], 0, 0, 0); SC_SCL4(S[2 * ks], dl); SC_PIN4(S[2 * ks]); SC_SB();
                    aw[1] = __builtin_amdgcn_mfma_f32_16x16x32_bf16(wf[1 * 4 + ks], sb[ks], aw[1], 0, 0, 0); SC_SCL4(S[2 * ks + 1], dl); SC_PIN4(S[2 * ks + 1]); SC_SB(); }
                bf16x8 vk[2]; unsigned char* vdst = (unsigned char*)(item0 + (size_t)n * IT_ELEMS) + IT_UT * 2 + dv0 * 128 + lane * 16;
                f32x4d x0, x1, y0, y1; u32x4 pv, pk;
                aw[2] = __builtin_amdgcn_mfma_f32_16x16x32_bf16(wf[2 * 4 + 0], sb[0], aw[2], 0, 0, 0); SC_SB();
                aw[3] = __builtin_amdgcn_mfma_f32_16x16x32_bf16(wf[3 * 4 + 0], sb[0], aw[3], 0, 0, 0); SC_SB();
                aw[2] = __builtin_amdgcn_mfma_f32_16x16x32_bf16(wf[2 * 4 + 1], sb[1], aw[2], 0, 0, 0);
                x0[0] = __uint_as_float(uu[0].x << 16) - aw[0][0]; x0[1] = __uint_as_float(uu[0].x & 0xffff0000u) - aw[0][1]; x0[2] = __uint_as_float(uu[0].y << 16) - aw[0][2]; x0[3] = __uint_as_float(uu[0].y & 0xffff0000u) - aw[0][3]; SC_PIN1x4(x0); SC_SB();
                aw[3] = __builtin_amdgcn_mfma_f32_16x16x32_bf16(wf[3 * 4 + 1], sb[1], aw[3], 0, 0, 0);
                x1[0] = __uint_as_float(uu[1].x << 16) - aw[1][0]; x1[1] = __uint_as_float(uu[1].x & 0xffff0000u) - aw[1][1]; x1[2] = __uint_as_float(uu[1].y << 16) - aw[1][2]; x1[3] = __uint_as_float(uu[1].y & 0xffff0000u) - aw[1][3]; SC_PIN1x4(x1); SC_SB();
                aw[2] = __builtin_amdgcn_mfma_f32_16x16x32_bf16(wf[2 * 4 + 2], sb[2], aw[2], 0, 0, 0);
                SC_MUL4(y0, x0, ek[0]); SC_MUL4(y1, x1, ek[1]); SC_PIN4(y0); SC_PIN4(y1); SC_SB();
                aw[3] = __builtin_amdgcn_mfma_f32_16x16x32_bf16(wf[3 * 4 + 2], sb[2], aw[3], 0, 0, 0);
                pv = (u32x4){pk2(x0[0], x0[1]), pk2(x0[2], x0[3]), pk2(x1[0], x1[1]), pk2(x1[2], x1[3])}; SC_PIN4(pv); SC_SB();
                aw[2] = __builtin_amdgcn_mfma_f32_16x16x32_bf16(wf[2 * 4 + 3], sb[3], aw[2], 0, 0, 0);
                pk = (u32x4){pk2(y0[0], y0[1]), pk2(y0[2], y0[3]), pk2(y1[0], y1[1]), pk2(y1[2], y1[3])}; SC_PIN4(pk); SC_SB();
                aw[3] = __builtin_amdgcn_mfma_f32_16x16x32_bf16(wf[3 * 4 + 3], sb[3], aw[3], 0, 0, 0);
                *(bf16x8*)(vdst) = __builtin_bit_cast(bf16x8, pv); vk[0] = __builtin_bit_cast(bf16x8, pk); SC_SB();
                asm volatile("s_waitcnt lgkmcnt(0)" ::: "memory"); SC_SB();
                S[0] = __builtin_amdgcn_mfma_f32_16x16x32_bf16(kf[0 * 2 + 0], vk[0], S[0], 0, 0, 0); SC_SB();
                S[1] = __builtin_amdgcn_mfma_f32_16x16x32_bf16(kf[1 * 2 + 0], vk[0], S[1], 0, 0, 0); SC_SB();
                S[2] = __builtin_amdgcn_mfma_f32_16x16x32_bf16(kf[2 * 2 + 0], vk[0], S[2], 0, 0, 0);
                x0[0] = __uint_as_float(uu[2].x << 16) - aw[2][0]; x0[1] = __uint_as_float(uu[2].x & 0xffff0000u) - aw[2][1]; x0[2] = __uint_as_float(uu[2].y << 16) - aw[2][2]; x0[3] = __uint_as_float(uu[2].y & 0xffff0000u) - aw[2][3]; SC_PIN1x4(x0); SC_SB();
                S[3] = __builtin_amdgcn_mfma_f32_16x16x32_bf16(kf[3 * 2 + 0], vk[0], S[3], 0, 0, 0);
                x1[0] = __uint_as_float(uu[3].x << 16) - aw[3][0]; x1[1] = __uint_as_float(uu[3].x & 0xffff0000u) - aw[3][1]; x1[2] = __uint_as_float(uu[3].y << 16) - aw[3][2]; x1[3] = __uint_as_float(uu[3].y & 0xffff0000u) - aw[3][3]; SC_PIN1x4(x1); SC_SB();
                S[4] = __builtin_amdgcn_mfma_f32_16x16x32_bf16(kf[4 * 2 + 0], vk[0], S[4], 0, 0, 0);
                SC_MUL4(y0, x0, ek[2]); SC_MUL4(y1, x1, ek[3]); SC_PIN4(y0); SC_PIN4(y1); SC_SB();
                S[5] = __builtin_amdgcn_mfma_f32_16x16x32_bf16(kf[5 * 2 + 0], vk[0], S[5], 0, 0, 0);
                pv = (u32x4){pk2(x0[0], x0[1]), pk2(x0[2], x0[3]), pk2(x1[0], x1[1]), pk2(x1[2], x1[3])}; SC_PIN4(pv); SC_SB();
                S[6] = __builtin_amdgcn_mfma_f32_16x16x32_bf16(kf[6 * 2 + 0], vk[0], S[6], 0, 0, 0);
                pk = (u32x4){pk2(y0[0], y0[1]), pk2(y0[2], y0[3]), pk2(y1[0], y1[1]), pk2(y1[2], y1[3])}; SC_PIN4(pk); SC_SB();
                S[7] = __builtin_amdgcn_mfma_f32_16x16x32_bf16(kf[7 * 2 + 0], vk[0], S[7], 0, 0, 0);
                *(bf16x8*)(vdst + 1024) = __builtin_bit_cast(bf16x8, pv); vk[1] = __builtin_bit_cast(bf16x8, pk); SC_SB();
#pragma unroll
                for (int mt = 0; mt < 8; ++mt) S[mt] = __builtin_amdgcn_mfma_f32_16x16x32_bf16(kf[mt * 2 + 1], vk[1], S[mt], 0, 0, 0);
#undef SC_PIN4
#undef SC_PIN1x4
#undef SC_SB
#undef SC_MUL4
#undef SC_SCL4
#undef SC_VMUL
#ifdef SCX_ADELAY
                __builtin_amdgcn_s_sleep(15);
#endif
                SC_LBAR();
            }
        }
        __syncthreads();
    }
}
#undef SC_BAR
#undef SC_LBAR

constexpr int OL_QP = 0, OL_IN = 16384, OL_RED = 24576, OL_RS = 26624, OL_T = 27136;
__device__ __forceinline__ void ph_od_out(LAS unsigned char* lds, unsigned char* mx, const float* o_gain, int G, int vcu) {
    const int tid = otid(), lane = tid & 63, wid = __builtin_amdgcn_readfirstlane(tid >> 6), n16 = lane & 15, g4 = lane >> 4;
    const bf16_t* ITEMS = (const bf16_t*)(mx + OD_ITEMS); const float* EG = (const float*)(mx + OD_EG); const unsigned char* SSN = mx + OD_SSN;
    const bf16_t* ZS = (const bf16_t*)(mx + OD_ZS); bf16_t* Y = (bf16_t*)(mx + OD_Y);
    LAS float* red = (LAS float*)(lds + OL_RED); LAS float* rsv = (LAS float*)(lds + OL_RS);
#define OD_OUT_LOADS(it_, ST, SB, VB, EGv, Z0, Z1) do { const int bh_ = (it_) >> 7, c_ = (it_) & 127; const unsigned char* itb_ = (const unsigned char*)(ITEMS + (size_t)(it_) * IT_ELEMS); \
        _Pragma("unroll") for (int i = 0; i < 3; ++i) { const int piece = tid + 512 * i; ST[i] = *(const u32x4*)(itb_ + (piece < 1024 ? IT_QP * 2 + piece * 16 : IT_IN * 2 + (piece - 1024) * 16)); } \
        _Pragma("unroll") for (int ks = 0; ks < 4; ++ks) SB[ks] = *(const bf16x8*)(SSN + ((size_t)(it_) * 8 + wid) * 4096 + ks * 1024 + lane * 16); \
        _Pragma("unroll") for (int ks = 0; ks < 2; ++ks) VB[ks] = *(const bf16x8*)(itb_ + IT_UT * 2 + wid * 2048 + ks * 1024 + lane * 16); \
        _Pragma("unroll") for (int q_ = 0; q_ < 4; ++q_) EGv[q_] = *(const f32x4*)(EG + (size_t)bh_ * SEQ + 64 * c_ + 16 * q_ + 4 * g4); \
        { const size_t ro_ = (size_t)((bh_ >> 3) * SEQ + 64 * c_ + (tid >> 3)) * 1024 + (bh_ & 7) * 128 + (tid & 7) * 16; Z0 = *(const u32x4*)(ZS + ro_); Z1 = *(const u32x4*)(ZS + ro_ + 8); } } while (0)
    u32x4 stn[3], zn0, zn1; bf16x8 sbn[4], vbn[2]; f32x4 egn[4];
#define OD_ITEM(k_) ((((8 * (vcu & 7) + (k_)) >> 5) * 8 + ((vcu >> 3) >> 2)) * 128 + 4 * ((8 * (vcu & 7) + (k_)) & 31) + ((vcu >> 3) & 3))
    OD_OUT_LOADS(OD_ITEM(0), stn, sbn, vbn, egn, zn0, zn1);
    for (int k = 0; k < 8; ++k) { const int item = OD_ITEM(k), bh = item >> 7, c = item & 127, b = bh >> 3, h = bh & 7;
        u32x4 st[3], z0, z1; bf16x8 sb[4], vb[2]; f32x4 eg[4];
#pragma unroll
        for (int i = 0; i < 3; ++i) st[i] = stn[i];
#pragma unroll
        for (int i = 0; i < 4; ++i) { sb[i] = sbn[i]; eg[i] = egn[i]; }
        vb[0] = vbn[0]; vb[1] = vbn[1]; z0 = zn0; z1 = zn1;
#pragma unroll
        for (int i = 0; i < 3; ++i) *(LAS u32x4*)(lds + (tid + 512 * i) * 16) = st[i];
        { const int nx = OD_ITEM(k + 1 < 8 ? k + 1 : k); OD_OUT_LOADS(nx, stn, sbn, vbn, egn, zn0, zn1); }
        __syncthreads();
        f32x4d o[4];
        { bf16x8 qf[16], nf[8];
#pragma unroll
          for (int f = 0; f < 16; ++f) qf[f] = *(LAS const bf16x8*)(lds + OL_QP + f * 1024 + lane * 16);
#pragma unroll
          for (int f = 0; f < 8; ++f) nf[f] = *(LAS const bf16x8*)(lds + OL_IN + f * 1024 + lane * 16);
          asm volatile("s_waitcnt lgkmcnt(0)" ::: "memory"); __builtin_amdgcn_sched_barrier(0);
          f32x4d aq[4];
#pragma unroll
          for (int it = 0; it < 4; ++it) aq[it] = (f32x4d){0.f, 0.f, 0.f, 0.f};
#pragma unroll
          for (int ks = 0; ks < 4; ++ks)
#pragma unroll
              for (int it = 0; it < 4; ++it) aq[it] = __builtin_amdgcn_mfma_f32_16x16x32_bf16(qf[it * 4 + ks], sb[ks], aq[it], 0, 0, 0);
#pragma unroll
          for (int it = 0; it < 4; ++it) o[it] = aq[it] * eg[it];
#pragma unroll
          for (int ks = 0; ks < 2; ++ks)
#pragma unroll
              for (int it = 0; it < 4; ++it) o[it] = __builtin_amdgcn_mfma_f32_16x16x32_bf16(nf[it * 2 + ks], vb[ks], o[it], 0, 0, 0); }
#pragma unroll
        for (int it = 0; it < 4; ++it)
#pragma unroll
            for (int r = 0; r < 4; ++r) { float q = o[it][r] * o[it][r]; q += dpp_f(q, 0xB1); q += dpp_f(q, 0x4E); q += dpp_f(q, 0x141); q += dpp_f(q, 0x140);
                if (n16 == 0) red[wid * 64 + 16 * it + 4 * g4 + r] = q; }
        __syncthreads();
        if (tid < 64) { float tot = 0.f;
#pragma unroll
            for (int w = 0; w < 8; ++w) tot += red[w * 64 + tid];
            rsv[tid] = 1.0f / sqrtf(tot * (1.0f / 128.0f) + EPS); }
        __syncthreads();
        { const float gn = o_gain[16 * wid + n16];
#pragma unroll
          for (int it = 0; it < 4; ++it) { const f32x4 rs4 = *(LAS const f32x4*)(rsv + 16 * it + 4 * g4);
#pragma unroll
              for (int r = 0; r < 4; ++r) *(LAS unsigned short*)(lds + OL_T + (16 * it + 4 * g4 + r) * 272 + (16 * wid + n16) * 2) = (unsigned short)(pk2(o[it][r] * rs4[r] * gn, 0.f) & 0xffffu); } }
        __syncthreads();
        { const int tok = tid >> 3, dg = tid & 7; const size_t ro = (size_t)(b * SEQ + 64 * c + tok) * 1024 + h * 128 + dg * 16;
          const u32x4 t0 = *(LAS const u32x4*)(lds + OL_T + tok * 272 + dg * 32), t1 = *(LAS const u32x4*)(lds + OL_T + tok * 272 + dg * 32 + 16);
          u32x4 w0, w1;
#define OD_MUL2(t, z) pk2(__uint_as_float((t) << 16) * __uint_as_float((z) << 16), __uint_as_float((t) & 0xffff0000u) * __uint_as_float((z) & 0xffff0000u))
          w0.x = OD_MUL2(t0.x, z0.x); w0.y = OD_MUL2(t0.y, z0.y); w0.z = OD_MUL2(t0.z, z0.z); w0.w = OD_MUL2(t0.w, z0.w);
          w1.x = OD_MUL2(t1.x, z1.x); w1.y = OD_MUL2(t1.y, z1.y); w1.z = OD_MUL2(t1.z, z1.z); w1.w = OD_MUL2(t1.w, z1.w);
#undef OD_MUL2
          *(u32x4*)(Y + ro) = w0; *(u32x4*)(Y + ro + 8) = w1; }
        __syncthreads();
    }
}
#undef OD_OUT_LOADS
#undef OD_ITEM

constexpr int LDS_BYTES = 147456;
constexpr int MISC_OFF = 146432;

__global__ void __launch_bounds__(512, 2) mk_fwd(Args a) {
    extern __shared__ __attribute__((aligned(16))) unsigned char lds_raw[];
    LAS unsigned char* lds = (LAS unsigned char*)lds_raw;
    const int G = gridDim.x, bid = blockIdx.x;
    unsigned char* ws = a.ws;
    float* ss = (float*)(ws + WS_SS); float* cs = (float*)(ws + WS_ROPE); float* sn = cs + NTOK * 8;
    bf16_t* xb = (bf16_t*)(ws + WS_XB);
    const Args& P = a;
    const int lo = a.ph_lo, hi = a.ph_hi; int pc = 0;
    int vcu = bid; bool locok = false;
#if MK_ONE_LAUNCH
    LAS unsigned* misc = (LAS unsigned*)(lds + MISC_OFF);
    if (threadIdx.x < 4) misc[threadIdx.x] = 0u;
    __syncthreads();
    XcdBarrier bar = xcd_barrier_post((unsigned*)(ws + WS_BAR), (volatile LAS unsigned*)misc);
    if (threadIdx.x == 0) { const unsigned r = xb_add((unsigned*)(ws + WS_BAR) + 8 + (bar.x & 15u), 1u); misc[16] = (bar.x & 15u) + 8u * r; }
#define GRID_BAR() xcd_barrier(bar)
#else
#define GRID_BAR() do { } while (0)
#endif
#ifndef PROBE_PC
#define PROBE_PC -1
#define PROBE_REP 0
#endif
#ifndef GX_NT
#define GX_NT 0
#endif
#ifndef GX_KZ
#define GX_KZ 0
#endif
#define PH_BEGIN if (pc >= lo && pc < hi) { const int nrep_ = (PROBE_PC >= 0 && pc == PROBE_PC) ? 1 + PROBE_REP : 1; for (int rep_ = 0; rep_ < nrep_; ++rep_) { if (rep_) GRID_BAR();
#define PH_END   } if (pc + 1 < hi) GRID_BAR(); } ++pc;
#define PH_END_L PH_END_C(true)
#define PH_END_C(c) } if (pc + 1 < hi) xcd_barrier(bar, locok && (c)); } ++pc;

    PH_BEGIN
        ph_xprep(a.in[0], xb, ss, G, bid);
        ph_rope((const int*)a.in[1], cs, sn, G, bid);
        if (bid == 0 && threadIdx.x < 32) ((unsigned*)(ws + WS_TICK))[threadIdx.x] = 0u;
        convert_layer((LAS float*)lds, P, ws, 0, bid, G);
#ifdef PRX_CV
        for (int q_ = 0; q_ < PRX_CV; ++q_) convert_layer((LAS float*)lds, P, ws, 0, bid, G);
#endif
    PH_END
#if MK_ONE_LAUNCH
    if (lo == 0 && hi > 1 && G == 256) {
        if (threadIdx.x == 0) { unsigned ok = 1u;
            for (unsigned j = 0; j < 16; ++j) { const unsigned c = xb_ld((unsigned*)(ws + WS_BAR) + XB_XCNT(j)); ok &= (c == (j < 8u ? 32u : 0u)) ? 1u : 0u; }
            misc[17] = (ok && misc[16] < 256u) ? 1u : 0u; }
        __syncthreads();
        locok = __builtin_amdgcn_readfirstlane((int)misc[17]) != 0; if (locok) vcu = __builtin_amdgcn_readfirstlane((int)misc[16]); }
#endif
    for (int s = 0; s < 8; ++s) {
        const int l = s >> 1; unsigned char* wr = ws + WS_W + (size_t)(l & 1) * WREG;
        bf16_t* H = (bf16_t*)(ws + WS_MIX + ((l & 1) ? (size_t)128 * MB : ((s & 1) ? (size_t)0 : (size_t)100 * MB)));
        PH_BEGIN
            pg8::Gemm g{xb, (const bf16_t*)(wr + ((s & 1) ? WO_GU1 : WO_GU0)), NTOK, 2 * DFF, DM}; pg8::StaticOrder S; S.init(NTOK, 2 * DFF, G, vcu);
            EpiGateUp E{H, ss, (LAS float*)(lds + 131072), 8 * (vcu & 7) + ((vcu >> 3) & 7)};
            pg8::gemm_phase<EpiGateUp, pg8::StaticOrder, true, true>(lds, g, S, E);
            if (l < 3 && !(l & 1) && G == 256 && vcu >= 128) { __syncthreads(); convert_layer((LAS float*)lds, P, ws, l + 1, (s & 1) + 2 * (vcu - 128), 256); }
        PH_END_L
        PH_BEGIN
            pg8::Gemm g{H, (const bf16_t*)(wr + ((s & 1) ? WO_D1 : WO_D0)), NTOK, DM, DFF, rep_ ? GX_NT : 0, rep_ ? GX_KZ : 0}; pg8::StaticOrder S; S.init(NTOK, DM, G, vcu);
            EpiResid E{xb, ss, rep_ ? 0.f : 0.5f};
            pg8::gemm_phase<EpiResid, pg8::StaticOrder, false, true>(lds, g, S, E);
            if ((s & 1) && l < 3 && G != 256) { __syncthreads(); convert_layer((LAS float*)lds, P, ws, l + 1, bid, G); }
        PH_END_C(!(s & 1))
        if (!(s & 1)) {
            unsigned char* mx = ws + WS_MIX;
            if (!(l & 1)) {
                PH_BEGIN
                    pg8::Gemm g{xb, (const bf16_t*)(wr + WO_MIN), NTOK, 3840, DM}; pg8::StaticOrder S; S.init(NTOK, 3840, G, vcu);
                    EpiEvIn E{mx, ss, cs, sn, (LAS float*)(lds + 131072), 8 * (vcu & 7) + ((vcu >> 3) & 7)};
                    pg8::gemm_phase<EpiEvIn, pg8::StaticOrder, true, true>(lds, g, S, E);
                PH_END
                PH_BEGIN
                    for (int rp_ = 0; rp_ < EVX_YC; ++rp_) ph_yconv(mx, a.in[7] + (size_t)(l >> 1) * 3 * 512, G, bid);
                    ph_ev_index(mx, G, bid);
                PH_END
                PH_BEGIN
                    for (int p = bid; p < 256; p += G) { const int x8 = p & 7, kk = p >> 3, bh = x8 + 8 * (kk >> 4), j = kk & 15;
                        at64::attn64_unit(bh >> 3, bh & 7, j, (const bf16_t*)(mx + EV_Q), (const bf16_t*)(mx + EV_K), (const bf16_t*)(mx + EV_V), (const unsigned*)(mx + EV_BM), (bf16_t*)(mx + EV_Y), (char*)lds_raw);
                        at64::attn64_unit(bh >> 3, bh & 7, 31 - j, (const bf16_t*)(mx + EV_Q), (const bf16_t*)(mx + EV_K), (const bf16_t*)(mx + EV_V), (const unsigned*)(mx + EV_BM), (bf16_t*)(mx + EV_Y), (char*)lds_raw); }
                PH_END
                PH_BEGIN
                    pg8::Gemm g{(const bf16_t*)(mx + EV_Y), (const bf16_t*)(wr + WO_MOUT), NTOK, DM, DM, rep_ ? GX_NT : 0, rep_ ? GX_KZ : 0}; pg8::StaticOrder S; S.init(NTOK, DM, G, vcu);
                    EpiResid E{xb, ss, rep_ ? 0.f : 1.0f};
                    pg8::gemm_phase<EpiResid, pg8::StaticOrder, false, true>(lds, g, S, E);
                PH_END_L
            } else {
                const int io = l >> 1;
                PH_BEGIN
                    pg8::Gemm g{xb, (const bf16_t*)(wr + WO_MIN), NTOK, 4096, DM}; pg8::StaticOrder S; S.init(NTOK, 4096, G, vcu);
                    EpiOdIn E{mx, ss, (LAS float*)(lds + 131072), 8 * (vcu & 7) + ((vcu >> 3) & 7)};
                    pg8::gemm_phase<EpiOdIn, pg8::StaticOrder, true, true>(lds, g, S, E);
                PH_END
                PH_BEGIN
                    ph_od_prep(lds, mx, xb, ss, (const bf16_t*)(wr + WO_BA), a.in[10] + (size_t)io * 4 * 3072, a.in[11] + io * 8, a.in[12] + io * 8, G, bid);
                PH_END
                PH_BEGIN
                    int role = bid; ph_od_scan(lds_raw, lds, mx, (unsigned*)(ws + WS_TICK) + (l >> 1) * 16, role, G, bid);
                    if (l < 3 && G == 256 && role >= 128) convert_layer((LAS float*)lds, P, ws, l + 1, role - 128, 128);
                PH_END
                PH_BEGIN
                    ph_od_out(lds, mx, a.in[13] + io * 128, G, vcu);
                PH_END_L
                PH_BEGIN
                    pg8::Gemm g{(const bf16_t*)(mx + OD_Y), (const bf16_t*)(wr + WO_MOUT), NTOK, DM, DM}; pg8::StaticOrder S; S.init(NTOK, DM, G, vcu);
                    EpiResid E{xb, ss, rep_ ? 0.f : 1.0f};
                    pg8::gemm_phase<EpiResid, pg8::StaticOrder, false, true>(lds, g, S, E);
                PH_END
            }
        }
    }
#ifdef BARX
    for (int q_ = 0; q_ < BARX; ++q_) GRID_BAR();
#endif
    PH_BEGIN
        const float* fg = a.in[15]; const int tid = otid(), wid = tid >> 6, lane = tid & 63;
        for (int row0 = bid * 8 + wid; row0 < NTOK; row0 += G * 8 * 2) {
            u32x4 xv[2][2]; float r[2];
#pragma unroll
            for (int k = 0; k < 2; ++k) { const int row = row0 + k * G * 8 < NTOK ? row0 + k * G * 8 : row0;
#pragma unroll
                for (int q = 0; q < 2; ++q) xv[k][q] = *(const u32x4*)(xb + (size_t)row * DM + q * 512 + lane * 8);
                r[k] = row_rstd(ss, row); }
#pragma unroll
            for (int k = 0; k < 2; ++k) { const int row = row0 + k * G * 8; if (row < NTOK) { float* orow = a.out + (size_t)row * DM;
#pragma unroll
                for (int q = 0; q < 2; ++q) { const int c = q * 512 + lane * 8; const u32x4 x4 = xv[k][q]; const f32x4 g0 = *(const f32x4*)(fg + c), g1 = *(const f32x4*)(fg + c + 4);
                    f32x4 v0, v1; v0[0] = __uint_as_float(x4.x << 16); v0[1] = __uint_as_float(x4.x & 0xffff0000u); v0[2] = __uint_as_float(x4.y << 16); v0[3] = __uint_as_float(x4.y & 0xffff0000u);
                    v1[0] = __uint_as_float(x4.z << 16); v1[1] = __uint_as_float(x4.z & 0xffff0000u); v1[2] = __uint_as_float(x4.w << 16); v1[3] = __uint_as_float(x4.w & 0xffff0000u);
                    *(f32x4*)(orow + c) = v0 * r[k] * g0; *(f32x4*)(orow + c + 4) = v1 * r[k] * g1; } } }
        }
    PH_END
}
}

#ifndef MK_SPLIT
#define MK_SPLIT 0
#endif
static void launch_phases(const mk::Args& base, int lo, int hi, int grid, hipStream_t st) {
    mk::Args a = base; a.ph_lo = lo; a.ph_hi = hi;
    if (hi - lo > 1) (void)hipMemsetAsync(base.ws + mk::WS_BAR, 0, XCD_BAR_WORDS * sizeof(unsigned), st);
    hipLaunchKernelGGL(mk::mk_fwd, dim3(grid), dim3(512), mk::LDS_BYTES, st, a);
}
constexpr int N_PHASES = 1 + 8 * 2 + 2 * 4 + 2 * 5 + 1;

extern "C" void kernel_launch(void* const* d_in, const int* in_sizes, int n_in, void* d_out, int out_size, void* d_ws, size_t ws_size, hipStream_t stream) {
    static int grid = 0;
    if (grid == 0) {
        int dev = 0, cus = 0;
        if (hipGetDevice(&dev) != hipSuccess || hipDeviceGetAttribute(&cus, hipDeviceAttributeMultiprocessorCount, dev) != hipSuccess) { grid = -1; return; }
        if (hipFuncSetAttribute((const void*)mk::mk_fwd, hipFuncAttributeMaxDynamicSharedMemorySize, mk::LDS_BYTES) != hipSuccess) { grid = -1; return; }
        if (cus < 256) { fprintf(stderr, "kernel_launch: needs 256 compute units (one output tile per workgroup in the residual GEMM phases), found %d\n", cus); grid = -1; return; }
        grid = 256;
        if (ws_size < (size_t)404 * mk::MB || n_in != 16) { fprintf(stderr, "kernel_launch: unexpected workspace/inputs: %zu %d\n", ws_size, n_in); grid = -1; return; }
    }
    if (grid < 0) return;
    mk::Args a{}; for (int i = 0; i < 16; ++i) a.in[i] = (const float*)d_in[i];
    a.out = (float*)d_out; a.ws = (unsigned char*)d_ws;
#if MK_SPLIT
    for (int p = 0; p < N_PHASES; ++p) launch_phases(a, p, p + 1, grid, stream);
#else
    launch_phases(a, 0, N_PHASES, grid, stream);
#endif
}
```
